# Optimizing an MI355X kernel written in HIP

```python
import math
import jax, jax.numpy as jnp
from jax import lax
import numpy as np

D_MODEL = 1024
BATCH = 8
SEQ = 4096
DEPTH = 1

MEM_LEN = 256
DIFF_HEADS = 8
DIFF_HEAD_DIM = 64
DIFF_V_DIM = 2 * DIFF_HEAD_DIM
DIFF_QK_WIDTH = DIFF_HEADS * 2 * DIFF_HEAD_DIM
DIFF_WIDTH = DIFF_HEADS * DIFF_V_DIM
CONV_WIDTH = D_MODEL
CONV_K = 3
MEM_HEADS = 4
MEM_HEAD_DIM = 256
MEM_WIDTH = MEM_HEADS * MEM_HEAD_DIM
N_BRANCH = 3
D_FF = 4 * D_MODEL
Q_BLOCK = 128
NORM_EPS = 1e-6
MASK_VALUE = -1e30

SPLIT_SIZES = (DIFF_QK_WIDTH, DIFF_QK_WIDTH, DIFF_WIDTH, 3 * CONV_WIDTH, MEM_WIDTH, N_BRANCH * D_MODEL)
SPLIT_POINTS = tuple(int(v) for v in np.cumsum(SPLIT_SIZES)[:-1])
PROJ_WIDTH = int(sum(SPLIT_SIZES))

kernel_name = "hybrid_diffattn_shortconv_memxattn_block"


def rms_norm(x, g):
    xf = x.astype(jnp.float32)
    y = xf * lax.rsqrt(jnp.mean(xf * xf, axis=-1, keepdims=True) + NORM_EPS)
    return (y * g.astype(jnp.float32)).astype(x.dtype)


def diff_attention(q_d, k_d, v_d, lam, q_norm_g, k_norm_g):
    B, S = q_d.shape[0], q_d.shape[1]
    q = rms_norm(q_d.reshape(B, S, DIFF_HEADS, 2, DIFF_HEAD_DIM), q_norm_g)
    q = q * jnp.asarray(DIFF_HEAD_DIM ** -0.5, q.dtype)
    k = rms_norm(k_d.reshape(B, S, DIFF_HEADS, 2, DIFF_HEAD_DIM), k_norm_g)
    v = v_d.reshape(B, S, DIFF_HEADS, DIFF_V_DIM)
    nb = S // Q_BLOCK
    q_blocks = jnp.moveaxis(q.reshape(B, nb, Q_BLOCK, DIFF_HEADS, 2, DIFF_HEAD_DIM), 1, 0)
    key_pos = jnp.arange(S)

    def one_block(args):
        q_blk, blk = args
        s = jnp.einsum('bqhcd,bkhcd->bhcqk', q_blk, k).astype(jnp.float32)
        q_pos = blk * Q_BLOCK + jnp.arange(Q_BLOCK)
        causal = key_pos[None, :] <= q_pos[:, None]
        s = jnp.where(causal, s, MASK_VALUE)
        p = jax.nn.softmax(s, axis=-1)
        a = p[:, :, 0] - lam * p[:, :, 1]
        return jnp.einsum('bhqk,bkhe->bqhe', a.astype(v.dtype), v)

    o = lax.map(one_block, (q_blocks, jnp.arange(nb)))
    return jnp.moveaxis(o, 0, 1).reshape(B, S, DIFF_HEADS, DIFF_V_DIM)


def short_gated_conv(conv_in, conv_w):
    x_c, gate_b, gate_c = jnp.split(conv_in, 3, axis=-1)
    inner = gate_c * x_c
    y = lax.conv_general_dilated(
        inner, conv_w[:, None, :], window_strides=(1,), padding=[(CONV_K - 1, 0)],
        dimension_numbers=('NWC', 'WIO', 'NWC'), feature_group_count=CONV_WIDTH)
    return gate_b * y


def memory_attention(q_m, mem_n, w_mem_kv, mq_norm_g, mk_norm_g):
    B, S = q_m.shape[0], q_m.shape[1]
    M = mem_n.shape[1]
    kv = mem_n @ w_mem_kv
    k_m, v_m = jnp.split(kv, 2, axis=-1)
    q = rms_norm(q_m.reshape(B, S, MEM_HEADS, MEM_HEAD_DIM), mq_norm_g)
    q = q * jnp.asarray(MEM_HEAD_DIM ** -0.5, q.dtype)
    k = rms_norm(k_m.reshape(B, M, MEM_HEADS, MEM_HEAD_DIM), mk_norm_g)
    v = v_m.reshape(B, M, MEM_HEADS, MEM_HEAD_DIM)
    s = jnp.einsum('bshd,bmhd->bhsm', q, k).astype(jnp.float32)
    p = jax.nn.softmax(s, axis=-1)
    o = jnp.einsum('bhsm,bmhd->bshd', p.astype(v.dtype), v)
    return o.reshape(B, S, MEM_WIDTH)


def hybrid_layer(x, mem, lam_init, norm_mix_g, norm_mem_g, w_in, b_gate, q_norm_g, k_norm_g,
                 lam_q1, lam_k1, lam_q2, lam_k2, subln_g, w_attn_o, conv_w, w_conv_o,
                 w_mem_kv, mq_norm_g, mk_norm_g, w_mem_o, w_o, norm_mlp_g, w_mlp_in, w_mlp_out):
    B, S, D = x.shape
    h = rms_norm(x, norm_mix_g)
    proj = h @ w_in
    q_d, k_d, v_d, conv_in, q_m, gate_logits = jnp.split(proj, SPLIT_POINTS, axis=-1)

    lam = (jnp.exp(jnp.sum(lam_q1.astype(jnp.float32) * lam_k1.astype(jnp.float32)))
           - jnp.exp(jnp.sum(lam_q2.astype(jnp.float32) * lam_k2.astype(jnp.float32)))
           + lam_init)
    o = diff_attention(q_d.reshape(B, S, DIFF_HEADS, -1), k_d.reshape(B, S, DIFF_HEADS, -1),
                       v_d.reshape(B, S, DIFF_HEADS, -1), lam, q_norm_g, k_norm_g)
    o = rms_norm(o, subln_g) * jnp.asarray(1.0 - lam_init, o.dtype)
    y_attn = o.reshape(B, S, DIFF_WIDTH) @ w_attn_o

    y_conv = short_gated_conv(conv_in, conv_w) @ w_conv_o

    mem_n = rms_norm(mem, norm_mem_g)
    y_mem = memory_attention(q_m, mem_n, w_mem_kv, mq_norm_g, mk_norm_g) @ w_mem_o

    g = jax.nn.sigmoid((gate_logits + b_gate).astype(jnp.float32)).astype(x.dtype)
    g = g.reshape(B, S, N_BRANCH, D)
    merged = g[:, :, 0] * y_attn + g[:, :, 1] * y_conv + g[:, :, 2] * y_mem
    x = x + merged @ w_o

    h2 = rms_norm(x, norm_mlp_g)
    x = x + jnp.square(jax.nn.relu(h2 @ w_mlp_in)) @ w_mlp_out
    return x


def setup_inputs(seed: int = 0) -> dict:
    key = jax.random.key(seed)
    ks = jax.random.split(key, 26)
    f32 = jnp.float32
    L = DEPTH

    def nrm(k, shape, scale):
        return jax.random.normal(k, shape, f32) * scale

    def gain(k, shape):
        return 1.0 + 0.05 * jax.random.normal(k, shape, f32)

    return {
        'x': nrm(ks[0], (BATCH, SEQ, D_MODEL), 1.0),
        'mem': nrm(ks[1], (BATCH, MEM_LEN, D_MODEL), 1.0),
        'norm_mix_g': gain(ks[2], (L, D_MODEL)),
        'norm_mem_g': gain(ks[3], (L, D_MODEL)),
        'w_in': nrm(ks[4], (L, D_MODEL, PROJ_WIDTH), D_MODEL ** -0.5),
        'b_gate': nrm(ks[5], (L, N_BRANCH * D_MODEL), 0.1),
        'q_norm_g': gain(ks[6], (L, DIFF_HEAD_DIM)),
        'k_norm_g': gain(ks[7], (L, DIFF_HEAD_DIM)),
        'lam_q1': nrm(ks[8], (L, DIFF_HEAD_DIM), 0.1),
        'lam_k1': nrm(ks[9], (L, DIFF_HEAD_DIM), 0.1),
        'lam_q2': nrm(ks[10], (L, DIFF_HEAD_DIM), 0.1),
        'lam_k2': nrm(ks[11], (L, DIFF_HEAD_DIM), 0.1),
        'subln_g': gain(ks[12], (L, DIFF_V_DIM)),
        'w_attn_o': nrm(ks[13], (L, DIFF_WIDTH, D_MODEL), DIFF_WIDTH ** -0.5),
        'conv_w': nrm(ks[14], (L, CONV_K, CONV_WIDTH), CONV_K ** -0.5),
        'w_conv_o': nrm(ks[15], (L, CONV_WIDTH, D_MODEL), CONV_WIDTH ** -0.5),
        'w_mem_kv': nrm(ks[16], (L, D_MODEL, 2 * MEM_WIDTH), D_MODEL ** -0.5),
        'mq_norm_g': gain(ks[17], (L, MEM_HEAD_DIM)),
        'mk_norm_g': gain(ks[18], (L, MEM_HEAD_DIM)),
        'w_mem_o': nrm(ks[19], (L, MEM_WIDTH, D_MODEL), MEM_WIDTH ** -0.5),
        'w_o': nrm(ks[20], (L, D_MODEL, D_MODEL), D_MODEL ** -0.5),
        'norm_mlp_g': gain(ks[21], (L, D_MODEL)),
        'w_mlp_in': nrm(ks[22], (L, D_MODEL, D_FF), D_MODEL ** -0.5),
        'w_mlp_out': nrm(ks[23], (L, D_FF, D_MODEL), D_FF ** -0.5),
    }


def reference(x, mem, norm_mix_g, norm_mem_g, w_in, b_gate, q_norm_g, k_norm_g,
              lam_q1, lam_k1, lam_q2, lam_k2, subln_g, w_attn_o, conv_w, w_conv_o,
              w_mem_kv, mq_norm_g, mk_norm_g, w_mem_o, w_o, norm_mlp_g, w_mlp_in, w_mlp_out):
    for l in range(DEPTH):
        lam_init = 0.8 - 0.6 * math.exp(-0.3 * l)
        x = hybrid_layer(x, mem, lam_init, norm_mix_g[l], norm_mem_g[l], w_in[l], b_gate[l],
                         q_norm_g[l], k_norm_g[l], lam_q1[l], lam_k1[l], lam_q2[l], lam_k2[l],
                         subln_g[l], w_attn_o[l], conv_w[l], w_conv_o[l], w_mem_kv[l],
                         mq_norm_g[l], mk_norm_g[l], w_mem_o[l], w_o[l], norm_mlp_g[l],
                         w_mlp_in[l], w_mlp_out[l])
    return x
```

```cpp
#include <hip/hip_runtime.h>
#include <hip/hip_cooperative_groups.h>
#include <hip/hip_bf16.h>
#include <cstdio>
#include <cstdint>
#include <cmath>
namespace cg = cooperative_groups;
namespace pg8 {
#define PG8_LAS __attribute__((address_space(3)))
typedef unsigned short bf16_t;
typedef short bf16x8 __attribute__((ext_vector_type(8)));
typedef float f32x4 __attribute__((ext_vector_type(4)));
typedef unsigned u32x4 __attribute__((ext_vector_type(4)));
constexpr int BM = 256, BK = 64, HALF = 128, HTB = HALF * BK * 2  , STAGE_BYTES = 8 * HTB, NXCD = 8, WGM = 8;

__host__ __device__ __forceinline__ int lds_byte(int r, int c) { const int st = (r >> 4) * 2 + (c >> 5), rr = r & 15, cc = c & 31, ob = rr * 64 + cc * 2; return st * 1024 + (ob ^ (((ob >> 9) & 1) << 5)); }
__host__ __device__ __forceinline__ void stage_rc(int b, int& R, int& C) { const int st = b / 1024, sb = b % 1024, swz = sb ^ (((sb >> 9) & 1) << 5); R = (st >> 1) * 16 + swz / 64; C = (st & 1) * 32 + (swz % 64) / 2; }
__host__ __device__ __forceinline__ int perm32(int rho) { const int n = rho >> 4, i = rho & 15; return 8 * (i >> 2) + 4 * n + (i & 3); }

struct Unit { int pm, pn; };
struct Gemm { const bf16_t* A; const bf16_t* Bt; int lda, ldb, K; long sAm, sAn, sBn, sBb; };

struct StaticOrder {
    int nM, nN, nwg, G, c;
    __host__ __device__ void init(int M, int N, int G_, int c_) { nM = M / BM; nN = N / BM; nwg = nM * nN; G = G_; c = c_; }
    __host__ __device__ bool next(int i, Unit& u) const {
        const long L = (long)i * G + c; if (L >= nwg) return false;
        int wgid = (int)L; { const int q = nwg / NXCD, r = nwg % NXCD, xcd = wgid % NXCD, off = wgid / NXCD; wgid = (xcd < r ? xcd * (q + 1) : r * (q + 1) + (xcd - r) * q) + off; }
        const int nig = WGM * nN, gid = wgid / nig, fm = gid * WGM, gsz = (nM - fm) < WGM ? (nM - fm) : WGM;
        u.pm = fm + ((wgid % nig) % gsz); u.pn = (wgid % nig) / gsz; return true;
    }
    __device__ __forceinline__ void a_ready(const Unit&) const {}
    __device__ __forceinline__ void done(const Unit&) const {}
};

__device__ __forceinline__ unsigned cvt_pk_bf16(float lo, float hi) { unsigned r; asm volatile("v_cvt_pk_bf16_f32 %0, %1, %2" : "=v"(r) : "v"(lo), "v"(hi)); return r; }
__device__ __forceinline__ u32x4 pack8(const f32x4& v0, const f32x4& v1) { u32x4 w; w.x = cvt_pk_bf16(v0[0], v0[1]); w.y = cvt_pk_bf16(v0[2], v0[3]); w.z = cvt_pk_bf16(v1[0], v1[1]); w.w = cvt_pk_bf16(v1[2], v1[3]); return w; }
__device__ __forceinline__ void unpack8(const u32x4& w, f32x4& v0, f32x4& v1) {
    v0[0] = __uint_as_float(w.x << 16); v0[1] = __uint_as_float(w.x & 0xffff0000u); v0[2] = __uint_as_float(w.y << 16); v0[3] = __uint_as_float(w.y & 0xffff0000u);
    v1[0] = __uint_as_float(w.z << 16); v1[1] = __uint_as_float(w.z & 0xffff0000u); v1[2] = __uint_as_float(w.w << 16); v1[3] = __uint_as_float(w.w & 0xffff0000u); }
typedef f32x4 Acc[2][2][4][2];
#define PG8_FOR_AM _Pragma("unroll") for (int ai = 0; ai < 2; ++ai) _Pragma("unroll") for (int m = 0; m < 4; ++m)
#define PG8_FOR_BN _Pragma("unroll") for (int bj = 0; bj < 2; ++bj) _Pragma("unroll") for (int n = 0; n < 2; ++n)
__device__ __forceinline__ float dot4(const f32x4& a) { return (a[0] * a[0] + a[1] * a[1]) + (a[2] * a[2] + a[3] * a[3]); }
__device__ __forceinline__ float sum4(const f32x4& a) { return (a[0] + a[1]) + (a[2] + a[3]); }
__device__ __forceinline__ void row_sum_xchg(float (&s)[2][4], PG8_LAS float* X, int wr, int wc, int fr, int fq) {
    PG8_FOR_AM { float v = s[ai][m]; v += __shfl_xor(v, 16); v += __shfl_xor(v, 32); if (fq == 0) X[(ai * HALF + wr * 64 + m * 16 + fr) * 4 + wc] = v; }
    asm volatile("s_waitcnt lgkmcnt(0)" ::: "memory"); __builtin_amdgcn_s_barrier(); asm volatile("" ::: "memory");
    PG8_FOR_AM { const f32x4 t = *(const PG8_LAS f32x4*)(X + (ai * HALF + wr * 64 + m * 16 + fr) * 4); s[ai][m] = (t[0] + t[1]) + (t[2] + t[3]); }
}
__device__ __forceinline__ void store_tile_bf16(const Acc& acc, bf16_t* base  , size_t ldc, int wr, int fr) {
    PG8_FOR_AM { bf16_t* rowp = base + (size_t)(ai * HALF + wr * 64 + m * 16 + fr) * ldc;
#pragma unroll
        for (int bj = 0; bj < 2; ++bj) *(u32x4*)(rowp + bj * 32) = pack8(acc[ai][bj][m][0], acc[ai][bj][m][1]); }
}
constexpr float LOG2E = 1.4426950408889634f;
constexpr float NORM_EPS = 1e-6f;
struct EpiQK {
    bf16_t* r0; size_t rstride; const float* qg; const float* kg;
    __device__ __forceinline__ void operator()(Acc& acc, const Unit& u, int wr, int wc, int fr, int fq) const {
        const int type = u.pn >> 2, colt = (u.pn & 3) * BM, c0 = wc * 64 + 8 * fq;
        const float* gp = type == 0 ? qg : kg; const float sc = type == 0 ? 0.125f * LOG2E : 1.0f;
        f32x4 gv[2][2];
        PG8_FOR_BN gv[bj][n] = *(const f32x4*)(gp + bj * 32 + 8 * fq + 4 * n) * sc;
        bf16_t* base = r0 + (size_t)type * rstride + (size_t)u.pm * BM * 1024 + colt + c0;
        PG8_FOR_AM { float ss = 0.f; PG8_FOR_BN ss += dot4(acc[ai][bj][m][n]);
            ss += __shfl_xor(ss, 16); ss += __shfl_xor(ss, 32);
            const float rstd = __builtin_amdgcn_rsqf(ss * (1.0f / 64.0f) + NORM_EPS);
            bf16_t* rowp = base + (size_t)(ai * HALF + wr * 64 + m * 16 + fr) * 1024;
#pragma unroll
            for (int bj = 0; bj < 2; ++bj) *(u32x4*)(rowp + bj * 32) = pack8(acc[ai][bj][m][0] * (gv[bj][0] * rstd), acc[ai][bj][m][1] * (gv[bj][1] * rstd)); }
    }
};
struct EpiRegion {
    bf16_t* r0; size_t rstride;
    __device__ __forceinline__ void operator()(Acc& acc, const Unit& u, int wr, int wc, int fr, int fq) const {
        store_tile_bf16(acc, r0 + (size_t)(u.pn >> 2) * rstride + (size_t)u.pm * BM * 1024 + (u.pn & 3) * BM + wc * 64 + 8 * fq, 1024, wr, fr);
    }
};
struct EpiQm {
    bf16_t* O; PG8_LAS float* X;
    __device__ __forceinline__ void operator()(Acc& acc, const Unit& u, int wr, int wc, int fr, int fq) const {
        float s[2][4];
        PG8_FOR_AM { float ss = 0.f; PG8_FOR_BN ss += dot4(acc[ai][bj][m][n]); s[ai][m] = ss; }
        row_sum_xchg(s, X, wr, wc, fr, fq);
        PG8_FOR_AM { const float rstd = __builtin_amdgcn_rsqf(s[ai][m] * (1.0f / 256.0f) + NORM_EPS); PG8_FOR_BN acc[ai][bj][m][n] = acc[ai][bj][m][n] * rstd; }
        asm volatile("s_waitcnt lgkmcnt(0)" ::: "memory"); __builtin_amdgcn_s_barrier(); asm volatile("" ::: "memory");
        store_tile_bf16(acc, O + (size_t)u.pm * BM * 1024 + u.pn * BM + wc * 64 + 8 * fq, 1024, wr, fr);
    }
};
struct EpiMemK {
    bf16_t* O; const float* gq; const float* gk; PG8_LAS float* X;
    __device__ __forceinline__ void operator()(Acc& acc, const Unit& u, int wr, int wc, int fr, int fq) const {
        const int c0 = wc * 64 + 8 * fq;
        f32x4 gv[2][2];
        PG8_FOR_BN gv[bj][n] = *(const f32x4*)(gq + c0 + bj * 32 + 4 * n) * *(const f32x4*)(gk + c0 + bj * 32 + 4 * n) * (LOG2E / 16.0f);
        float s[2][4];
        PG8_FOR_AM { float ss = 0.f; PG8_FOR_BN ss += dot4(acc[ai][bj][m][n]); s[ai][m] = ss; }
        row_sum_xchg(s, X, wr, wc, fr, fq);
        PG8_FOR_AM { const float rstd = __builtin_amdgcn_rsqf(s[ai][m] * (1.0f / 256.0f) + NORM_EPS); PG8_FOR_BN acc[ai][bj][m][n] = acc[ai][bj][m][n] * (gv[bj][n] * rstd); }
        asm volatile("s_waitcnt lgkmcnt(0)" ::: "memory"); __builtin_amdgcn_s_barrier(); asm volatile("" ::: "memory");
        store_tile_bf16(acc, O + (size_t)u.pm * BM * 1024 + u.pn * BM + c0, 1024, wr, fr);
    }
};
struct EpiPlain {
    bf16_t* O; int ldc;
    __device__ __forceinline__ void operator()(Acc& acc, const Unit& u, int wr, int wc, int fr, int fq) const {
        store_tile_bf16(acc, O + (size_t)u.pm * BM * ldc + u.pn * BM + wc * 64 + 8 * fq, ldc, wr, fr);
    }
};
struct EpiSoftmax {
    bf16_t* O; PG8_LAS float* X;
    __device__ __forceinline__ void operator()(Acc& acc, const Unit& u, int wr, int wc, int fr, int fq) const {
        float s[2][4];
        PG8_FOR_AM { float ss = 0.f; PG8_FOR_BN { f32x4& v = acc[ai][bj][m][n]; v[0] = __builtin_amdgcn_exp2f(v[0]); v[1] = __builtin_amdgcn_exp2f(v[1]); v[2] = __builtin_amdgcn_exp2f(v[2]); v[3] = __builtin_amdgcn_exp2f(v[3]); ss += sum4(v); } s[ai][m] = ss; }
        row_sum_xchg(s, X, wr, wc, fr, fq);
        PG8_FOR_AM { const float inv = __builtin_amdgcn_rcpf(s[ai][m]); PG8_FOR_BN acc[ai][bj][m][n] = acc[ai][bj][m][n] * inv; }
        asm volatile("s_waitcnt lgkmcnt(0)" ::: "memory"); __builtin_amdgcn_s_barrier(); asm volatile("" ::: "memory");
        store_tile_bf16(acc, O + (size_t)u.pm * BM * 1024 + u.pn * BM + wc * 64 + 8 * fq, 1024, wr, fr);
    }
};
struct EpiGate {
    bf16_t* g0; size_t gstride; const float* bias;
    __device__ __forceinline__ void operator()(Acc& acc, const Unit& u, int wr, int wc, int fr, int fq) const {
        const int br = u.pn >> 2, colt = (u.pn & 3) * BM, c0 = wc * 64 + 8 * fq;
        f32x4 bv[2][2];
        PG8_FOR_BN bv[bj][n] = *(const f32x4*)(bias + u.pn * BM + c0 + bj * 32 + 4 * n);
        PG8_FOR_AM PG8_FOR_BN { f32x4 v = acc[ai][bj][m][n] + bv[bj][n];
#pragma unroll
            for (int e = 0; e < 4; ++e) v[e] = __builtin_amdgcn_rcpf(1.0f + __builtin_amdgcn_exp2f(-LOG2E * v[e]));
            acc[ai][bj][m][n] = v; }
        store_tile_bf16(acc, g0 + (size_t)br * gstride + (size_t)u.pm * BM * 1024 + colt + c0, 1024, wr, fr);
    }
};
template <bool ACCUM> struct EpiBranch {
    const bf16_t* g; bf16_t* O;
    __device__ __forceinline__ void operator()(Acc& acc, const Unit& u, int wr, int wc, int fr, int fq) const {
        const size_t off0 = (size_t)u.pm * BM * 1024 + u.pn * BM + wc * 64 + 8 * fq;
        PG8_FOR_AM { const size_t ro = off0 + (size_t)(ai * HALF + wr * 64 + m * 16 + fr) * 1024;
#pragma unroll
            for (int bj = 0; bj < 2; ++bj) { f32x4 g0v, g1v; unpack8(*(const u32x4*)(g + ro + bj * 32), g0v, g1v);
                f32x4 v0 = acc[ai][bj][m][0] * g0v, v1 = acc[ai][bj][m][1] * g1v;
                if (ACCUM) { f32x4 p0, p1; unpack8(*(const u32x4*)(O + ro + bj * 32), p0, p1); v0 = v0 + p0; v1 = v1 + p1; }
                *(u32x4*)(O + ro + bj * 32) = pack8(v0, v1); } }
    }
};
struct EpiResF32 {
    const float* base; float* out;
    __device__ __forceinline__ void operator()(Acc& acc, const Unit& u, int wr, int wc, int fr, int fq) const {
        const size_t off0 = (size_t)u.pm * BM * 1024 + u.pn * BM + wc * 64 + 8 * fq;
        PG8_FOR_AM { const size_t ro = off0 + (size_t)(ai * HALF + wr * 64 + m * 16 + fr) * 1024;
            PG8_FOR_BN { const f32x4 b = *(const f32x4*)(base + ro + bj * 32 + 4 * n); *(f32x4*)(out + ro + bj * 32 + 4 * n) = b + acc[ai][bj][m][n]; } }
    }
};
struct EpiRelu2 {
    bf16_t* O; int ldc;
    __device__ __forceinline__ void operator()(Acc& acc, const Unit& u, int wr, int wc, int fr, int fq) const {
        PG8_FOR_AM PG8_FOR_BN { f32x4 v = acc[ai][bj][m][n];
#pragma unroll
            for (int e = 0; e < 4; ++e) { const float r = __builtin_fmaxf(v[e], 0.f); v[e] = r * r; }
            acc[ai][bj][m][n] = v; }
        store_tile_bf16(acc, O + (size_t)u.pm * BM * ldc + u.pn * BM + wc * 64 + 8 * fq, ldc, wr, fr);
    }
};

template <class Epi, class Sched, bool ALIGN_EPI = false, bool SP2 = false>
__device__ __forceinline__ void gemm_phase(PG8_LAS unsigned char* lds, const Gemm g, const Sched& S, const Epi& E) {
    const int tid = threadIdx.x, wid = __builtin_amdgcn_readfirstlane(tid >> 6), lane = tid & 63, wr = wid >> 2, wc = wid & 3, fr = lane & 15, fq = lane >> 4;
    const int K = g.K, nt = K / BK;
    unsigned voffA[2], voffB[2];
#pragma unroll
    for (int i = 0; i < 2; ++i) { int R, C; stage_rc(tid * 16 + i * 8192, R, C); const int Rb = 64 * (R >> 5) + perm32(R & 31);
        voffA[i] = (unsigned)(R * g.lda + C) * 2u; voffB[i] = (unsigned)(Rb * g.ldb + C) * 2u; }
    const size_t kstep = (size_t)(BK * 2);
    const size_t hstepA = (size_t)HALF * g.lda * 2;
    const size_t hstepB = (size_t)32 * g.ldb * 2;
    const unsigned ldsw = (unsigned)wid * 1024u;
    const int aoff = lds_byte(wr * 64 + fr, fq * 8), boff = lds_byte(wc * 32 + fr, fq * 8);
#define PG8_SA(b, h) (((b) * 2 + (h)) * HTB)
#define PG8_SB(b, h) ((4 + (b) * 2 + (h)) * HTB)
#define PG8_STAGE(bufoff, gbase, voff) do { _Pragma("unroll") for (int _i = 0; _i < 2; ++_i) \
        __builtin_amdgcn_global_load_lds((const unsigned*)((const char*)(gbase) + (voff)[_i]), (PG8_LAS unsigned*)(lds + (bufoff) + ldsw + _i * 8192), 16, 0, 0); } while (0)
#define PG8_LDA(dst, b, h) do { _Pragma("unroll") for (int m = 0; m < 4; ++m) _Pragma("unroll") for (int k = 0; k < 2; ++k) dst[m][k] = *(const PG8_LAS bf16x8*)(lds + PG8_SA(b, h) + aoff + m * 2048 + k * 1024); } while (0)
#define PG8_LDB(dst, b, h) do { _Pragma("unroll") for (int n = 0; n < 2; ++n) _Pragma("unroll") for (int k = 0; k < 2; ++k) dst[n][k] = *(const PG8_LAS bf16x8*)(lds + PG8_SB(b, h) + boff + n * 2048 + k * 1024); } while (0)
#define PG8_MMA(ai, bj, At, Bt) do { __builtin_amdgcn_s_setprio(1); _Pragma("unroll") for (int m = 0; m < 4; ++m) _Pragma("unroll") for (int n = 0; n < 2; ++n) _Pragma("unroll") for (int k = 0; k < 2; ++k) \
        acc[ai][bj][m][n] = __builtin_amdgcn_mfma_f32_16x16x32_bf16(Bt[n][k], At[m][k], acc[ai][bj][m][n], 0, 0, 0); __builtin_amdgcn_s_setprio(0); } while (0)
#define PG8_WAIT_V(n) asm volatile("s_waitcnt vmcnt(" #n ")" ::: "memory")
#define PG8_WAIT_L(n) asm volatile("s_waitcnt lgkmcnt(" #n ")" ::: "memory")
#define PG8_BAR __builtin_amdgcn_s_barrier()
#define PG8_SCHED __builtin_amdgcn_sched_barrier(0)
    Unit cur, nxt; int ui = 0;
    if (!S.next(0, cur)) return;
    f32x4 acc[2][2][4][2];
#pragma unroll
    for (int a = 0; a < 2; ++a)
#pragma unroll
        for (int b = 0; b < 2; ++b)
#pragma unroll
            for (int m = 0; m < 4; ++m)
#pragma unroll
                for (int n = 0; n < 2; ++n) acc[a][b][m][n] = (f32x4){0.f, 0.f, 0.f, 0.f};
    bf16x8 At[4][2], B0[2][2], B1[2][2];
    const char* cA = (const char*)(g.A + (size_t)cur.pm * g.sAm + (size_t)cur.pn * g.sAn); const char* cB = (const char*)(g.Bt + (size_t)cur.pn * g.sBn + (size_t)(cur.pm >> 4) * g.sBb);
    S.a_ready(cur);
    if constexpr (SP2) {
        PG8_STAGE(PG8_SB(0, 0), cB, voffB); PG8_STAGE(PG8_SB(0, 1), cB + hstepB, voffB); PG8_STAGE(PG8_SA(0, 0), cA, voffA); PG8_STAGE(PG8_SA(0, 1), cA + hstepA, voffA);
        if (wr == 1) PG8_BAR;
        PG8_WAIT_V(2); PG8_BAR;
        PG8_STAGE(PG8_SB(1, 0), cB + kstep, voffB); PG8_STAGE(PG8_SA(1, 0), cA + kstep, voffA); PG8_STAGE(PG8_SB(1, 1), cB + hstepB + kstep, voffB);
        PG8_WAIT_V(6); PG8_BAR;
    } else {
        PG8_STAGE(PG8_SB(0, 0), cB, voffB); PG8_STAGE(PG8_SA(0, 0), cA, voffA); PG8_STAGE(PG8_SB(0, 1), cB + hstepB, voffB); PG8_STAGE(PG8_SA(0, 1), cA + hstepA, voffA);
        if (wr == 1) PG8_BAR;
        PG8_WAIT_V(4); PG8_BAR;
        PG8_STAGE(PG8_SB(1, 0), cB + kstep, voffB); PG8_STAGE(PG8_SA(1, 0), cA + kstep, voffA); PG8_STAGE(PG8_SB(1, 1), cB + hstepB + kstep, voffB);
        PG8_WAIT_V(6); PG8_BAR;
    }
    for (;;) {
        const bool has_next = S.next(ui + 1, nxt);
        const char* nA = has_next ? (const char*)(g.A + (size_t)nxt.pm * g.sAm + (size_t)nxt.pn * g.sAn) : cA; const char* nB = has_next ? (const char*)(g.Bt + (size_t)nxt.pn * g.sBn + (size_t)(nxt.pm >> 4) * g.sBb) : cB;
#pragma nounroll
        for (int t = 0; t < nt; t += 2) {
            const bool last = (t == nt - 2);
            const char* a1 = cA + (size_t)(t + 1) * kstep;
            const char* a2 = last ? nA : cA + (size_t)(t + 2) * kstep; const char* b2 = last ? nB : cB + (size_t)(t + 2) * kstep;
            const char* a3 = a2 + kstep; const char* b3 = b2 + kstep;
            if (last && has_next) S.a_ready(nxt);
            if constexpr (SP2) {
            PG8_LDB(B0, 0, 0); PG8_LDB(B1, 0, 1); PG8_SCHED; PG8_LDA(At, 0, 0); PG8_STAGE(PG8_SA(1, 1), a1 + hstepA, voffA);
            PG8_WAIT_V(8); PG8_WAIT_L(0); PG8_BAR; PG8_MMA(0, 0, At, B0); PG8_MMA(0, 1, At, B1); PG8_BAR; PG8_SCHED;
            PG8_LDA(At, 0, 1); PG8_STAGE(PG8_SB(0, 0), b2, voffB); PG8_STAGE(PG8_SB(0, 1), b2 + hstepB, voffB); PG8_STAGE(PG8_SA(0, 0), a2, voffA);
            PG8_WAIT_V(8); PG8_WAIT_L(0); PG8_BAR; PG8_MMA(1, 0, At, B0); PG8_MMA(1, 1, At, B1); PG8_BAR; PG8_SCHED;
            PG8_LDB(B0, 1, 0); PG8_LDB(B1, 1, 1); PG8_SCHED; PG8_LDA(At, 1, 0); PG8_STAGE(PG8_SA(0, 1), a2 + hstepA, voffA);
            PG8_WAIT_V(8); PG8_WAIT_L(0); PG8_BAR; PG8_MMA(0, 0, At, B0); PG8_MMA(0, 1, At, B1); PG8_BAR; PG8_SCHED;
            PG8_LDA(At, 1, 1); PG8_STAGE(PG8_SB(1, 0), b3, voffB); PG8_STAGE(PG8_SB(1, 1), b3 + hstepB, voffB); PG8_STAGE(PG8_SA(1, 0), a3, voffA);
            PG8_WAIT_V(8); PG8_WAIT_L(0); PG8_BAR; PG8_MMA(1, 0, At, B0); PG8_MMA(1, 1, At, B1); PG8_BAR; PG8_SCHED;
            } else {
            PG8_LDB(B0, 0, 0); PG8_SCHED; PG8_LDA(At, 0, 0); PG8_STAGE(PG8_SA(1, 1), a1 + hstepA, voffA);
            PG8_WAIT_L(8); PG8_BAR; PG8_WAIT_L(0); PG8_MMA(0, 0, At, B0); PG8_BAR; PG8_SCHED;
            PG8_LDB(B1, 0, 1); PG8_STAGE(PG8_SB(0, 0), b2, voffB);
            PG8_BAR; PG8_WAIT_L(0); PG8_MMA(0, 1, At, B1); PG8_BAR;
            PG8_LDA(At, 0, 1); PG8_STAGE(PG8_SA(0, 0), a2, voffA);
            PG8_BAR; PG8_WAIT_L(0); PG8_MMA(1, 0, At, B0); PG8_BAR; PG8_SCHED;
            PG8_STAGE(PG8_SB(0, 1), b2 + hstepB, voffB);
            PG8_WAIT_V(6); PG8_BAR; PG8_MMA(1, 1, At, B1); PG8_BAR;
            PG8_LDB(B0, 1, 0); PG8_SCHED; PG8_LDA(At, 1, 0); PG8_STAGE(PG8_SA(0, 1), a2 + hstepA, voffA);
            PG8_WAIT_L(8); PG8_BAR; PG8_WAIT_L(0); PG8_MMA(0, 0, At, B0); PG8_BAR; PG8_SCHED;
            PG8_LDB(B1, 1, 1); PG8_STAGE(PG8_SB(1, 0), b3, voffB);
            PG8_BAR; PG8_WAIT_L(0); PG8_MMA(0, 1, At, B1); PG8_BAR;
            PG8_LDA(At, 1, 1); PG8_STAGE(PG8_SA(1, 0), a3, voffA);
            PG8_BAR; PG8_WAIT_L(0); PG8_MMA(1, 0, At, B0); PG8_BAR; PG8_SCHED;
            PG8_STAGE(PG8_SB(1, 1), b3 + hstepB, voffB);
            PG8_WAIT_V(6); PG8_BAR; PG8_MMA(1, 1, At, B1); PG8_BAR;
            }
        }
        if constexpr (ALIGN_EPI) { if (wr == 0) PG8_BAR; }
        E(acc, cur, wr, wc, fr, fq); S.done(cur);
        if (!has_next) break;
#pragma unroll
        for (int a = 0; a < 2; ++a)
#pragma unroll
            for (int b = 0; b < 2; ++b)
#pragma unroll
                for (int m = 0; m < 4; ++m)
#pragma unroll
                    for (int n = 0; n < 2; ++n) acc[a][b][m][n] = (f32x4){0.f, 0.f, 0.f, 0.f};
        cur = nxt; cA = nA; cB = nB; ++ui;
        if constexpr (ALIGN_EPI) { if (wr == 1) PG8_BAR; }
    }
    PG8_WAIT_V(0);
    if constexpr (!ALIGN_EPI) { if (wr == 0) PG8_BAR; }
    PG8_BAR;
#undef PG8_SA
#undef PG8_SB
#undef PG8_STAGE
#undef PG8_LDA
#undef PG8_LDB
#undef PG8_MMA
#undef PG8_WAIT_V
#undef PG8_WAIT_L
#undef PG8_BAR
#undef PG8_SCHED
}
}
#include <hip/hip_bf16.h>
#include <cmath>
namespace attn_body {
using bf16=__hip_bfloat16;
using bf16x8=__attribute__((ext_vector_type(8)))short;
using s16x4=__attribute__((ext_vector_type(4)))short;
using f32x16=__attribute__((ext_vector_type(16)))float;
using u32x4=__attribute__((ext_vector_type(4)))unsigned;
constexpr int BATCH=8,NHEAD=16,SEQ=4096,D=64,DM=NHEAD*D;
constexpr int NW=8,QBLK=32,QB=QBLK*NW,KVBLK=64,NQB=SEQ/QB;
constexpr int ATTN_PITCH=DM, ATTN_UNIT_ROWS=QB;
__device__ __forceinline__ int crow(int r,int hi){return (r&3)+8*(r>>2)+4*hi;}
#define SBAR() __builtin_amdgcn_sched_barrier(0)
__device__ __forceinline__ void cmask(f32x16&p0,f32x16&p1,int jb,int qrel,int hi){
  const float NEG=-INFINITY; int kb=64*jb+4*hi;
  #pragma unroll
  for(int r=0;r<16;++r){int kv=kb+(r&3)+8*(r>>2); if(kv>qrel)p0[r]=NEG; if(kv+32>qrel)p1[r]=NEG;}
}

constexpr int NSLOT=3, SLOTB=8192;
constexpr int LDS_K=0, LDS_V=NSLOT*SLOTB, LDS_WS=2*NSLOT*SLOTB, LDS_OST=LDS_WS+NW*64*4, LDS_BYTES=LDS_OST+NW*4096;
constexpr float C2=0.125f*1.4426950408889634f;
__device__ __forceinline__ void glds16(const void*gsrc,unsigned lds_dst){unsigned keep;
  asm volatile("s_mov_b32 %0, m0\n\ts_mov_b32 m0, %2\n\ts_nop 0\n\tglobal_load_lds_dwordx4 %1, off\n\ts_mov_b32 m0, %0":"=&s"(keep):"v"(gsrc),"s"(lds_dst):"memory");}
__device__ __forceinline__ float max3f(float a,float b,float c){float r;asm("v_max3_f32 %0, %1, %2, %3":"=v"(r):"v"(a),"v"(b),"v"(c));return r;}
__device__ __forceinline__ float max2f(float a,float b){float r;asm("v_max_f32_e32 %0, %1, %2":"=v"(r):"v"(a),"v"(b));return r;}
__device__ __forceinline__ float fadd_s(float a,float b){float r;asm("v_add_f32_e32 %0, %1, %2":"=v"(r):"v"(a),"v"(b));return r;}
__device__ __forceinline__ float fsub_s(float a,float b){float r;asm("v_sub_f32_e32 %0, %1, %2":"=v"(r):"v"(a),"v"(b));return r;}
typedef float f32x2_t __attribute__((ext_vector_type(2))); typedef __bf16 bf16x2_t __attribute__((ext_vector_type(2)));
__device__ __forceinline__ unsigned cvtpk_s(float lo,float hi){f32x2_t v={lo,hi};bf16x2_t b=__builtin_convertvector(v,bf16x2_t);return __builtin_bit_cast(unsigned,b);}
#define WAIT_BAR(N) asm volatile("s_waitcnt vmcnt(" #N ") lgkmcnt(0)\n\ts_barrier":::"memory")

__device__ __forceinline__ void qkt(f32x16&p0,f32x16&p1,const char*Kslot,const bf16x8*qr,const f32x16&negm,int r32,int hi){
  const char*kb=Kslot+hi*1024+r32*16;
  #pragma unroll
  for(int d0=0;d0<4;++d0){
    const bf16x8 b0=*reinterpret_cast<const bf16x8*>(kb+d0*2048);
    const bf16x8 b1=*reinterpret_cast<const bf16x8*>(kb+d0*2048+512);
    if(d0==0){p0=__builtin_amdgcn_mfma_f32_32x32x16_bf16(b0,qr[0],negm,0,0,0);p1=__builtin_amdgcn_mfma_f32_32x32x16_bf16(b1,qr[0],negm,0,0,0);}
    else{p0=__builtin_amdgcn_mfma_f32_32x32x16_bf16(b0,qr[d0],p0,0,0,0);p1=__builtin_amdgcn_mfma_f32_32x32x16_bf16(b1,qr[d0],p1,0,0,0);}}
}
typedef __attribute__((address_space(3))) const char* lds_cptr;
typedef short v4i16_t __attribute__((ext_vector_type(4)));
__device__ __forceinline__ void kload8(bf16x8*kf,lds_cptr kp){
  kf[0]=*(const __attribute__((address_space(3))) bf16x8*)(kp);      kf[1]=*(const __attribute__((address_space(3))) bf16x8*)(kp+512);
  kf[2]=*(const __attribute__((address_space(3))) bf16x8*)(kp+2048); kf[3]=*(const __attribute__((address_space(3))) bf16x8*)(kp+2560);
  kf[4]=*(const __attribute__((address_space(3))) bf16x8*)(kp+4096); kf[5]=*(const __attribute__((address_space(3))) bf16x8*)(kp+4608);
  kf[6]=*(const __attribute__((address_space(3))) bf16x8*)(kp+6144); kf[7]=*(const __attribute__((address_space(3))) bf16x8*)(kp+6656);
}
__device__ __forceinline__ void kload2(bf16x8*kf,lds_cptr kp,int j){ kf[2*j]=*(const __attribute__((address_space(3))) bf16x8*)(kp+j*2048); kf[2*j+1]=*(const __attribute__((address_space(3))) bf16x8*)(kp+j*2048+512); }
__device__ __forceinline__ s16x4 vtr(lds_cptr p){ return __builtin_bit_cast(s16x4,__builtin_amdgcn_ds_read_tr16_b64_v4i16((__attribute__((address_space(3))) v4i16_t*)p)); }
__device__ __forceinline__ float rowmax(const f32x16&p0,const f32x16&p1){
  float a=max3f(p0[0],p0[1],p1[0]),b=max3f(p0[2],p0[3],p1[1]);a=max3f(a,p1[2],p1[3]);
  #pragma unroll
  for(int r=4;r<16;r+=4){a=max3f(a,p0[r],p0[r+1]);b=max3f(b,p0[r+2],p0[r+3]);a=max3f(a,p1[r],p1[r+1]);b=max3f(b,p1[r+2],p1[r+3]);}
  const float m=max2f(a,b);
  auto rr=__builtin_amdgcn_permlane32_swap(__float_as_uint(m),__float_as_uint(m),false,false);
  return max2f(__uint_as_float(rr[0]),__uint_as_float(rr[1]));
}
__device__ __forceinline__ void pv(f32x16*o,int vb,bf16x8 pa0,bf16x8 pa1,bf16x8 pa2,bf16x8 pa3){
  #pragma unroll
  for(int d0=0;d0<2;++d0){s16x4 lo[4],hi[4];
    #pragma unroll
    for(int ks=0;ks<4;++ks){
      asm volatile("ds_read_b64_tr_b16 %0,%1 offset:%c2":"=&v"(lo[ks]):"v"(vb),"i"(d0*4096+ks*1024):"memory");
      asm volatile("ds_read_b64_tr_b16 %0,%1 offset:%c2":"=&v"(hi[ks]):"v"(vb),"i"(d0*4096+ks*1024+512):"memory");}
    asm volatile("s_waitcnt lgkmcnt(0)":::"memory");SBAR();
    #define PK(k) (bf16x8){lo[k][0],lo[k][1],lo[k][2],lo[k][3],hi[k][0],hi[k][1],hi[k][2],hi[k][3]}
    o[d0]=__builtin_amdgcn_mfma_f32_32x32x16_bf16(pa0,PK(0),o[d0],0,0,0);
    o[d0]=__builtin_amdgcn_mfma_f32_32x32x16_bf16(pa1,PK(1),o[d0],0,0,0);
    o[d0]=__builtin_amdgcn_mfma_f32_32x32x16_bf16(pa2,PK(2),o[d0],0,0,0);
    o[d0]=__builtin_amdgcn_mfma_f32_32x32x16_bf16(pa3,PK(3),o[d0],0,0,0);
    #undef PK
  }
}

#ifndef ATTN_STORE16
#define ATTN_STORE16(p,v) (*(u32x4*)(p)=(v))
#endif
template<int THRL> __device__ __forceinline__ void attn_unit(int b,int h,int hv,int qb,const bf16*Q,const bf16*__restrict__ K,const bf16*__restrict__ V,bf16*O,char*shm){
  int tid_=threadIdx.x; asm volatile("":"+v"(tid_));
  const int tid=tid_,lane=tid&63,r32=lane&31,hi=lane>>5; const int wid=__builtin_amdgcn_readfirstlane(tid>>6);
  const long rowbase=(long)b*SEQ; const int q0=qb*QB;
  const bf16*Qw=Q+(rowbase+q0+wid*QBLK)*DM+h*D;
  const bf16*Kh=K+rowbase*DM+h*D,*Vh=V+rowbase*DM+hv*D;
  const unsigned lds0=(unsigned)(uintptr_t)shm;
  float*wsf=(float*)(shm+LDS_WS)+wid*64;
  const bf16*ksrc=Kh+(long)lane*DM+wid*8;
  const bf16*vsrc=Vh+(long)(16*(wid&3)+(lane>>2))*DM+(wid>>2)*32+(lane&3)*8;
  const unsigned kdst=lds0+LDS_K+wid*1024, vdst=lds0+LDS_V+wid*1024;
  #define DMA_K(t,slot) glds16(ksrc+(long)(t)*KVBLK*DM,(unsigned)__builtin_amdgcn_readfirstlane(kdst+(slot)))
  #define DMA_V(t,slot) glds16(vsrc+(long)(t)*KVBLK*DM,(unsigned)__builtin_amdgcn_readfirstlane(vdst+(slot)))
  const int vb0=(int)(lds0+LDS_V)+((lane>>4)&1)*32+(lane&3)*8+(4*hi+((lane&15)>>2))*64;
  const char*Kbase=shm+LDS_K; bf16x8 kf[8];
  const lds_cptr shm3=(lds_cptr)shm; const lds_cptr kp0=shm3+LDS_K+hi*1024+r32*16; const lds_cptr vp0=shm3+LDS_V+((lane>>4)&1)*32+(lane&3)*8+(4*hi+((lane&15)>>2))*64;
  const int NT=(q0+QB)/KVBLK;
  DMA_K(0,0);DMA_V(0,0);DMA_K(1,SLOTB);
  bf16x8 qr[4];
  #pragma unroll
  for(int d0=0;d0<4;++d0)qr[d0]=*reinterpret_cast<const bf16x8*>(&Qw[(long)r32*DM+d0*16+hi*8]);
  float mhat=0.f,l_reg=0.f;f32x16 o[2];o[0]=f32x16{};o[1]=f32x16{};f32x16 negm=f32x16{};asm volatile("":"+v"(negm));
  const int qrel=wid*QBLK+r32;
  #define CMASK(P0,P1,t) do{int jb_=(t)-(NT-4); if(jb_>=0)cmask(P0,P1,jb_,qrel,hi);}while(0)
  bool resc=false;
  #define START(P0,P1) do{ const float rm=rowmax(P0,P1); resc=false; \
    { const float dl=rm; mhat=fadd_s(mhat,dl); \
      _Pragma("unroll") for(int r=0;r<16;++r){P0[r]=fsub_s(P0[r],dl);P1[r]=fsub_s(P1[r],dl);} \
      _Pragma("unroll") for(int r=0;r<16;++r)negm[r]=-mhat; asm volatile("":"+v"(negm)); } \
    _Pragma("unroll") for(int r=0;r<16;++r)P0[r]=__builtin_amdgcn_exp2f(P0[r]); }while(0)
  #define RESC() do{ if(resc){ asm volatile("s_waitcnt lgkmcnt(0)":::"memory"); \
      _Pragma("unroll") for(int d_=0;d_<2;++d_) _Pragma("unroll") for(int r=0;r<16;++r)o[d_][r]*=wsf[crow(r,hi)]; } }while(0)
  f32x16 pA0,pA1,pB0,pB1;
  int sl_prev=0,sl_cur=0,sl_next=SLOTB;
  #define ROT() do{sl_prev=sl_cur;sl_cur=sl_next;sl_next=(sl_next==(NSLOT-1)*SLOTB)?0:sl_next+SLOTB;}while(0)
  DMA_K(2,2*SLOTB);
  WAIT_BAR(3);
  qkt(pA0,pA1,Kbase,qr,negm,r32,hi);asm volatile("s_nop 15\n\ts_nop 7":"+v"(pA0),"+v"(pA1));CMASK(pA0,pA1,0);
  START(pA0,pA1);
  _Pragma("unroll") for(int r=0;r<16;++r)pA1[r]=__builtin_amdgcn_exp2f(pA1[r]);
  WAIT_BAR(0);
  DMA_K(3,0);DMA_V(1,SLOTB);
  ROT();
  kload8(kf,kp0+sl_cur);
  WAIT_BAR(2);
  s16x4 vlo[8],vhi[8]; u32x4 pw0,pw1,pw2,pw3;
  #define PKW(P,B) cvtpk_s(P[B],P[B+1])
  #define PAF(k) __builtin_bit_cast(bf16x8,pw##k)
  #define VFR(i) (bf16x8){vlo[i][0],vlo[i][1],vlo[i][2],vlo[i][3],vhi[i][0],vhi[i][1],vhi[i][2],vhi[i][3]}
  #define PIN(x) asm volatile("":"+v"(x))
  #define MX3(a,b,c) __builtin_fmaxf(__builtin_fmaxf((a),(b)),(c))
  #define GAPA(MF,A0,A1,A2,A3,W0,W1,PW) do{ MF; sacc+=A0; sacc+=A1; sacc+=A2; sacc+=A3; PIN(sacc); W0; W1; PIN(PW); SBAR(); }while(0)
  #define EX(v) __builtin_amdgcn_exp2f(v)
  #define GAPB(MF,X,B) do{ MF; X[B]=EX(X[B]); X[B+1]=EX(X[B+1]); X[B+2]=EX(X[B+2]); X[B+3]=EX(X[B+3]); PIN(X); SBAR(); }while(0)
  #define VRD(i) do{ vlo[i]=vtr(vp_+(((i)>>2)*4096+((i)&3)*1024)); vhi[i]=vtr(vp_+(((i)>>2)*4096+((i)&3)*1024+512)); }while(0)
  #define KRD(G,j) do{ if(G){ kload2(kf,kp0+sl_next,j); SBAR(); } }while(0)
  #define STEP(C0,C1,P0,P1,t,GK,GV,GL) do{ SBAR(); \
    const lds_cptr vp_=vp0+sl_prev; \
    VRD(0); SBAR(); float sacc=(P0[0]+P0[1]); \
    GAPA(C0=__builtin_amdgcn_mfma_f32_32x32x16_bf16(kf[0],qr[0],negm,0,0,0), P0[2],P0[3],P0[4],P0[5],     pw0[0]=PKW(P0,0), pw0[1]=PKW(P0,2), pw0); \
    VRD(4); SBAR(); GAPA(C1=__builtin_amdgcn_mfma_f32_32x32x16_bf16(kf[1],qr[0],negm,0,0,0), P0[6],P0[7],P0[8],P0[9],     pw0[2]=PKW(P0,4), pw0[3]=PKW(P0,6), pw0); \
    VRD(1); SBAR(); GAPA(C0=__builtin_amdgcn_mfma_f32_32x32x16_bf16(kf[2],qr[1],C0,0,0,0),   P0[10],P0[11],P0[12],P0[13], pw1[0]=PKW(P0,8), pw1[1]=PKW(P0,10), pw1); \
    VRD(5); SBAR(); GAPA(C1=__builtin_amdgcn_mfma_f32_32x32x16_bf16(kf[3],qr[1],C1,0,0,0),   P0[14],P0[15],P1[0],P1[1],   pw1[2]=PKW(P0,12),pw1[3]=PKW(P0,14), pw1); \
    VRD(2); SBAR(); GAPA(C0=__builtin_amdgcn_mfma_f32_32x32x16_bf16(kf[4],qr[2],C0,0,0,0),   P1[2],P1[3],P1[4],P1[5],     pw2[0]=PKW(P1,0), pw2[1]=PKW(P1,2), pw2); \
    VRD(6); SBAR(); GAPA(C1=__builtin_amdgcn_mfma_f32_32x32x16_bf16(kf[5],qr[2],C1,0,0,0),   P1[6],P1[7],P1[8],P1[9],     pw2[2]=PKW(P1,4), pw2[3]=PKW(P1,6), pw2); \
    VRD(3); SBAR(); GAPA(C0=__builtin_amdgcn_mfma_f32_32x32x16_bf16(kf[6],qr[3],C0,0,0,0),   P1[10],P1[11],P1[12],P1[13], pw3[0]=PKW(P1,8), pw3[1]=PKW(P1,10), pw3); \
    VRD(7); SBAR(); GAPA(C1=__builtin_amdgcn_mfma_f32_32x32x16_bf16(kf[7],qr[3],C1,0,0,0),   P1[14],P1[15],0.f,0.f,       pw3[2]=PKW(P1,12),pw3[3]=PKW(P1,14), pw3); \
    l_reg+=sacc; \
    if(GK){DMA_K((t)+3,sl_cur);} if(GV){DMA_V((t)+1,sl_next);} \
    CMASK(C0,C1,t); \
    { float a=MX3(C0[0],C0[1],C1[0]),b=MX3(C0[2],C0[3],C1[1]); a=MX3(a,C1[2],C1[3]); \
      _Pragma("unroll") for(int r=4;r<16;r+=4){a=MX3(a,C0[r],C0[r+1]);b=MX3(b,C0[r+2],C0[r+3]);a=MX3(a,C1[r],C1[r+1]);b=MX3(b,C1[r+2],C1[r+3]);} \
      float rm=__builtin_fmaxf(a,b); { auto rr=__builtin_amdgcn_permlane32_swap(__float_as_uint(rm),__float_as_uint(rm),false,false); rm=__builtin_fmaxf(__uint_as_float(rr[0]),__uint_as_float(rr[1])); } \
      resc=false; \
      if(__builtin_expect(__any(rm>(float)THRL),0)){ const float dl=__builtin_fmaxf(rm,0.f); mhat+=dl; \
        _Pragma("unroll") for(int r=0;r<16;++r){C0[r]-=dl;C1[r]-=dl;} \
        _Pragma("unroll") for(int r=0;r<16;++r)negm[r]=-mhat; asm volatile("":"+v"(negm)); \
        const float f=__builtin_amdgcn_exp2f(-dl); l_reg*=f; if(hi==0)wsf[r32]=f; resc=true; } } \
    SBAR(); \
    GAPB(o[0]=__builtin_amdgcn_mfma_f32_32x32x16_bf16(PAF(0),VFR(0),o[0],0,0,0), C0,0); \
    GAPB(o[1]=__builtin_amdgcn_mfma_f32_32x32x16_bf16(PAF(0),VFR(4),o[1],0,0,0), C0,4); \
    KRD(GL,0); GAPB(o[0]=__builtin_amdgcn_mfma_f32_32x32x16_bf16(PAF(1),VFR(1),o[0],0,0,0), C0,8); \
    KRD(GL,1); GAPB(o[1]=__builtin_amdgcn_mfma_f32_32x32x16_bf16(PAF(1),VFR(5),o[1],0,0,0), C0,12); \
    KRD(GL,2); GAPB(o[0]=__builtin_amdgcn_mfma_f32_32x32x16_bf16(PAF(2),VFR(2),o[0],0,0,0), C1,0); \
    KRD(GL,3); GAPB(o[1]=__builtin_amdgcn_mfma_f32_32x32x16_bf16(PAF(2),VFR(6),o[1],0,0,0), C1,4); \
    GAPB(o[0]=__builtin_amdgcn_mfma_f32_32x32x16_bf16(PAF(3),VFR(3),o[0],0,0,0), C1,8); \
    GAPB(o[1]=__builtin_amdgcn_mfma_f32_32x32x16_bf16(PAF(3),VFR(7),o[1],0,0,0), C1,12); \
    }while(0)
  int t=1;
  #undef CMASK
  #define CMASK(P0,P1,t) do{}while(0)
  for(;t+5<NT;t+=2){
    STEP(pB0,pB1,pA0,pA1,t,true,true,true);     WAIT_BAR(2); RESC(); ROT();
    STEP(pA0,pA1,pB0,pB1,t+1,true,true,true);   WAIT_BAR(2); RESC(); ROT();
  }
  #undef CMASK
  #define CMASK(P0,P1,t) do{int jb_=(t)-(NT-4); if(jb_>=0)cmask(P0,P1,jb_,qrel,hi);}while(0)
  #define ENDW(tt) do{ if((tt)+3<NT){WAIT_BAR(2);} else if((tt)+2<NT){WAIT_BAR(1);} else {WAIT_BAR(0);} }while(0)
  for(;t+1<NT;t+=2){
    STEP(pB0,pB1,pA0,pA1,t,(t+3<NT),(t+1<NT),(t+1<NT));       ENDW(t);   RESC(); ROT();
    STEP(pA0,pA1,pB0,pB1,t+1,(t+4<NT),(t+2<NT),(t+2<NT));     ENDW(t+1); RESC(); ROT();
  }
  STEP(pB0,pB1,pA0,pA1,NT-1,false,false,false); RESC();
  { float sacc=pB0[0]+pB0[1]; _Pragma("unroll") for(int r=2;r<16;++r)sacc+=pB0[r]; _Pragma("unroll") for(int r=0;r<16;++r)sacc+=pB1[r]; l_reg+=sacc;
    pw0=(u32x4){PKW(pB0,0),PKW(pB0,2),PKW(pB0,4),PKW(pB0,6)};pw1=(u32x4){PKW(pB0,8),PKW(pB0,10),PKW(pB0,12),PKW(pB0,14)};pw2=(u32x4){PKW(pB1,0),PKW(pB1,2),PKW(pB1,4),PKW(pB1,6)};pw3=(u32x4){PKW(pB1,8),PKW(pB1,10),PKW(pB1,12),PKW(pB1,14)};
    SBAR(); pv(o,vb0+sl_cur,PAF(0),PAF(1),PAF(2),PAF(3)); }
  #undef PKW
  #undef PAF
  #undef VFR
  #undef PIN
  #undef MX3
  #undef GAPA
  #undef GAPB
  #undef EX
  #undef VRD
  #undef KRD
  #undef STEP
  #undef ENDW
  {auto rr=__builtin_amdgcn_permlane32_swap(__float_as_uint(l_reg),__float_as_uint(l_reg),false,false);l_reg=__uint_as_float(rr[0])+__uint_as_float(rr[1]);}
  if(hi==0)wsf[32+r32]=l_reg;asm volatile("s_waitcnt lgkmcnt(0)":::"memory");
  float rli[16];
  #pragma unroll
  for(int r=0;r<16;++r)rli[r]=__builtin_amdgcn_rcpf(wsf[32+crow(r,hi)]);
  bf16*Ow=O+(rowbase+q0+wid*QBLK)*DM+hv*D;
  { bf16*stg=(bf16*)(shm+LDS_OST)+wid*2048;
    #pragma unroll
    for(int r=0;r<16;++r){const int orow=crow(r,hi);
      #pragma unroll
      for(int d0=0;d0<2;++d0)stg[orow*64+d0*32+r32]=__float2bfloat16(o[d0][r]*rli[r]);}
    asm volatile("s_waitcnt lgkmcnt(0)":::"memory");
    #pragma unroll
    for(int i=0;i<4;++i){const int row=i*8+(lane>>3),ch=lane&7; const u32x4 v=*(const u32x4*)(stg+row*64+ch*8); ATTN_STORE16(Ow+(long)row*DM+ch*8,v);} }
  asm volatile("s_waitcnt lgkmcnt(0)\n\ts_barrier":::"memory");
  #undef DMA_K
  #undef DMA_V
  #undef CMASK
  #undef START
  #undef RESC
  #undef ROT
}
constexpr int ATTN_LDS_BYTES=LDS_BYTES;
struct AttnTensors { const bf16* Q; const bf16* K; const bf16* V; bf16* O0; bf16* O1; };
struct AttnUnit { int combo; int qb; };
struct AttnOrder {
  int vcu, G;
  __device__ __forceinline__ bool next(int i,AttnUnit&u)const{ const int L=i*G+vcu; if(L>=BATCH*8*2*2*NQB)return false; u.combo=L&255; u.qb=NQB-1-(L>>8); return true; }
};
template<int THRL=8> __device__ __forceinline__ void attn_phase(char*lds,const AttnTensors&T,const AttnOrder&S){
  AttnUnit u;
  for(int i=0;S.next(i,u);++i){
    const int b=u.combo>>5, h=(u.combo>>2)&7, c=(u.combo>>1)&1, vh=u.combo&1;
    attn_unit<THRL>(b,2*h+c,2*h+vh,u.qb,T.Q,T.K,T.V,c?T.O1:T.O0,lds);
  }
}
#undef SBAR
#undef WAIT_BAR
}

constexpr int NWAVES = 8;
constexpr int BATCH = 8, T = 4096, D = 1024, FF = 4096, MEMLEN = 256;
constexpr int M = BATCH * T;
constexpr int MM = BATCH * MEMLEN;
constexpr int NPROJ1 = 7 * D;
constexpr int PROJW = 10 * D;
constexpr size_t MiB = 1u << 20;
constexpr size_t WS_CTL = 0, CTL_ZERO_BYTES = 64 * 1024;
constexpr size_t WS_WIN = 1 * MiB;
constexpr size_t WS_WA = 21 * MiB, WS_WC = 23 * MiB, WS_WM = 25 * MiB, WS_WO = 27 * MiB;
constexpr size_t WS_WKV = 29 * MiB;
constexpr size_t WS_W1 = 33 * MiB;
constexpr size_t WS_W2 = 41 * MiB;
constexpr size_t WS_MEMN = 49 * MiB;
constexpr size_t WS_KP = 53 * MiB;
constexpr size_t WS_VT = 57 * MiB;
constexpr size_t REG = 64 * MiB;
constexpr size_t WS_R1 = 1 * REG;
constexpr size_t WS_R2 = 2 * REG;
constexpr size_t WS_R3 = 3 * REG;
constexpr size_t WS_R4 = 4 * REG;
constexpr size_t WS_R5 = 5 * REG;
constexpr size_t WS_R6 = 6 * REG;
constexpr size_t WS_R7 = 7 * REG;
constexpr size_t WS_END = 8 * REG;
constexpr int CW_BAR = 4096;

constexpr int RING_OFF = 0, RING_BYTES = 131072;
constexpr int LDSCTL_OFF = RING_BYTES, MISC_OFF = LDSCTL_OFF + 320;
constexpr int XCH_OFF = RING_BYTES + 1024;
constexpr int LDS_BYTES = 147456;
static_assert(XCH_OFF + 8192 <= LDS_BYTES, "LDS map");
#define GAS __attribute__((address_space(1)))
#define LAS __attribute__((address_space(3)))
typedef unsigned short bf16;
typedef unsigned v4u __attribute__((ext_vector_type(4)));
typedef float f32x4 __attribute__((ext_vector_type(4)));
typedef short bf16x8 __attribute__((ext_vector_type(8)));
typedef GAS unsigned gu32;
typedef GAS unsigned long long gu64;
#define RLX_AGENT __ATOMIC_RELAXED, __HIP_MEMORY_SCOPE_AGENT
#define LDS_WAIT() asm volatile("s_waitcnt lgkmcnt(0)" ::: "memory")
#define VM_WAIT() asm volatile("s_waitcnt vmcnt(0)" ::: "memory")
__device__ __forceinline__ unsigned long long rt() { return __builtin_amdgcn_s_memrealtime(); }
__device__ __forceinline__ unsigned f2bf(float f) { unsigned u = __builtin_bit_cast(unsigned, f); return (u + 0x7fffu + ((u >> 16) & 1u)) >> 16; }
__device__ __forceinline__ unsigned pk2(float lo, float hi) { return f2bf(lo) | (f2bf(hi) << 16); }

#define XB_TMO      128
#define XB_XCNT(j)  (256  + 64 * (j))
#define XB_XSUB(j)  (1280 + 64 * (j))
#define XB_XGEN(j)  (2304 + 64 * (j))
#define XB_TOP      3328
#define XB_TOPGEN   3392
#define XCD_BAR_WORDS 3456
#define XB_SPIN_CAP (1u << 18)

__device__ __forceinline__ unsigned xb_ld(unsigned* p)              { return __hip_atomic_load(p, __ATOMIC_RELAXED, __HIP_MEMORY_SCOPE_AGENT); }
__device__ __forceinline__ unsigned xb_add(unsigned* p, unsigned v) { return __hip_atomic_fetch_add(p, v, __ATOMIC_RELAXED, __HIP_MEMORY_SCOPE_AGENT); }
__device__ __forceinline__ unsigned xb_xcc_id() { return (unsigned)__builtin_amdgcn_s_getreg((3 << 11) | 20) & 0xFu; }
#define XB_SPIN(cond, bar) do { unsigned _sp = 0; while (cond) { __builtin_amdgcn_s_sleep(1); \
    if ((++_sp & 255u) == 0u) { if (xb_ld(&(bar)[XB_TMO])) break; if (_sp > XB_SPIN_CAP) { atomicAdd(&(bar)[XB_TMO], 1u); break; } } } } while (0)

struct XcdBarrier {
    unsigned* bar; unsigned x;
    volatile LAS unsigned* st;
};

__device__ __forceinline__ XcdBarrier xcd_barrier_post(unsigned* bar, volatile LAS unsigned* st) {
    XcdBarrier b; b.bar = bar; b.x = xb_xcc_id(); b.st = st;
    if (threadIdx.x == 0) (void)xb_add(&bar[XB_XCNT(b.x)], 1u);
    return b;
}
__device__ __forceinline__ void xcd_barrier_complete(unsigned* bar, unsigned x, unsigned& nloc, unsigned& nx) {
    const unsigned G = gridDim.x * gridDim.y * gridDim.z;
    unsigned sum, cnt, mine, sp = 0u;
    for (;;) {
        sum = 0u; cnt = 0u; mine = 0u;
#pragma unroll
        for (unsigned j = 0; j < 16; ++j) { const unsigned c = xb_ld(&bar[XB_XCNT(j)]); sum += c; cnt += (c > 0u) ? 1u : 0u; mine = (j == x) ? c : mine; }
        if (sum == G) break;
        __builtin_amdgcn_s_sleep(1);
        if ((++sp & 255u) == 0u) { if (xb_ld(&bar[XB_TMO])) break; if (sp > XB_SPIN_CAP) { atomicAdd(&bar[XB_TMO], 1u); break; } }
    }
    nloc = mine > 0u ? mine : 1u; nx = cnt > 0u ? cnt : 1u;
}

__device__ __forceinline__ void xcd_barrier(const XcdBarrier& b) {
    asm volatile("s_waitcnt vmcnt(0)" ::: "memory");
    __syncthreads();
    if (threadIdx.x == 0) {
        unsigned* bar = b.bar;
        __builtin_amdgcn_s_waitcnt(0);
        unsigned nloc = b.st[0], nx = b.st[1];
        if (nloc == 0u) { xcd_barrier_complete(bar, b.x, nloc, nx); b.st[0] = nloc; b.st[1] = nx; }
        const unsigned old = xb_add(&bar[XB_XSUB(b.x)], 1u);
        const unsigned gen = old / nloc;
        if (old + 1u == (gen + 1u) * nloc) {
            __builtin_amdgcn_fence(__ATOMIC_RELEASE, "agent");
            asm volatile("s_waitcnt vmcnt(0)" ::: "memory");
            const unsigned og = xb_add(&bar[XB_TOP], 1u);
            const unsigned tg = og / nx;
            if (og + 1u == (tg + 1u) * nx) xb_add(&bar[XB_TOPGEN], 1u);
            else XB_SPIN(xb_ld(&bar[XB_TOPGEN]) == tg, bar);
            __builtin_amdgcn_fence(__ATOMIC_ACQUIRE, "agent");
            xb_add(&bar[XB_XGEN(b.x)], 1u);
            asm volatile("s_waitcnt vmcnt(0)" ::: "memory");
        } else {
            XB_SPIN(xb_ld(&bar[XB_XGEN(b.x)]) == gen, bar);
            __builtin_amdgcn_fence(__ATOMIC_ACQUIRE, "agent");
            asm volatile("s_waitcnt vmcnt(0)" ::: "memory");
        }
    }
    __syncthreads();
}
struct Frame {
    LAS unsigned char* lds;
    volatile LAS unsigned* MISC;
    gu32* ctl;
    int wave;
    int vcu, G;
};
__device__ __forceinline__ float wave_sum(float v) {
#pragma unroll
    for (int o = 1; o < 64; o <<= 1) v += __shfl_xor(v, o);
    return v;
}
__device__ __forceinline__ void p0_transpose_item(const float* W, int K, int N, bf16* WT, int row_off, LAS float* scr, int item, int lane) {
    const int nblk = N / 32, kb = item / nblk, nb = item % nblk, k0 = 64 * kb, n0 = 32 * nb;
#pragma unroll 8
    for (int i = 0; i < 32; ++i) { const int kk = 2 * i + (lane >> 5); scr[kk * 33 + (lane & 31)] = W[(size_t)(k0 + kk) * N + n0 + (lane & 31)]; }
    LDS_WAIT(); asm volatile("" ::: "memory");
    const int c = lane & 7;
#pragma unroll
    for (int j = 0; j < 4; ++j) { const int n = (lane >> 3) + 8 * j; const LAS float* s = scr + (8 * c) * 33 + n;
        v4u o; o.x = pk2(s[0 * 33], s[1 * 33]); o.y = pk2(s[2 * 33], s[3 * 33]); o.z = pk2(s[4 * 33], s[5 * 33]); o.w = pk2(s[6 * 33], s[7 * 33]);
        *(GAS v4u*)(WT + (size_t)(row_off + n0 + n) * K + k0 + 8 * c) = o; }
    LDS_WAIT(); asm volatile("" ::: "memory");
}
__device__ __forceinline__ void rms_row_to_bf16(int lane, const float* xrow, const float* g, bf16* orow) {
    const GAS f32x4* xr = (const GAS f32x4*)xrow + lane; const GAS f32x4* gr = (const GAS f32x4*)g + lane;
    f32x4 v[4]; float s = 0.f;
#pragma unroll
    for (int j = 0; j < 4; ++j) { v[j] = xr[64 * j]; s += (v[j].x * v[j].x + v[j].y * v[j].y) + (v[j].z * v[j].z + v[j].w * v[j].w); }
    const float rstd = 1.f / sqrtf(wave_sum(s) * (1.f / D) + 1e-6f);
    GAS unsigned long long* o8 = (GAS unsigned long long*)orow + lane;
#pragma unroll
    for (int j = 0; j < 4; ++j) { const f32x4 gg = gr[64 * j]; o8[64 * j] = (unsigned long long)pk2(v[j].x * rstd * gg.x, v[j].y * rstd * gg.y) | ((unsigned long long)pk2(v[j].z * rstd * gg.z, v[j].w * rstd * gg.w) << 32); }
}
__device__ __forceinline__ void unpack8f(const v4u w, float (&v)[8]) {
    v[0] = __uint_as_float(w.x << 16); v[1] = __uint_as_float(w.x & 0xffff0000u); v[2] = __uint_as_float(w.y << 16); v[3] = __uint_as_float(w.y & 0xffff0000u);
    v[4] = __uint_as_float(w.z << 16); v[5] = __uint_as_float(w.z & 0xffff0000u); v[6] = __uint_as_float(w.w << 16); v[7] = __uint_as_float(w.w & 0xffff0000u); }
__device__ __forceinline__ v4u pack8f(const float (&v)[8]) { v4u o; o.x = pk2(v[0], v[1]); o.y = pk2(v[2], v[3]); o.z = pk2(v[4], v[5]); o.w = pk2(v[6], v[7]); return o; }

struct Args { const float* in[24]; float* out; unsigned char* ws; int ph_lo, ph_hi; };
constexpr int N_PHASES = 10;

typedef const __attribute__((address_space(4))) Args KArgs;
__device__ __forceinline__ KArgs* ka_ptr() { KArgs* p = (KArgs*)__builtin_amdgcn_kernarg_segment_ptr(); asm volatile("" : "+s"(p)); return p; }
#define PHASE_PTRS const KArgs* KA = ka_ptr(); unsigned char* ws = KA->ws; const float* x = KA->in[0]; const float* mem = KA->in[1]; const float* norm_mix_g = KA->in[2]; const float* norm_mem_g = KA->in[3]; const float* w_in = KA->in[4]; const float* b_gate = KA->in[5]; const float* q_norm_g = KA->in[6]; const float* k_norm_g = KA->in[7]; const float* lam_q1 = KA->in[8]; const float* lam_k1 = KA->in[9]; const float* lam_q2 = KA->in[10]; const float* lam_k2 = KA->in[11]; const float* subln_g = KA->in[12]; const float* w_attn_o = KA->in[13]; const float* conv_w = KA->in[14]; const float* w_conv_o = KA->in[15]; const float* w_mem_kv = KA->in[16]; const float* mq_norm_g = KA->in[17]; const float* mk_norm_g = KA->in[18]; const float* w_mem_o = KA->in[19]; const float* w_o = KA->in[20]; const float* norm_mlp_g = KA->in[21]; const float* w_mlp_in = KA->in[22]; const float* w_mlp_out = KA->in[23]; float* out = KA->out; bf16* WinT = (bf16*)(ws + WS_WIN); bf16* WaT = (bf16*)(ws + WS_WA); bf16* WcT = (bf16*)(ws + WS_WC); bf16* WmT = (bf16*)(ws + WS_WM); bf16* WoT = (bf16*)(ws + WS_WO); bf16* WkvT = (bf16*)(ws + WS_WKV); bf16* W1T = (bf16*)(ws + WS_W1); bf16* W2T = (bf16*)(ws + WS_W2); bf16* MEMN = (bf16*)(ws + WS_MEMN); bf16* KP = (bf16*)(ws + WS_KP); bf16* VT = (bf16*)(ws + WS_VT); bf16* R1 = (bf16*)(ws + WS_R1); bf16* R2 = (bf16*)(ws + WS_R2); bf16* R3 = (bf16*)(ws + WS_R3); bf16* R4 = (bf16*)(ws + WS_R4); bf16* R5 = (bf16*)(ws + WS_R5); bf16* R6 = (bf16*)(ws + WS_R6); bf16* R7 = (bf16*)(ws + WS_R7); bf16* D0 = (bf16*)out; bf16* D1 = (bf16*)out + (size_t)M * D;
__global__ void __launch_bounds__(NWAVES * 64, 2) hybrid_fwd(Args args) {
    extern __shared__ __attribute__((aligned(16))) unsigned char lds[];
    Frame F;
    F.lds = (LAS unsigned char*)lds;
    F.MISC = (volatile LAS unsigned*)(F.lds + MISC_OFF);
    F.wave = __builtin_amdgcn_readfirstlane((int)threadIdx.x >> 6);
    F.G = gridDim.x; { const int bx = blockIdx.x; F.vcu = (F.G % 8 == 0) ? (bx % 8) * (F.G / 8) + bx / 8 : bx; }
    F.ctl = (gu32*)(args.ws + WS_CTL);
    for (int u = ((int)threadIdx.x); u < (LDS_BYTES - LDSCTL_OFF) / 4; u += NWAVES * 64) ((LAS unsigned*)(F.lds + LDSCTL_OFF))[u] = 0u;
    __syncthreads();
    const int lo = args.ph_lo, hi = args.ph_hi;
    const bool multi = (hi - lo) > 1;
    XcdBarrier bar; bar.bar = (unsigned*)(F.ctl + CW_BAR); bar.x = 0; bar.st = nullptr;
    if (multi) bar = xcd_barrier_post((unsigned*)(F.ctl + CW_BAR), F.MISC + 8);
#ifndef PH_MASK
#define PH_MASK 0x3ff
#endif
#define IN(k) (((PH_MASK >> (k)) & 1) && lo <= (k) && (k) < hi)
#define BOTH(k) (IN(k) && IN((k) + 1))
#define GRID_BAR() xcd_barrier(bar)
    PG8_LAS float* X0 = (PG8_LAS float*)(F.lds + XCH_OFF); PG8_LAS float* X1 = (PG8_LAS float*)(F.lds + XCH_OFF + 4096);
    const int gw = F.vcu * NWAVES + F.wave, NGW = F.G * NWAVES;
    LAS unsigned char* ring = F.lds + RING_OFF;
    const int cid = (int)blockIdx.x;
    typedef pg8::StaticOrder SO;

    if (IN(0)) { PHASE_PTRS
        LAS float* scr = (LAS float*)(F.lds + RING_OFF + F.wave * 16384);
        constexpr int I_IN = (D / 64) * (PROJW / 32), I_SQ = (D / 64) * (D / 32), I_KV = (D / 64) * (2 * D / 32), I_1 = (D / 64) * (FF / 32), I_2 = (FF / 64) * (D / 32);
        constexpr int NITEMS = I_IN + 4 * I_SQ + I_KV + I_1 + I_2;
        for (int it = gw; it < NITEMS; it += NGW) {
            int r = it;
            if (r < I_IN) { p0_transpose_item(w_in, D, PROJW, WinT, 0, scr, r, ((int)threadIdx.x & 63)); continue; } r -= I_IN;
            if (r < I_SQ) { p0_transpose_item(w_attn_o, D, D, WaT, 0, scr, r, ((int)threadIdx.x & 63)); continue; } r -= I_SQ;
            if (r < I_SQ) { p0_transpose_item(w_conv_o, D, D, WcT, 0, scr, r, ((int)threadIdx.x & 63)); continue; } r -= I_SQ;
            if (r < I_SQ) { p0_transpose_item(w_mem_o, D, D, WmT, 0, scr, r, ((int)threadIdx.x & 63)); continue; } r -= I_SQ;
            if (r < I_SQ) { p0_transpose_item(w_o, D, D, WoT, 0, scr, r, ((int)threadIdx.x & 63)); continue; } r -= I_SQ;
            if (r < I_KV) { p0_transpose_item(w_mem_kv, D, 2 * D, WkvT, 0, scr, r, ((int)threadIdx.x & 63)); continue; } r -= I_KV;
            if (r < I_1) { p0_transpose_item(w_mlp_in, D, FF, W1T, 0, scr, r, ((int)threadIdx.x & 63)); continue; } r -= I_1;
            p0_transpose_item(w_mlp_out, FF, D, W2T, 0, scr, r, ((int)threadIdx.x & 63));
        }
        for (int m = gw; m < MM; m += NGW) rms_row_to_bf16(((int)threadIdx.x & 63), mem + (size_t)m * D, norm_mem_g, MEMN + (size_t)m * D);
        for (int m = gw; m < M; m += NGW) rms_row_to_bf16(((int)threadIdx.x & 63), x + (size_t)m * D, norm_mix_g, R1 + (size_t)m * D);
        if (BOTH(0)) GRID_BAR();
    }
    if (IN(1)) { PHASE_PTRS
#ifndef P1_SUB
#define P1_SUB 31
#endif
        if (P1_SUB & 1) { pg8::Gemm g{MEMN, WkvT, D, D, D, (long)256 * D, 0, (long)256 * D, 0}; SO S; S.init(MM, D, F.G, cid);
          pg8::EpiMemK E{KP, mq_norm_g, mk_norm_g, X0};
          pg8::gemm_phase<pg8::EpiMemK, SO, true, true>(ring, g, S, E); }
        if (P1_SUB & 2) { pg8::Gemm g{WkvT + (size_t)D * D, MEMN, D, D, D, (long)256 * D, 0, (long)256 * D, 0}; SO S; S.init(D, MM, F.G, (cid + 64) % F.G);
          pg8::EpiPlain E{VT, MM};
          pg8::gemm_phase<pg8::EpiPlain, SO, true, true>(ring, g, S, E); }
        if (P1_SUB & 4) { pg8::Gemm g{R1, WinT, D, D, D, (long)256 * D, 0, (long)256 * D, 0}; SO S; S.init(M, 2 * D, F.G, cid);
          pg8::EpiQK E{R2, (size_t)M * D, q_norm_g, k_norm_g};
          pg8::gemm_phase<pg8::EpiQK, SO, true, true>(ring, g, S, E); }
        if (P1_SUB & 8) { pg8::Gemm g{R1, WinT + (size_t)2 * D * D, D, D, D, (long)256 * D, 0, (long)256 * D, 0}; SO S; S.init(M, 4 * D, F.G, cid);
          pg8::EpiRegion E{R4, (size_t)M * D};
          pg8::gemm_phase<pg8::EpiRegion, SO, true, true>(ring, g, S, E); }
        if (P1_SUB & 16) { pg8::Gemm g{R1, WinT + (size_t)6 * D * D, D, D, D, (long)256 * D, 0, (long)256 * D, 0}; SO S; S.init(M, D, F.G, cid);
          pg8::EpiQm E{D0, X0};
          pg8::gemm_phase<pg8::EpiQm, SO, true, true>(ring, g, S, E); }
        if (BOTH(1)) GRID_BAR();
    }
    if (IN(2)) { PHASE_PTRS
#ifndef P2_SUB
#define P2_SUB 7
#endif
        if (P2_SUB & 1) {
            const int cg8 = (((int)threadIdx.x) & 127) * 8, sub = ((int)threadIdx.x) >> 7;
            float w0[8], w1[8], w2[8];
#pragma unroll
            for (int e = 0; e < 8; ++e) { w0[e] = conv_w[cg8 + e]; w1[e] = conv_w[D + cg8 + e]; w2[e] = conv_w[2 * D + cg8 + e]; }
            for (int it = F.vcu; it < M / 64; it += F.G) {
                const int r0 = it * 64 + sub * 16;
                float p2[8], p1[8];
                if ((r0 & (T - 1)) == 0) {
#pragma unroll
                    for (int e = 0; e < 8; ++e) { p2[e] = 0.f; p1[e] = 0.f; }
                } else {
                    float a[8], b[8];
                    unpack8f(*(const GAS v4u*)(R5 + (size_t)(r0 - 2) * D + cg8), a); unpack8f(*(const GAS v4u*)(R7 + (size_t)(r0 - 2) * D + cg8), b);
#pragma unroll
                    for (int e = 0; e < 8; ++e) p2[e] = a[e] * b[e];
                    unpack8f(*(const GAS v4u*)(R5 + (size_t)(r0 - 1) * D + cg8), a); unpack8f(*(const GAS v4u*)(R7 + (size_t)(r0 - 1) * D + cg8), b);
#pragma unroll
                    for (int e = 0; e < 8; ++e) p1[e] = a[e] * b[e];
                }
#pragma unroll 4
                for (int r = 0; r < 16; ++r) {
                    const size_t off = (size_t)(r0 + r) * D + cg8;
                    float a[8], b[8], gb[8], y[8];
                    unpack8f(*(const GAS v4u*)(R5 + off), a); unpack8f(*(const GAS v4u*)(R7 + off), b); unpack8f(*(const GAS v4u*)(R6 + off), gb);
#pragma unroll
                    for (int e = 0; e < 8; ++e) { const float cur = a[e] * b[e]; y[e] = gb[e] * (w0[e] * p2[e] + w1[e] * p1[e] + w2[e] * cur); p2[e] = p1[e]; p1[e] = cur; }
                    *(GAS v4u*)(D1 + off) = pack8f(y);
                }
            }
        }
        __syncthreads();
        if (P2_SUB & 2) { pg8::Gemm g{D0, KP, D, D, 256, (long)256 * D, 256, 256, (long)256 * D}; SO S; S.init(M, D, F.G, cid);
          pg8::EpiSoftmax E{D0, X0};
          pg8::gemm_phase<pg8::EpiSoftmax, SO, true, true>(ring, g, S, E); }
        VM_WAIT(); __syncthreads();
        if (P2_SUB & 4) { pg8::Gemm g{D0, VT, D, MM, 256, (long)256 * D, 256, (long)256 * MM, 256}; SO S; S.init(M, D, F.G, cid);
          pg8::EpiPlain E{D0, D};
          pg8::gemm_phase<pg8::EpiPlain, SO, true, true>(ring, g, S, E); }
        if (BOTH(2)) GRID_BAR();
    }
    if (IN(3)) { PHASE_PTRS
        const attn_body::AttnTensors AT{(const attn_body::bf16*)R2, (const attn_body::bf16*)R3, (const attn_body::bf16*)R4, (attn_body::bf16*)R6, (attn_body::bf16*)R7};
        const attn_body::AttnOrder AS{F.vcu, F.G};
        attn_body::attn_phase<8>((char*)lds + RING_OFF, AT, AS);
        if (BOTH(3)) GRID_BAR();
    }
    if (IN(4)) { PHASE_PTRS
        {
            const float d1 = wave_sum(lam_q1[((int)threadIdx.x & 63)] * lam_k1[((int)threadIdx.x & 63)]), d2 = wave_sum(lam_q2[((int)threadIdx.x & 63)] * lam_k2[((int)threadIdx.x & 63)]);
            const float lam = expf(d1) - expf(d2) + 0.2f;
            float sg[16];
#pragma unroll
            for (int e = 0; e < 16; ++e) sg[e] = subln_g[(((int)threadIdx.x & 63) & 7) * 16 + e] * 0.8f;
            for (int m = gw; m < M; m += NGW) {
                const size_t off = (size_t)m * D + ((int)threadIdx.x & 63) * 16;
                float a[16], b[16];
                { float t0[8], t1[8]; unpack8f(*(const GAS v4u*)(R6 + off), t0); unpack8f(*(const GAS v4u*)(R6 + off + 8), t1);
#pragma unroll
                  for (int e = 0; e < 8; ++e) { a[e] = t0[e]; a[8 + e] = t1[e]; } }
                { float t0[8], t1[8]; unpack8f(*(const GAS v4u*)(R7 + off), t0); unpack8f(*(const GAS v4u*)(R7 + off + 8), t1);
#pragma unroll
                  for (int e = 0; e < 8; ++e) { b[e] = t0[e]; b[8 + e] = t1[e]; } }
                float ss = 0.f;
#pragma unroll
                for (int e = 0; e < 16; ++e) { a[e] = a[e] - lam * b[e]; ss += a[e] * a[e]; }
                ss += __shfl_xor(ss, 1); ss += __shfl_xor(ss, 2); ss += __shfl_xor(ss, 4);
                const float rstd = 1.f / sqrtf(ss * (1.f / 128.f) + 1e-6f);
                float o0[8], o1[8];
#pragma unroll
                for (int e = 0; e < 8; ++e) { o0[e] = a[e] * rstd * sg[e]; o1[e] = a[8 + e] * rstd * sg[8 + e]; }
                *(GAS v4u*)(R2 + off) = pack8f(o0); *(GAS v4u*)(R2 + off + 8) = pack8f(o1);
            }
        }
        __syncthreads();
        { pg8::Gemm g{R1, WinT + (size_t)NPROJ1 * D, D, D, D, (long)256 * D, 0, (long)256 * D, 0}; SO S; S.init(M, 3 * D, F.G, cid);
          pg8::EpiGate E{R3, (size_t)M * D, b_gate};
          pg8::gemm_phase<pg8::EpiGate, SO, true, true>(ring, g, S, E); }
        if (BOTH(4)) GRID_BAR();
    }
    if (IN(5)) { PHASE_PTRS
        { pg8::Gemm g{R2, WaT, D, D, D, (long)256 * D, 0, (long)256 * D, 0}; SO S; S.init(M, D, F.G, cid);
          pg8::EpiBranch<false> E{R3, R1};
          pg8::gemm_phase<pg8::EpiBranch<false>, SO, true, true>(ring, g, S, E); }
        { pg8::Gemm g{D1, WcT, D, D, D, (long)256 * D, 0, (long)256 * D, 0}; SO S; S.init(M, D, F.G, cid);
          pg8::EpiBranch<true> E{R4, R1};
          pg8::gemm_phase<pg8::EpiBranch<true>, SO, true, true>(ring, g, S, E); }
        { pg8::Gemm g{D0, WmT, D, D, D, (long)256 * D, 0, (long)256 * D, 0}; SO S; S.init(M, D, F.G, cid);
          pg8::EpiBranch<true> E{R5, R1};
          pg8::gemm_phase<pg8::EpiBranch<true>, SO, true, true>(ring, g, S, E); }
        if (BOTH(5)) GRID_BAR();
    }
    if (IN(6)) { PHASE_PTRS
        { pg8::Gemm g{R1, WoT, D, D, D, (long)256 * D, 0, (long)256 * D, 0}; SO S; S.init(M, D, F.G, cid);
          pg8::EpiResF32 E{x, out};
          pg8::gemm_phase<pg8::EpiResF32, SO, true, true>(ring, g, S, E); }
        if (BOTH(6)) GRID_BAR();
    }
    if (IN(7)) { PHASE_PTRS
        for (int m = gw; m < M; m += NGW) rms_row_to_bf16(((int)threadIdx.x & 63), out + (size_t)m * D, norm_mlp_g, R2 + (size_t)m * D);
        if (BOTH(7)) GRID_BAR();
    }
    if (IN(8)) { PHASE_PTRS
        { pg8::Gemm g{R2, W1T, D, D, D, (long)256 * D, 0, (long)256 * D, 0}; SO S; S.init(M, FF, F.G, cid);
          pg8::EpiRelu2 E{R3, FF};
          pg8::gemm_phase<pg8::EpiRelu2, SO, true, true>(ring, g, S, E); }
        if (BOTH(8)) GRID_BAR();
    }
    if (IN(9)) { PHASE_PTRS
        { pg8::Gemm g{R3, W2T, FF, FF, FF, (long)256 * FF, 0, (long)256 * FF, 0}; SO S; S.init(M, D, F.G, cid);
          pg8::EpiResF32 E{out, out};
          pg8::gemm_phase<pg8::EpiResF32, SO, true, true>(ring, g, S, E); }
    }
    if (hi > N_PHASES) { const unsigned long long* ia = (const unsigned long long*)__builtin_amdgcn_implicitarg_ptr(); if (ia[11] == 1ull) __builtin_trap(); }
#undef IN
#undef BOTH
}

#ifndef MK_N_LAUNCHES
#define MK_N_LAUNCHES 1
#endif
extern "C" void kernel_launch(void* const* d_in, const int* in_sizes, int n_in, void* d_out, int out_size, void* d_ws, size_t ws_size, hipStream_t stream) {
    static int grid = 0;
    if (grid == 0) {
        if (n_in != 24 || in_sizes[0] != M * D || out_size != M * D || ws_size < WS_END) { fprintf(stderr, "kernel_launch: unexpected shapes (n_in %d, in0 %d, out %d, ws %zu); nothing launched\n", n_in, n_in > 0 ? in_sizes[0] : -1, out_size, ws_size); grid = -1; return; }
        int dev = 0, cus = 0, per_cu = 0;
        if (hipGetDevice(&dev) != hipSuccess || hipDeviceGetAttribute(&cus, hipDeviceAttributeMultiprocessorCount, dev) != hipSuccess) { grid = -1; return; }
        if (hipFuncSetAttribute((const void*)hybrid_fwd, hipFuncAttributeMaxDynamicSharedMemorySize, LDS_BYTES) != hipSuccess) { fprintf(stderr, "kernel_launch: hipFuncSetAttribute failed\n"); grid = -1; return; }
        if (hipOccupancyMaxActiveBlocksPerMultiprocessor(&per_cu, (const void*)hybrid_fwd, NWAVES * 64, LDS_BYTES) != hipSuccess || per_cu < 1) { fprintf(stderr, "kernel_launch: occupancy query says %d\n", per_cu); per_cu = 1; }
        (void)hipGetLastError();
        grid = cus * 1;
    }
    if (grid < 0) return;
    (void)hipMemsetAsync((char*)d_ws + WS_CTL, 0, CTL_ZERO_BYTES, stream);
    Args a{};
    for (int i = 0; i < 24; ++i) a.in[i] = (const float*)d_in[i];
    a.out = (float*)d_out; a.ws = (unsigned char*)d_ws;
    if (MK_N_LAUNCHES == 1) {
        a.ph_lo = 0; a.ph_hi = N_PHASES;
        void* kargs[] = {&a};
        hipError_t e = hipLaunchCooperativeKernel((const void*)hybrid_fwd, dim3(grid), dim3(NWAVES * 64), kargs, LDS_BYTES, stream);
        if (e != hipSuccess) fprintf(stderr, "kernel_launch: cooperative launch failed: %s (grid %d)\n", hipGetErrorString(e), grid);
    } else {
        for (int p = 0; p < N_PHASES; ++p) { a.ph_lo = p; a.ph_hi = p + 1; hipLaunchKernelGGL(hybrid_fwd, dim3(grid), dim3(NWAVES * 64), LDS_BYTES, stream, a); }
    }
}
```

```cpp
#include <hip/hip_runtime.h>
#include <hip/hip_cooperative_groups.h>
#include <hip/hip_bf16.h>
#include <cstdio>
#include <cstdint>
#include <cmath>
namespace cg = cooperative_groups;
namespace pg8 {
#define PG8_LAS __attribute__((address_space(3)))
typedef unsigned short bf16_t;
typedef short bf16x8 __attribute__((ext_vector_type(8)));
typedef float f32x4 __attribute__((ext_vector_type(4)));
typedef unsigned u32x4 __attribute__((ext_vector_type(4)));
constexpr int BM = 256, BK = 64, HALF = 128, HTB = HALF * BK * 2  , STAGE_BYTES = 8 * HTB, NXCD = 8, WGM = 8;

__host__ __device__ __forceinline__ int lds_byte(int r, int c) { const int st = (r >> 4) * 2 + (c >> 5), rr = r & 15, cc = c & 31, ob = rr * 64 + cc * 2; return st * 1024 + (ob ^ (((ob >> 9) & 1) << 5)); }
__host__ __device__ __forceinline__ void stage_rc(int b, int& R, int& C) { const int st = b / 1024, sb = b % 1024, swz = sb ^ (((sb >> 9) & 1) << 5); R = (st >> 1) * 16 + swz / 64; C = (st & 1) * 32 + (swz % 64) / 2; }
__host__ __device__ __forceinline__ int perm32(int rho) { const int n = rho >> 4, i = rho & 15; return 8 * (i >> 2) + 4 * n + (i & 3); }

struct Unit { int pm, pn, seg; };
struct Gemm { const bf16_t* A; const bf16_t* Bt; int lda, ldb, K; long sAm, sAn, sBn, sBb; const bf16_t* A1 = nullptr; const bf16_t* A2 = nullptr; long sBseg = 0; };

struct StaticOrder {
    int nM, nN, nwg, G, c;
    __host__ __device__ void init(int M, int N, int G_, int c_) { nM = M / BM; nN = N / BM; nwg = nM * nN; G = G_; c = c_; }
    __host__ __device__ bool next(int i, Unit& u) const {
        const long L = (long)i * G + c; if (L >= nwg) return false;
        int wgid = (int)L; { const int q = nwg / NXCD, r = nwg % NXCD, xcd = wgid % NXCD, off = wgid / NXCD; wgid = (xcd < r ? xcd * (q + 1) : r * (q + 1) + (xcd - r) * q) + off; }
        const int nig = WGM * nN, gid = wgid / nig, fm = gid * WGM, gsz = (nM - fm) < WGM ? (nM - fm) : WGM;
        u.pm = fm + ((wgid % nig) % gsz); u.pn = (wgid % nig) / gsz; u.seg = 0; return true;
    }
    __device__ __forceinline__ void a_ready(const Unit&) const {}
    __device__ __forceinline__ void done(const Unit&) const {}
};

struct SegOrder {
    StaticOrder base;
    __host__ __device__ bool next(int i, Unit& u) const { if (!base.next(i / 3, u)) return false; u.seg = i % 3; return true; }
    __device__ __forceinline__ void a_ready(const Unit&) const {}
    __device__ __forceinline__ void done(const Unit&) const {}
};
struct GateOrder {
    StaticOrder base;
    __host__ __device__ bool next(int i, Unit& u) const { if (!base.next(i / 3, u)) return false; u.pn += 4 * (i % 3); return true; }
    __device__ __forceinline__ void a_ready(const Unit&) const {}
    __device__ __forceinline__ void done(const Unit&) const {}
};
__device__ __forceinline__ unsigned cvt_pk_bf16(float lo, float hi) { unsigned r; asm volatile("v_cvt_pk_bf16_f32 %0, %1, %2" : "=v"(r) : "v"(lo), "v"(hi)); return r; }
__device__ __forceinline__ u32x4 pack8(const f32x4& v0, const f32x4& v1) { u32x4 w; w.x = cvt_pk_bf16(v0[0], v0[1]); w.y = cvt_pk_bf16(v0[2], v0[3]); w.z = cvt_pk_bf16(v1[0], v1[1]); w.w = cvt_pk_bf16(v1[2], v1[3]); return w; }
__device__ __forceinline__ void unpack8(const u32x4& w, f32x4& v0, f32x4& v1) {
    v0[0] = __uint_as_float(w.x << 16); v0[1] = __uint_as_float(w.x & 0xffff0000u); v0[2] = __uint_as_float(w.y << 16); v0[3] = __uint_as_float(w.y & 0xffff0000u);
    v1[0] = __uint_as_float(w.z << 16); v1[1] = __uint_as_float(w.z & 0xffff0000u); v1[2] = __uint_as_float(w.w << 16); v1[3] = __uint_as_float(w.w & 0xffff0000u); }
typedef f32x4 Acc[2][2][4][2];
typedef int v8i32 __attribute__((ext_vector_type(8))); typedef int v4i32 __attribute__((ext_vector_type(4)));
__device__ __forceinline__ v8i32 pg8_cat(bf16x8 lo, bf16x8 hi) { return __builtin_shufflevector(__builtin_bit_cast(v4i32, lo), __builtin_bit_cast(v4i32, hi), 0, 1, 2, 3, 4, 5, 6, 7); }
#define PG8_FOR_AM _Pragma("unroll") for (int ai = 0; ai < 2; ++ai) _Pragma("unroll") for (int m = 0; m < 4; ++m)
#define PG8_FOR_BN _Pragma("unroll") for (int bj = 0; bj < 2; ++bj) _Pragma("unroll") for (int n = 0; n < 2; ++n)
__device__ __forceinline__ float dot4(const f32x4& a) { return (a[0] * a[0] + a[1] * a[1]) + (a[2] * a[2] + a[3] * a[3]); }
__device__ __forceinline__ float sum4(const f32x4& a) { return (a[0] + a[1]) + (a[2] + a[3]); }
__device__ __forceinline__ void row_sum_xchg(float (&s)[2][4], PG8_LAS float* X, int wr, int wc, int fr, int fq) {
    PG8_FOR_AM { float v = s[ai][m]; v += __shfl_xor(v, 16); v += __shfl_xor(v, 32); if (fq == 0) X[(ai * HALF + wr * 64 + m * 16 + fr) * 4 + wc] = v; }
    asm volatile("s_waitcnt lgkmcnt(0)" ::: "memory"); __builtin_amdgcn_s_barrier(); asm volatile("" ::: "memory");
    PG8_FOR_AM { const f32x4 t = *(const PG8_LAS f32x4*)(X + (ai * HALF + wr * 64 + m * 16 + fr) * 4); s[ai][m] = (t[0] + t[1]) + (t[2] + t[3]); }
}
__device__ __forceinline__ void store_tile_bf16(const Acc& acc, bf16_t* base  , size_t ldc, int wr, int fr) {
    PG8_FOR_AM { bf16_t* rowp = base + (size_t)(ai * HALF + wr * 64 + m * 16 + fr) * ldc;
#pragma unroll
        for (int bj = 0; bj < 2; ++bj) *(u32x4*)(rowp + bj * 32) = pack8(acc[ai][bj][m][0], acc[ai][bj][m][1]); }
}
__device__ __forceinline__ void dequant_i8(Acc& acc, const float* sa, const float* sb, int wr, int wc, int fr, int fq) {
    float ra[2][4];
    PG8_FOR_AM ra[ai][m] = sa[ai * HALF + wr * 64 + m * 16 + fr];
#pragma unroll
    for (int bj = 0; bj < 2; ++bj) {
        const f32x4 c0 = *(const f32x4*)(sb + wc * 64 + bj * 32 + 8 * fq), c1 = *(const f32x4*)(sb + wc * 64 + bj * 32 + 8 * fq + 4);
        PG8_FOR_AM { const v4i32 q0 = __builtin_bit_cast(v4i32, acc[ai][bj][m][0]), q1 = __builtin_bit_cast(v4i32, acc[ai][bj][m][1]); f32x4 v0, v1;
            v0[0] = (float)q0[0]; v0[1] = (float)q0[1]; v0[2] = (float)q0[2]; v0[3] = (float)q0[3]; v1[0] = (float)q1[0]; v1[1] = (float)q1[1]; v1[2] = (float)q1[2]; v1[3] = (float)q1[3];
            acc[ai][bj][m][0] = v0 * c0 * ra[ai][m]; acc[ai][bj][m][1] = v1 * c1 * ra[ai][m]; }
    }
}
__device__ __forceinline__ void dequant_i8_cols(Acc& acc, const float* sb, int wc, int fq) {
#pragma unroll
    for (int bj = 0; bj < 2; ++bj) {
        const f32x4 c0 = *(const f32x4*)(sb + wc * 64 + bj * 32 + 8 * fq), c1 = *(const f32x4*)(sb + wc * 64 + bj * 32 + 8 * fq + 4);
        PG8_FOR_AM { const v4i32 q0 = __builtin_bit_cast(v4i32, acc[ai][bj][m][0]), q1 = __builtin_bit_cast(v4i32, acc[ai][bj][m][1]); f32x4 v0, v1;
            v0[0] = (float)q0[0]; v0[1] = (float)q0[1]; v0[2] = (float)q0[2]; v0[3] = (float)q0[3]; v1[0] = (float)q1[0]; v1[1] = (float)q1[1]; v1[2] = (float)q1[2]; v1[3] = (float)q1[3];
            acc[ai][bj][m][0] = v0 * c0; acc[ai][bj][m][1] = v1 * c1; }
    }
}
constexpr float LOG2E = 1.4426950408889634f;
constexpr float NORM_EPS = 1e-6f;
struct EpiQK {
    bf16_t* r0; size_t rstride; const float* qg; const float* kg; const float* sa; const float* sb;
    __device__ __forceinline__ void operator()(Acc& acc, const Unit& u, int wr, int wc, int fr, int fq) const {
        dequant_i8_cols(acc, sb + u.pn * BM, wc, fq);
        const int type = u.pn >> 2, colt = (u.pn & 3) * BM, c0 = wc * 64 + 8 * fq;
        const float* gp = type == 0 ? qg : kg; const float sc = type == 0 ? 0.125f * LOG2E : 1.0f;
        f32x4 gv[2][2];
        PG8_FOR_BN gv[bj][n] = *(const f32x4*)(gp + bj * 32 + 8 * fq + 4 * n) * sc;
        bf16_t* base = r0 + (size_t)type * rstride + (size_t)u.pm * BM * 1024 + colt + c0;
        PG8_FOR_AM { float ss = 0.f; PG8_FOR_BN ss += dot4(acc[ai][bj][m][n]);
            ss += __shfl_xor(ss, 16); ss += __shfl_xor(ss, 32);
            const float ra = sa[u.pm * BM + ai * HALF + wr * 64 + m * 16 + fr];
            const float rstd = __builtin_amdgcn_rsqf(ss * (1.0f / 64.0f) + NORM_EPS * __builtin_amdgcn_rcpf(ra * ra + 1e-30f));
            bf16_t* rowp = base + (size_t)(ai * HALF + wr * 64 + m * 16 + fr) * 1024;
#pragma unroll
            for (int bj = 0; bj < 2; ++bj) *(u32x4*)(rowp + bj * 32) = pack8(acc[ai][bj][m][0] * (gv[bj][0] * rstd), acc[ai][bj][m][1] * (gv[bj][1] * rstd)); }
    }
};
struct EpiP1b {
    bf16_t* rv; bf16_t* rgb; bf16_t* rin; const float* sa; const float* sb;
    __device__ __forceinline__ void operator()(Acc& acc, const Unit& u, int wr, int wc, int fr, int fq) const {
        dequant_i8(acc, sa + u.pm * BM, sb + u.pn * BM, wr, wc, fr, fq);
        if (u.pn < 8) {
            store_tile_bf16(acc, (u.pn < 4 ? rv : rgb) + (size_t)u.pm * BM * 1024 + (u.pn & 3) * BM + wc * 64 + 8 * fq, 1024, wr, fr);
        } else {
            bf16_t* base = rin + (size_t)u.pm * BM * 1024 + (u.pn - 8) * 128 + wc * 32 + 8 * fq;
            PG8_FOR_AM *(u32x4*)(base + (size_t)(ai * HALF + wr * 64 + m * 16 + fr) * 1024) = pack8(acc[ai][0][m][0] * acc[ai][1][m][0], acc[ai][0][m][1] * acc[ai][1][m][1]);
        }
    }
};
struct EpiQm {
    bf16_t* O; PG8_LAS float* X; const float* sa; const float* sb;
    __device__ __forceinline__ void operator()(Acc& acc, const Unit& u, int wr, int wc, int fr, int fq) const {
        dequant_i8_cols(acc, sb + u.pn * BM, wc, fq);
        float s[2][4];
        PG8_FOR_AM { float ss = 0.f; PG8_FOR_BN ss += dot4(acc[ai][bj][m][n]); s[ai][m] = ss; }
        row_sum_xchg(s, X, wr, wc, fr, fq);
        PG8_FOR_AM { const float ra = sa[u.pm * BM + ai * HALF + wr * 64 + m * 16 + fr]; const float rstd = __builtin_amdgcn_rsqf(s[ai][m] * (1.0f / 256.0f) + NORM_EPS * __builtin_amdgcn_rcpf(ra * ra + 1e-30f)); PG8_FOR_BN acc[ai][bj][m][n] = acc[ai][bj][m][n] * rstd; }
        asm volatile("s_waitcnt lgkmcnt(0)" ::: "memory"); __builtin_amdgcn_s_barrier(); asm volatile("" ::: "memory");
        store_tile_bf16(acc, O + (size_t)u.pm * BM * 1024 + u.pn * BM + wc * 64 + 8 * fq, 1024, wr, fr);
    }
};
struct EpiMemK {
    bf16_t* O; const float* gq; const float* gk; PG8_LAS float* X;
    __device__ __forceinline__ void operator()(Acc& acc, const Unit& u, int wr, int wc, int fr, int fq) const {
        const int c0 = wc * 64 + 8 * fq;
        f32x4 gv[2][2];
        PG8_FOR_BN gv[bj][n] = *(const f32x4*)(gq + c0 + bj * 32 + 4 * n) * *(const f32x4*)(gk + c0 + bj * 32 + 4 * n) * (LOG2E / 16.0f);
        float s[2][4];
        PG8_FOR_AM { float ss = 0.f; PG8_FOR_BN ss += dot4(acc[ai][bj][m][n]); s[ai][m] = ss; }
        row_sum_xchg(s, X, wr, wc, fr, fq);
        PG8_FOR_AM { const float rstd = __builtin_amdgcn_rsqf(s[ai][m] * (1.0f / 256.0f) + NORM_EPS); PG8_FOR_BN acc[ai][bj][m][n] = acc[ai][bj][m][n] * (gv[bj][n] * rstd); }
        asm volatile("s_waitcnt lgkmcnt(0)" ::: "memory"); __builtin_amdgcn_s_barrier(); asm volatile("" ::: "memory");
        store_tile_bf16(acc, O + (size_t)u.pm * BM * 1024 + u.pn * BM + c0, 1024, wr, fr);
    }
};
struct EpiPlain {
    bf16_t* O; int ldc;
    __device__ __forceinline__ void operator()(Acc& acc, const Unit& u, int wr, int wc, int fr, int fq) const {
        store_tile_bf16(acc, O + (size_t)u.pm * BM * ldc + u.pn * BM + wc * 64 + 8 * fq, ldc, wr, fr);
    }
};
struct EpiSoftmax {
    bf16_t* O; PG8_LAS float* X;
    __device__ __forceinline__ void operator()(Acc& acc, const Unit& u, int wr, int wc, int fr, int fq) const {
        float s[2][4];
        PG8_FOR_AM { float ss = 0.f; PG8_FOR_BN { f32x4& v = acc[ai][bj][m][n]; v[0] = __builtin_amdgcn_exp2f(v[0]); v[1] = __builtin_amdgcn_exp2f(v[1]); v[2] = __builtin_amdgcn_exp2f(v[2]); v[3] = __builtin_amdgcn_exp2f(v[3]); ss += sum4(v); } s[ai][m] = ss; }
        row_sum_xchg(s, X, wr, wc, fr, fq);
        PG8_FOR_AM { const float inv = __builtin_amdgcn_rcpf(s[ai][m]); PG8_FOR_BN acc[ai][bj][m][n] = acc[ai][bj][m][n] * inv; }
        asm volatile("s_waitcnt lgkmcnt(0)" ::: "memory"); __builtin_amdgcn_s_barrier(); asm volatile("" ::: "memory");
        store_tile_bf16(acc, O + (size_t)u.pm * BM * 1024 + u.pn * BM + wc * 64 + 8 * fq, 1024, wr, fr);
    }
};
struct EpiGate {
    bf16_t* g0; size_t gstride; const float* bias; const float* sa; const float* sb;
    __device__ __forceinline__ void operator()(Acc& acc, const Unit& u, int wr, int wc, int fr, int fq) const {
        dequant_i8(acc, sa + u.pm * BM, sb + u.pn * BM, wr, wc, fr, fq);
        const int br = u.pn >> 2, colt = (u.pn & 3) * BM, c0 = wc * 64 + 8 * fq;
        f32x4 bv[2][2];
        PG8_FOR_BN bv[bj][n] = *(const f32x4*)(bias + u.pn * BM + c0 + bj * 32 + 4 * n);
        PG8_FOR_AM PG8_FOR_BN { f32x4 v = acc[ai][bj][m][n] + bv[bj][n];
#pragma unroll
            for (int e = 0; e < 4; ++e) v[e] = __builtin_amdgcn_rcpf(1.0f + __builtin_amdgcn_exp2f(-LOG2E * v[e]));
            acc[ai][bj][m][n] = v; }
        store_tile_bf16(acc, g0 + (size_t)br * gstride + (size_t)u.pm * BM * 1024 + colt + c0, 1024, wr, fr);
    }
};
template <bool ACCUM> struct EpiBranch {
    const bf16_t* g; bf16_t* O;
    __device__ __forceinline__ void operator()(Acc& acc, const Unit& u, int wr, int wc, int fr, int fq) const {
        const size_t off0 = (size_t)u.pm * BM * 1024 + u.pn * BM + wc * 64 + 8 * fq + (size_t)(wr * 64 + fr) * 1024;
#pragma unroll
        for (int ai = 0; ai < 2; ++ai) {
            u32x4 gq[4][2], oq[4][2];
#pragma unroll
            for (int m = 0; m < 4; ++m)
#pragma unroll
                for (int bj = 0; bj < 2; ++bj) { gq[m][bj] = *(const u32x4*)(g + off0 + (size_t)(ai * HALF + m * 16) * 1024 + bj * 32);
                    if (ACCUM) oq[m][bj] = *(const u32x4*)(O + off0 + (size_t)(ai * HALF + m * 16) * 1024 + bj * 32); }
#pragma unroll
            for (int m = 0; m < 4; ++m)
#pragma unroll
                for (int bj = 0; bj < 2; ++bj) { f32x4 g0v, g1v; unpack8(gq[m][bj], g0v, g1v);
                    f32x4 v0 = acc[ai][bj][m][0] * g0v, v1 = acc[ai][bj][m][1] * g1v;
                    if (ACCUM) { f32x4 p0, p1; unpack8(oq[m][bj], p0, p1); v0 = v0 + p0; v1 = v1 + p1; }
                    *(u32x4*)(O + off0 + (size_t)(ai * HALF + m * 16) * 1024 + bj * 32) = pack8(v0, v1); }
        }
    }
};
struct EpiBranch3 {
    const bf16_t* g0; const bf16_t* g1; const bf16_t* g2; bf16_t* O;
    __device__ __forceinline__ void operator()(Acc& acc, const Unit& u, int wr, int wc, int fr, int fq) const {
        const size_t off0 = (size_t)u.pm * BM * 1024 + u.pn * BM + wc * 64 + 8 * fq + (size_t)(wr * 64 + fr) * 1024;
        const bf16_t* gn = u.seg == 0 ? g0 : u.seg == 1 ? g1 : g2;
        const bf16_t* gd = u.seg == 0 ? g1 : g2;
        const bool last = u.seg == 2;
#pragma unroll
        for (int ai = 0; ai < 2; ++ai) {
            u32x4 nq[4][2], dq[4][2];
#pragma unroll
            for (int m = 0; m < 4; ++m)
#pragma unroll
                for (int bj = 0; bj < 2; ++bj) { nq[m][bj] = *(const u32x4*)(gn + off0 + (size_t)(ai * HALF + m * 16) * 1024 + bj * 32);
                    if (!last) dq[m][bj] = *(const u32x4*)(gd + off0 + (size_t)(ai * HALF + m * 16) * 1024 + bj * 32); }
#pragma unroll
            for (int m = 0; m < 4; ++m)
#pragma unroll
                for (int bj = 0; bj < 2; ++bj) { f32x4 n0, n1; unpack8(nq[m][bj], n0, n1);
                    if (!last) { f32x4 d0, d1; unpack8(dq[m][bj], d0, d1);
#pragma unroll
                        for (int e = 0; e < 4; ++e) { n0[e] *= __builtin_amdgcn_rcpf(__builtin_fmaxf(d0[e], 1e-20f)); n1[e] *= __builtin_amdgcn_rcpf(__builtin_fmaxf(d1[e], 1e-20f)); } }
                    acc[ai][bj][m][0] = acc[ai][bj][m][0] * n0; acc[ai][bj][m][1] = acc[ai][bj][m][1] * n1;
                    if (last) *(u32x4*)(O + off0 + (size_t)(ai * HALF + m * 16) * 1024 + bj * 32) = pack8(acc[ai][bj][m][0], acc[ai][bj][m][1]); }
        }
    }
};
struct EpiResF32 {
    const float* base; float* out;
    __device__ __forceinline__ void operator()(Acc& acc, const Unit& u, int wr, int wc, int fr, int fq) const {
        const size_t off0 = (size_t)u.pm * BM * 1024 + u.pn * BM + wc * 64 + 8 * fq + (size_t)(wr * 64 + fr) * 1024;
#pragma unroll
        for (int ai = 0; ai < 2; ++ai) {
            f32x4 bv[4][2][2];
#pragma unroll
            for (int m = 0; m < 4; ++m) PG8_FOR_BN bv[m][bj][n] = *(const f32x4*)(base + off0 + (size_t)(ai * HALF + m * 16) * 1024 + bj * 32 + 4 * n);
#pragma unroll
            for (int m = 0; m < 4; ++m) PG8_FOR_BN *(f32x4*)(out + off0 + (size_t)(ai * HALF + m * 16) * 1024 + bj * 32 + 4 * n) = bv[m][bj][n] + acc[ai][bj][m][n];
        }
    }
};
struct EpiX1 {
    const float* base; float* out; bf16_t* xb; float* stats;
    __device__ __forceinline__ void operator()(Acc& acc, const Unit& u, int wr, int wc, int fr, int fq) const {
        const size_t off0 = (size_t)u.pm * BM * 1024 + u.pn * BM + wc * 64 + 8 * fq + (size_t)(wr * 64 + fr) * 1024;
#pragma unroll
        for (int ai = 0; ai < 2; ++ai) {
            f32x4 bv[4][2][2];
#pragma unroll
            for (int m = 0; m < 4; ++m) PG8_FOR_BN bv[m][bj][n] = *(const f32x4*)(base + off0 + (size_t)(ai * HALF + m * 16) * 1024 + bj * 32 + 4 * n);
#pragma unroll
            for (int m = 0; m < 4; ++m) { const size_t ro = off0 + (size_t)(ai * HALF + m * 16) * 1024; float ss = 0.f;
                PG8_FOR_BN { const f32x4 v = bv[m][bj][n] + acc[ai][bj][m][n]; *(f32x4*)(out + ro + bj * 32 + 4 * n) = v; acc[ai][bj][m][n] = v; ss += dot4(v); }
#pragma unroll
                for (int bj = 0; bj < 2; ++bj) *(u32x4*)(xb + ro + bj * 32) = pack8(acc[ai][bj][m][0], acc[ai][bj][m][1]);
                ss += __shfl_xor(ss, 16); ss += __shfl_xor(ss, 32);
                if (fq == 0) stats[(size_t)(u.pm * BM + ai * HALF + wr * 64 + m * 16 + fr) * 16 + u.pn * 4 + wc] = ss; }
        }
    }
};
struct EpiRelu2P {
    bf16_t* O; int ldc;
    __device__ __forceinline__ void operator()(Acc& acc, const Unit& u, int wr, int wc, int fr, int fq) const {
        bf16_t* base = O + (size_t)u.pm * BM * ldc + u.pn * BM + wc * 64 + 8 * fq;
        PG8_FOR_AM {
            PG8_FOR_BN { f32x4 v = acc[ai][bj][m][n];
#pragma unroll
                for (int e = 0; e < 4; ++e) { const float r = __builtin_fmaxf(v[e], 0.f); v[e] = r * r; }
                acc[ai][bj][m][n] = v; }
#pragma unroll
            for (int bj = 0; bj < 2; ++bj) *(u32x4*)(base + (size_t)(ai * HALF + wr * 64 + m * 16 + fr) * ldc + bj * 32) = pack8(acc[ai][bj][m][0], acc[ai][bj][m][1]); }
    }
};
struct EpiOutN {
    const float* base; float* out; const float* stats;
    __device__ __forceinline__ void operator()(Acc& acc, const Unit& u, int wr, int wc, int fr, int fq) const {
        const size_t off0 = (size_t)u.pm * BM * 1024 + u.pn * BM + wc * 64 + 8 * fq + (size_t)(wr * 64 + fr) * 1024;
        float rs[2][4];
        PG8_FOR_AM rs[ai][m] = sum4(*(const f32x4*)(stats + (size_t)(u.pm * BM + ai * HALF + wr * 64 + m * 16 + fr) * 16 + 4 * fq));
#pragma unroll
        for (int ai = 0; ai < 2; ++ai) {
            f32x4 bv[4][2][2];
#pragma unroll
            for (int m = 0; m < 4; ++m) PG8_FOR_BN bv[m][bj][n] = *(const f32x4*)(base + off0 + (size_t)(ai * HALF + m * 16) * 1024 + bj * 32 + 4 * n);
#pragma unroll
            for (int m = 0; m < 4; ++m) { float t = rs[ai][m]; t += __shfl_xor(t, 16); t += __shfl_xor(t, 32);
                const float r2 = __builtin_amdgcn_rcpf(t * (1.0f / 1024.0f) + NORM_EPS);
                PG8_FOR_BN *(f32x4*)(out + off0 + (size_t)(ai * HALF + m * 16) * 1024 + bj * 32 + 4 * n) = bv[m][bj][n] + acc[ai][bj][m][n] * r2; }
        }
    }
};
struct EpiRelu2N {
    bf16_t* O; int ldc; const float* stats;
    __device__ __forceinline__ void operator()(Acc& acc, const Unit& u, int wr, int wc, int fr, int fq) const {
        bf16_t* base = O + (size_t)u.pm * BM * ldc + u.pn * BM + wc * 64 + 8 * fq;
        float rs[2][4];
        PG8_FOR_AM rs[ai][m] = sum4(*(const f32x4*)(stats + (size_t)(u.pm * BM + ai * HALF + wr * 64 + m * 16 + fr) * 16 + 4 * fq));
        PG8_FOR_AM { float t = rs[ai][m]; t += __shfl_xor(t, 16); t += __shfl_xor(t, 32); rs[ai][m] = __builtin_amdgcn_rsqf(t * (1.0f / 1024.0f) + NORM_EPS); }
        PG8_FOR_AM { const float rstd = rs[ai][m];
            PG8_FOR_BN { f32x4 v = acc[ai][bj][m][n] * rstd;
#pragma unroll
                for (int e = 0; e < 4; ++e) { const float r = __builtin_fmaxf(v[e], 0.f); v[e] = r * r; }
                acc[ai][bj][m][n] = v; }
#pragma unroll
            for (int bj = 0; bj < 2; ++bj) *(u32x4*)(base + (size_t)(ai * HALF + wr * 64 + m * 16 + fr) * ldc + bj * 32) = pack8(acc[ai][bj][m][0], acc[ai][bj][m][1]); }
    }
};

template <class Epi, class Sched, bool ALIGN_EPI = false, bool SP2 = false, bool SEG3 = false, bool F8 = false, bool I8 = false>
__device__ __forceinline__ void gemm_phase(PG8_LAS unsigned char* lds, const Gemm g, const Sched& S, const Epi& E) {
    int tid_ = threadIdx.x; asm volatile("" : "+v"(tid_));
    const int tid = tid_, wid = __builtin_amdgcn_readfirstlane(tid >> 6), lane = tid & 63, wr = wid >> 2, wc = wid & 3, fr = lane & 15, fq = lane >> 4;
    const int K = g.K, nt = K / BK;
    unsigned voffA[2], voffB[2];
#pragma unroll
    for (int i = 0; i < 2; ++i) { int R, C; stage_rc(tid * 16 + i * 8192, R, C); const int Rb = 64 * (R >> 5) + perm32(R & 31);
        voffA[i] = (unsigned)(R * g.lda + C) * 2u; voffB[i] = (unsigned)(Rb * g.ldb + C) * 2u; }
    const size_t kstep = (size_t)(BK * 2);
    const size_t hstepA = (size_t)HALF * g.lda * 2;
    const size_t hstepB = (size_t)32 * g.ldb * 2;
    const unsigned ldsw = (unsigned)wid * 1024u;
    const int aoff = lds_byte(wr * 64 + fr, fq * 8), boff = lds_byte(wc * 32 + fr, fq * 8);
#define PG8_SA(b, h) (((b) * 2 + (h)) * HTB)
#define PG8_SB(b, h) ((4 + (b) * 2 + (h)) * HTB)
#define PG8_STAGE(bufoff, gbase, voff) do { _Pragma("unroll") for (int _i = 0; _i < 2; ++_i) \
        __builtin_amdgcn_global_load_lds((const unsigned*)((const char*)(gbase) + (voff)[_i]), (PG8_LAS unsigned*)(lds + (bufoff) + ldsw + _i * 8192), 16, 0, 0); } while (0)
#define PG8_LDA(dst, b, h) do { if constexpr (F8) { _Pragma("unroll") for (int m = 0; m < 4; ++m) dst##8[m] = pg8_cat(*(const PG8_LAS bf16x8*)(lds + PG8_SA(b, h) + aoff + m * 2048), *(const PG8_LAS bf16x8*)(lds + PG8_SA(b, h) + aoff + m * 2048 + 1024)); } \
        else { _Pragma("unroll") for (int m = 0; m < 4; ++m) _Pragma("unroll") for (int k = 0; k < 2; ++k) dst[m][k] = *(const PG8_LAS bf16x8*)(lds + PG8_SA(b, h) + aoff + m * 2048 + k * 1024); } } while (0)
#define PG8_LDB(dst, b, h) do { if constexpr (F8) { _Pragma("unroll") for (int n = 0; n < 2; ++n) dst##8[n] = pg8_cat(*(const PG8_LAS bf16x8*)(lds + PG8_SB(b, h) + boff + n * 2048), *(const PG8_LAS bf16x8*)(lds + PG8_SB(b, h) + boff + n * 2048 + 1024)); } \
        else { _Pragma("unroll") for (int n = 0; n < 2; ++n) _Pragma("unroll") for (int k = 0; k < 2; ++k) dst[n][k] = *(const PG8_LAS bf16x8*)(lds + PG8_SB(b, h) + boff + n * 2048 + k * 1024); } } while (0)
#define PG8_MMA(ai, bj, At, Bt) do { __builtin_amdgcn_s_setprio(1); _Pragma("unroll") for (int m = 0; m < 4; ++m) _Pragma("unroll") for (int n = 0; n < 2; ++n) { \
        if constexpr (F8) { asm volatile("v_mfma_f32_16x16x128_f8f6f4 %0, %1, %2, %0" : "+v"(acc[ai][bj][m][n]) : "v"(Bt##8[n]), "v"(At##8[m])); }     \
        else if constexpr (I8) { _Pragma("unroll") for (int k = 0; k < 2; ++k) acc[ai][bj][m][n] = __builtin_bit_cast(f32x4, __builtin_amdgcn_mfma_i32_16x16x64_i8(__builtin_bit_cast(v4i32, Bt[n][k]), __builtin_bit_cast(v4i32, At[m][k]), __builtin_bit_cast(v4i32, acc[ai][bj][m][n]), 0, 0, 0)); } \
        else { _Pragma("unroll") for (int k = 0; k < 2; ++k) acc[ai][bj][m][n] = __builtin_amdgcn_mfma_f32_16x16x32_bf16(Bt[n][k], At[m][k], acc[ai][bj][m][n], 0, 0, 0); } } __builtin_amdgcn_s_setprio(0); } while (0)
#define PG8_WAIT_V(n) asm volatile("s_waitcnt vmcnt(" #n ")" ::: "memory")
#define PG8_WAIT_L(n) asm volatile("s_waitcnt lgkmcnt(" #n ")" ::: "memory")
#define PG8_BAR __builtin_amdgcn_s_barrier()
#define PG8_SCHED __builtin_amdgcn_sched_barrier(0)
    Unit cur, nxt; int ui = 0;
    if (!S.next(0, cur)) return;
    f32x4 acc[2][2][4][2];
#pragma unroll
    for (int a = 0; a < 2; ++a)
#pragma unroll
        for (int b = 0; b < 2; ++b)
#pragma unroll
            for (int m = 0; m < 4; ++m)
#pragma unroll
                for (int n = 0; n < 2; ++n) acc[a][b][m][n] = (f32x4){0.f, 0.f, 0.f, 0.f};
    bf16x8 At[4][2], B0[2][2], B1[2][2]; v8i32 At8[4], B08[2], B18[2];
#define PG8_APTR(u) (const char*)((SEG3 ? ((u).seg == 0 ? g.A : (u).seg == 1 ? g.A1 : g.A2) : g.A) + (size_t)(u).pm * g.sAm + (size_t)(u).pn * g.sAn)
#define PG8_BPTR(u) (const char*)(g.Bt + (SEG3 ? (size_t)(u).seg * g.sBseg : (size_t)0) + (size_t)(u).pn * g.sBn + (size_t)((u).pm >> 4) * g.sBb)
    const char* cA = PG8_APTR(cur); const char* cB = PG8_BPTR(cur);
    S.a_ready(cur);
    if constexpr (SP2) {
        PG8_STAGE(PG8_SB(0, 0), cB, voffB); PG8_STAGE(PG8_SB(0, 1), cB + hstepB, voffB); PG8_STAGE(PG8_SA(0, 0), cA, voffA); PG8_STAGE(PG8_SA(0, 1), cA + hstepA, voffA);
        if (wr == 1) PG8_BAR;
        PG8_WAIT_V(2); PG8_BAR;
        PG8_STAGE(PG8_SB(1, 0), cB + kstep, voffB); PG8_STAGE(PG8_SA(1, 0), cA + kstep, voffA); PG8_STAGE(PG8_SB(1, 1), cB + hstepB + kstep, voffB);
        PG8_WAIT_V(6); PG8_BAR;
    } else {
        PG8_STAGE(PG8_SB(0, 0), cB, voffB); PG8_STAGE(PG8_SA(0, 0), cA, voffA); PG8_STAGE(PG8_SB(0, 1), cB + hstepB, voffB); PG8_STAGE(PG8_SA(0, 1), cA + hstepA, voffA);
        if (wr == 1) PG8_BAR;
        PG8_WAIT_V(4); PG8_BAR;
        PG8_STAGE(PG8_SB(1, 0), cB + kstep, voffB); PG8_STAGE(PG8_SA(1, 0), cA + kstep, voffA); PG8_STAGE(PG8_SB(1, 1), cB + hstepB + kstep, voffB);
        PG8_WAIT_V(6); PG8_BAR;
    }
    for (;;) {
        const bool has_next = S.next(ui + 1, nxt);
        const char* nA = has_next ? PG8_APTR(nxt) : cA; const char* nB = has_next ? PG8_BPTR(nxt) : cB;
#pragma nounroll
        for (int t = 0; t < nt; t += 2) {
            const bool last = (t == nt - 2);
            const char* a1 = cA + (size_t)(t + 1) * kstep;
            const char* a2 = last ? nA : cA + (size_t)(t + 2) * kstep; const char* b2 = last ? nB : cB + (size_t)(t + 2) * kstep;
            const char* a3 = a2 + kstep; const char* b3 = b2 + kstep;
            if (last && has_next) S.a_ready(nxt);
            if constexpr (SP2) {
            PG8_LDB(B0, 0, 0); PG8_LDB(B1, 0, 1); PG8_SCHED; PG8_LDA(At, 0, 0); PG8_STAGE(PG8_SA(1, 1), a1 + hstepA, voffA);
            PG8_WAIT_V(8); PG8_WAIT_L(0); PG8_BAR; PG8_MMA(0, 0, At, B0); PG8_MMA(0, 1, At, B1); PG8_BAR; PG8_SCHED;
            PG8_LDA(At, 0, 1); PG8_STAGE(PG8_SB(0, 0), b2, voffB); PG8_STAGE(PG8_SB(0, 1), b2 + hstepB, voffB); PG8_STAGE(PG8_SA(0, 0), a2, voffA);
            PG8_WAIT_V(8); PG8_WAIT_L(0); PG8_BAR; PG8_MMA(1, 0, At, B0); PG8_MMA(1, 1, At, B1); PG8_BAR; PG8_SCHED;
            PG8_LDB(B0, 1, 0); PG8_LDB(B1, 1, 1); PG8_SCHED; PG8_LDA(At, 1, 0); PG8_STAGE(PG8_SA(0, 1), a2 + hstepA, voffA);
            PG8_WAIT_V(8); PG8_WAIT_L(0); PG8_BAR; PG8_MMA(0, 0, At, B0); PG8_MMA(0, 1, At, B1); PG8_BAR; PG8_SCHED;
            PG8_LDA(At, 1, 1); PG8_STAGE(PG8_SB(1, 0), b3, voffB); PG8_STAGE(PG8_SB(1, 1), b3 + hstepB, voffB); PG8_STAGE(PG8_SA(1, 0), a3, voffA);
            PG8_WAIT_V(8); PG8_WAIT_L(0); PG8_BAR; PG8_MMA(1, 0, At, B0); PG8_MMA(1, 1, At, B1); PG8_BAR; PG8_SCHED;
            } else {
            PG8_LDB(B0, 0, 0); PG8_SCHED; PG8_LDA(At, 0, 0); PG8_STAGE(PG8_SA(1, 1), a1 + hstepA, voffA);
            PG8_WAIT_L(8); PG8_BAR; PG8_WAIT_L(0); PG8_MMA(0, 0, At, B0); PG8_BAR; PG8_SCHED;
            PG8_LDB(B1, 0, 1); PG8_STAGE(PG8_SB(0, 0), b2, voffB);
            PG8_BAR; PG8_WAIT_L(0); PG8_MMA(0, 1, At, B1); PG8_BAR;
            PG8_LDA(At, 0, 1); PG8_STAGE(PG8_SA(0, 0), a2, voffA);
            PG8_BAR; PG8_WAIT_L(0); PG8_MMA(1, 0, At, B0); PG8_BAR; PG8_SCHED;
            PG8_STAGE(PG8_SB(0, 1), b2 + hstepB, voffB);
            PG8_WAIT_V(6); PG8_BAR; PG8_MMA(1, 1, At, B1); PG8_BAR;
            PG8_LDB(B0, 1, 0); PG8_SCHED; PG8_LDA(At, 1, 0); PG8_STAGE(PG8_SA(0, 1), a2 + hstepA, voffA);
            PG8_WAIT_L(8); PG8_BAR; PG8_WAIT_L(0); PG8_MMA(0, 0, At, B0); PG8_BAR; PG8_SCHED;
            PG8_LDB(B1, 1, 1); PG8_STAGE(PG8_SB(1, 0), b3, voffB);
            PG8_BAR; PG8_WAIT_L(0); PG8_MMA(0, 1, At, B1); PG8_BAR;
            PG8_LDA(At, 1, 1); PG8_STAGE(PG8_SA(1, 0), a3, voffA);
            PG8_BAR; PG8_WAIT_L(0); PG8_MMA(1, 0, At, B0); PG8_BAR; PG8_SCHED;
            PG8_STAGE(PG8_SB(1, 1), b3 + hstepB, voffB);
            PG8_WAIT_V(6); PG8_BAR; PG8_MMA(1, 1, At, B1); PG8_BAR;
            }
        }
        if constexpr (ALIGN_EPI) { if (wr == 0) PG8_BAR; }
        E(acc, cur, wr, wc, fr, fq); S.done(cur);
        if (!has_next) break;
        if (!(SEG3 && cur.seg < 2))
#pragma unroll
        for (int a = 0; a < 2; ++a)
#pragma unroll
            for (int b = 0; b < 2; ++b)
#pragma unroll
                for (int m = 0; m < 4; ++m)
#pragma unroll
                    for (int n = 0; n < 2; ++n) acc[a][b][m][n] = (f32x4){0.f, 0.f, 0.f, 0.f};
        cur = nxt; cA = nA; cB = nB; ++ui;
        if constexpr (ALIGN_EPI) { if (wr == 1) PG8_BAR; }
    }
    PG8_WAIT_V(0);
    if constexpr (!ALIGN_EPI) { if (wr == 0) PG8_BAR; }
    PG8_BAR;
#undef PG8_APTR
#undef PG8_BPTR
#undef PG8_SA
#undef PG8_SB
#undef PG8_STAGE
#undef PG8_LDA
#undef PG8_LDB
#undef PG8_MMA
#undef PG8_WAIT_V
#undef PG8_WAIT_L
#undef PG8_BAR
#undef PG8_SCHED
}
}
#include <hip/hip_bf16.h>
#include <cmath>
namespace attn_body {
using bf16=__hip_bfloat16;
using bf16x8=__attribute__((ext_vector_type(8)))short;
using s16x4=__attribute__((ext_vector_type(4)))short;
using f32x16=__attribute__((ext_vector_type(16)))float;
using u32x4=__attribute__((ext_vector_type(4)))unsigned;
constexpr int BATCH=8,NHEAD=16,SEQ=4096,D=64,DM=NHEAD*D;
constexpr int NW=8,QBLK=32,QB=QBLK*NW,KVBLK=64,NQB=SEQ/QB;
constexpr int ATTN_PITCH=DM, ATTN_UNIT_ROWS=QB;
__device__ __forceinline__ int crow(int r,int hi){return (r&3)+8*(r>>2)+4*hi;}
#define SBAR() __builtin_amdgcn_sched_barrier(0)
__device__ __forceinline__ void cmask(f32x16&p0,f32x16&p1,int jb,int qrel,int hi){
  const float NEG=-INFINITY; int kb=64*jb+4*hi;
  #pragma unroll
  for(int r=0;r<16;++r){int kv=kb+(r&3)+8*(r>>2); if(kv>qrel)p0[r]=NEG; if(kv+32>qrel)p1[r]=NEG;}
}

constexpr int NSLOT=3, SLOTB=8192;
constexpr int VSLOTB=2*SLOTB;
constexpr int LDS_K=0, LDS_V=NSLOT*SLOTB, LDS_WS=LDS_V+NSLOT*VSLOTB, LDS_OST=LDS_WS+NW*64*4, LDS_BYTES=LDS_OST+NW*4096;
constexpr float C2=0.125f*1.4426950408889634f;
__device__ __forceinline__ void glds16(const void*gsrc,unsigned lds_dst){unsigned keep;
  asm volatile("s_mov_b32 %0, m0\n\ts_mov_b32 m0, %2\n\ts_nop 0\n\tglobal_load_lds_dwordx4 %1, off\n\ts_mov_b32 m0, %0":"=&s"(keep):"v"(gsrc),"s"(lds_dst):"memory");}
__device__ __forceinline__ float max3f(float a,float b,float c){float r;asm("v_max3_f32 %0, %1, %2, %3":"=v"(r):"v"(a),"v"(b),"v"(c));return r;}
__device__ __forceinline__ float max2f(float a,float b){float r;asm("v_max_f32_e32 %0, %1, %2":"=v"(r):"v"(a),"v"(b));return r;}
__device__ __forceinline__ float fadd_s(float a,float b){float r;asm("v_add_f32_e32 %0, %1, %2":"=v"(r):"v"(a),"v"(b));return r;}
__device__ __forceinline__ float fsub_s(float a,float b){float r;asm("v_sub_f32_e32 %0, %1, %2":"=v"(r):"v"(a),"v"(b));return r;}
typedef float f32x2_t __attribute__((ext_vector_type(2))); typedef __bf16 bf16x2_t __attribute__((ext_vector_type(2)));
__device__ __forceinline__ unsigned cvtpk_s(float lo,float hi){f32x2_t v={lo,hi};bf16x2_t b=__builtin_convertvector(v,bf16x2_t);return __builtin_bit_cast(unsigned,b);}
#define WAIT_BAR(N) asm volatile("s_waitcnt vmcnt(" #N ") lgkmcnt(0)\n\ts_barrier":::"memory")

__device__ __forceinline__ void qkt(f32x16&p0,f32x16&p1,const char*Kslot,const bf16x8*qr,const f32x16&negm,int r32,int hi){
  const char*kb=Kslot+hi*1024+r32*16;
  #pragma unroll
  for(int d0=0;d0<4;++d0){
    const bf16x8 b0=*reinterpret_cast<const bf16x8*>(kb+d0*2048);
    const bf16x8 b1=*reinterpret_cast<const bf16x8*>(kb+d0*2048+512);
    if(d0==0){p0=__builtin_amdgcn_mfma_f32_32x32x16_bf16(b0,qr[0],negm,0,0,0);p1=__builtin_amdgcn_mfma_f32_32x32x16_bf16(b1,qr[0],negm,0,0,0);}
    else{p0=__builtin_amdgcn_mfma_f32_32x32x16_bf16(b0,qr[d0],p0,0,0,0);p1=__builtin_amdgcn_mfma_f32_32x32x16_bf16(b1,qr[d0],p1,0,0,0);}}
}
typedef __attribute__((address_space(3))) const char* lds_cptr;
typedef short v4i16_t __attribute__((ext_vector_type(4)));
__device__ __forceinline__ void kload8(bf16x8*kf,lds_cptr kp){
  kf[0]=*(const __attribute__((address_space(3))) bf16x8*)(kp);      kf[1]=*(const __attribute__((address_space(3))) bf16x8*)(kp+512);
  kf[2]=*(const __attribute__((address_space(3))) bf16x8*)(kp+2048); kf[3]=*(const __attribute__((address_space(3))) bf16x8*)(kp+2560);
  kf[4]=*(const __attribute__((address_space(3))) bf16x8*)(kp+4096); kf[5]=*(const __attribute__((address_space(3))) bf16x8*)(kp+4608);
  kf[6]=*(const __attribute__((address_space(3))) bf16x8*)(kp+6144); kf[7]=*(const __attribute__((address_space(3))) bf16x8*)(kp+6656);
}
__device__ __forceinline__ void kload2(bf16x8*kf,lds_cptr kp,int j){ kf[2*j]=*(const __attribute__((address_space(3))) bf16x8*)(kp+j*2048); kf[2*j+1]=*(const __attribute__((address_space(3))) bf16x8*)(kp+j*2048+512); }
__device__ __forceinline__ s16x4 vtr(lds_cptr p){ return __builtin_bit_cast(s16x4,__builtin_amdgcn_ds_read_tr16_b64_v4i16((__attribute__((address_space(3))) v4i16_t*)p)); }
__device__ __forceinline__ float rowmax(const f32x16&p0,const f32x16&p1){
  float a=max3f(p0[0],p0[1],p1[0]),b=max3f(p0[2],p0[3],p1[1]);a=max3f(a,p1[2],p1[3]);
  #pragma unroll
  for(int r=4;r<16;r+=4){a=max3f(a,p0[r],p0[r+1]);b=max3f(b,p0[r+2],p0[r+3]);a=max3f(a,p1[r],p1[r+1]);b=max3f(b,p1[r+2],p1[r+3]);}
  const float m=max2f(a,b);
  auto rr=__builtin_amdgcn_permlane32_swap(__float_as_uint(m),__float_as_uint(m),false,false);
  return max2f(__uint_as_float(rr[0]),__uint_as_float(rr[1]));
}
__device__ __forceinline__ void pv(f32x16*o,int vb,bf16x8 pa0,bf16x8 pa1,bf16x8 pa2,bf16x8 pa3){
  #pragma unroll
  for(int d0=0;d0<4;++d0){s16x4 lo[4],hi[4];
    #pragma unroll
    for(int ks=0;ks<4;++ks){
      asm volatile("ds_read_b64_tr_b16 %0,%1 offset:%c2":"=&v"(lo[ks]):"v"(vb),"i"(d0*4096+ks*1024):"memory");
      asm volatile("ds_read_b64_tr_b16 %0,%1 offset:%c2":"=&v"(hi[ks]):"v"(vb),"i"(d0*4096+ks*1024+512):"memory");}
    asm volatile("s_waitcnt lgkmcnt(0)":::"memory");SBAR();
    #define PK(k) (bf16x8){lo[k][0],lo[k][1],lo[k][2],lo[k][3],hi[k][0],hi[k][1],hi[k][2],hi[k][3]}
    o[d0]=__builtin_amdgcn_mfma_f32_32x32x16_bf16(pa0,PK(0),o[d0],0,0,0);
    o[d0]=__builtin_amdgcn_mfma_f32_32x32x16_bf16(pa1,PK(1),o[d0],0,0,0);
    o[d0]=__builtin_amdgcn_mfma_f32_32x32x16_bf16(pa2,PK(2),o[d0],0,0,0);
    o[d0]=__builtin_amdgcn_mfma_f32_32x32x16_bf16(pa3,PK(3),o[d0],0,0,0);
    #undef PK
  }
}

#ifndef ATTN_STORE16
#define ATTN_STORE16(p,v) (*(u32x4*)(p)=(v))
#endif
template<int THRL,int MODE> __device__ __forceinline__ void attn_unit(int b,int h,int hv,int qb,const bf16*Q,const bf16*__restrict__ K,const bf16*__restrict__ V,bf16*O,bf16*OUT,float lam,const float*sg,char*shm,
    bool pre,bool has_next,int nb,int nh,int nhv,int nqb,bf16x8 (&qr)[4]){
  int tid_=threadIdx.x; asm volatile("":"+v"(tid_));
  const int tid=tid_,lane=tid&63,r32=lane&31,hi=lane>>5; const int wid=__builtin_amdgcn_readfirstlane(tid>>6);
  if(wid>=4)__builtin_amdgcn_s_setprio(1);
  const long rowbase=(long)b*SEQ; const int q0=qb*QB;
  const bf16*Qw=Q+(rowbase+q0+wid*QBLK)*DM+h*D;
  const bf16*Kh=K+rowbase*DM+h*D,*Vh=V+rowbase*DM+hv*D;
  const unsigned lds0=(unsigned)(uintptr_t)shm;
  float*wsf=(float*)(shm+LDS_WS)+wid*64;
  const bf16*ksrc=Kh+(long)lane*DM+wid*8;
  const bf16*vsrc=Vh+(long)(16*(wid&3)+(lane>>2))*DM+(wid>>2)*32+(lane&3)*8;
  const unsigned kdst=lds0+LDS_K+wid*1024, vdst=lds0+LDS_V+wid*1024;
  #define DMA_K(t,slot) glds16(ksrc+(long)(t)*KVBLK*DM,(unsigned)__builtin_amdgcn_readfirstlane(kdst+(slot)))
  #define DMA_V(t,slot) do{ glds16(vsrc+(long)(t)*KVBLK*DM,(unsigned)__builtin_amdgcn_readfirstlane(vdst+2*(slot))); glds16(vsrc+64+(long)(t)*KVBLK*DM,(unsigned)__builtin_amdgcn_readfirstlane(vdst+2*(slot)+SLOTB)); }while(0)
  const int vb0=(int)(lds0+LDS_V)+((lane>>4)&1)*32+(lane&3)*8+(4*hi+((lane&15)>>2))*64;
  const char*Kbase=shm+LDS_K; bf16x8 kf[8];
  const lds_cptr shm3=(lds_cptr)shm; const lds_cptr kp0=shm3+LDS_K+hi*1024+r32*16; const lds_cptr vp0=shm3+LDS_V+((lane>>4)&1)*32+(lane&3)*8+(4*hi+((lane&15)>>2))*64;
  const int NT=(q0+QB)/KVBLK;
  if(!pre){
  DMA_K(0,0);DMA_V(0,0);DMA_K(1,SLOTB);
  #pragma unroll
  for(int d0=0;d0<4;++d0)qr[d0]=*reinterpret_cast<const bf16x8*>(&Qw[(long)r32*DM+d0*16+hi*8]);
  }
  float l_reg=0.f;f32x16 o[4];o[0]=f32x16{};o[1]=f32x16{};o[2]=f32x16{};o[3]=f32x16{};const f32x16 negm=f32x16{};
  const int qrel=wid*QBLK+r32;
  #define CMASK(P0,P1,t) do{int jb_=(t)-(NT-4); if(jb_>=0)cmask(P0,P1,jb_,qrel,hi);}while(0)
  #define START(P0,P1) do{ _Pragma("unroll") for(int r=0;r<16;++r)P0[r]=__builtin_amdgcn_exp2f(P0[r]); }while(0)
  #define RESC() do{}while(0)
  f32x16 pA0,pA1,pB0,pB1;
  int sl_prev=0,sl_cur=0,sl_next=SLOTB;
  #define ROT() do{sl_prev=sl_cur;sl_cur=sl_next;sl_next=(sl_next==(NSLOT-1)*SLOTB)?0:sl_next+SLOTB;}while(0)
  DMA_K(2,2*SLOTB);
  WAIT_BAR(4);
  qkt(pA0,pA1,Kbase,qr,negm,r32,hi);asm volatile("s_nop 15\n\ts_nop 7":"+v"(pA0),"+v"(pA1));CMASK(pA0,pA1,0);
  START(pA0,pA1);
  _Pragma("unroll") for(int r=0;r<16;++r)pA1[r]=__builtin_amdgcn_exp2f(pA1[r]);
  WAIT_BAR(0);
  DMA_K(3,0);DMA_V(1,SLOTB);
  ROT();
  kload8(kf,kp0+sl_cur);
  WAIT_BAR(3);
  s16x4 vlo[8],vhi[8],wlo[8],whi[8]; u32x4 pw0,pw1,pw2,pw3;
  #define PKW(P,B) cvtpk_s(P[B],P[B+1])
  #define PAF(k) __builtin_bit_cast(bf16x8,pw##k)
  #define VFR(i) (bf16x8){vlo[i][0],vlo[i][1],vlo[i][2],vlo[i][3],vhi[i][0],vhi[i][1],vhi[i][2],vhi[i][3]}
  #define PIN(x) asm volatile("":"+v"(x))
  #define MX3(a,b,c) __builtin_fmaxf(__builtin_fmaxf((a),(b)),(c))
  #define GAPA(MF,A0,A1,A2,A3,W0,W1,PW) do{ MF; sacc+=A0; sacc+=A1; sacc+=A2; sacc+=A3; PIN(sacc); W0; W1; PIN(PW); SBAR(); }while(0)
  #define EX(v) __builtin_amdgcn_exp2f(v)
  #define GAPB(MF,X,B) do{ MF; X[B]=EX(X[B]); X[B+1]=EX(X[B+1]); X[B+2]=EX(X[B+2]); X[B+3]=EX(X[B+3]); PIN(X); SBAR(); }while(0)
  #define VRD(i) do{ vlo[i]=vtr(vp_+(((i)>>2)*4096+((i)&3)*1024)); vhi[i]=vtr(vp_+(((i)>>2)*4096+((i)&3)*1024+512)); }while(0)
  #define VRD1(i) do{ wlo[i]=vtr(vp_+(SLOTB+((i)>>2)*4096+((i)&3)*1024)); whi[i]=vtr(vp_+(SLOTB+((i)>>2)*4096+((i)&3)*1024+512)); SBAR(); }while(0)
  #define VFR1(i) (bf16x8){wlo[i][0],wlo[i][1],wlo[i][2],wlo[i][3],whi[i][0],whi[i][1],whi[i][2],whi[i][3]}
  #define GAPB2(MF,MG,X,B) do{ MF; MG; X[B]=EX(X[B]); X[B+1]=EX(X[B+1]); X[B+2]=EX(X[B+2]); X[B+3]=EX(X[B+3]); PIN(X); SBAR(); }while(0)
  #define KRD(G,j) do{ if(G){ kload2(kf,kp0+sl_next,j); SBAR(); } }while(0)
  #define STEP(C0,C1,P0,P1,t,GK,GV,GL) do{ SBAR(); \
    const lds_cptr vp_=vp0+2*sl_prev; \
    VRD(0); SBAR(); float sacc=(P0[0]+P0[1]); \
    GAPA(C0=__builtin_amdgcn_mfma_f32_32x32x16_bf16(kf[0],qr[0],negm,0,0,0), P0[2],P0[3],P0[4],P0[5],     pw0[0]=PKW(P0,0), pw0[1]=PKW(P0,2), pw0); \
    VRD(4); SBAR(); GAPA(C1=__builtin_amdgcn_mfma_f32_32x32x16_bf16(kf[1],qr[0],negm,0,0,0), P0[6],P0[7],P0[8],P0[9],     pw0[2]=PKW(P0,4), pw0[3]=PKW(P0,6), pw0); \
    VRD(1); SBAR(); GAPA(C0=__builtin_amdgcn_mfma_f32_32x32x16_bf16(kf[2],qr[1],C0,0,0,0),   P0[10],P0[11],P0[12],P0[13], pw1[0]=PKW(P0,8), pw1[1]=PKW(P0,10), pw1); \
    VRD(5); SBAR(); GAPA(C1=__builtin_amdgcn_mfma_f32_32x32x16_bf16(kf[3],qr[1],C1,0,0,0),   P0[14],P0[15],P1[0],P1[1],   pw1[2]=PKW(P0,12),pw1[3]=PKW(P0,14), pw1); \
    VRD(2); SBAR(); GAPA(C0=__builtin_amdgcn_mfma_f32_32x32x16_bf16(kf[4],qr[2],C0,0,0,0),   P1[2],P1[3],P1[4],P1[5],     pw2[0]=PKW(P1,0), pw2[1]=PKW(P1,2), pw2); VRD1(0); \
    VRD(6); SBAR(); GAPA(C1=__builtin_amdgcn_mfma_f32_32x32x16_bf16(kf[5],qr[2],C1,0,0,0),   P1[6],P1[7],P1[8],P1[9],     pw2[2]=PKW(P1,4), pw2[3]=PKW(P1,6), pw2); VRD1(4); \
    VRD(3); SBAR(); GAPA(C0=__builtin_amdgcn_mfma_f32_32x32x16_bf16(kf[6],qr[3],C0,0,0,0),   P1[10],P1[11],P1[12],P1[13], pw3[0]=PKW(P1,8), pw3[1]=PKW(P1,10), pw3); VRD1(1); \
    VRD(7); SBAR(); GAPA(C1=__builtin_amdgcn_mfma_f32_32x32x16_bf16(kf[7],qr[3],C1,0,0,0),   P1[14],P1[15],0.f,0.f,       pw3[2]=PKW(P1,12),pw3[3]=PKW(P1,14), pw3); VRD1(5); \
    l_reg+=sacc; \
    if(GK){DMA_K((t)+3,sl_cur);} if(GV){DMA_V((t)+1,sl_next);} \
    CMASK(C0,C1,t); \
    SBAR(); \
      \
    GAPB(o[0]=__builtin_amdgcn_mfma_f32_32x32x16_bf16(PAF(0),VFR(0),o[0],0,0,0), C0,0); VRD1(2); \
    GAPB2(o[1]=__builtin_amdgcn_mfma_f32_32x32x16_bf16(PAF(0),VFR(4),o[1],0,0,0), o[2]=__builtin_amdgcn_mfma_f32_32x32x16_bf16(PAF(0),VFR1(0),o[2],0,0,0), C0,4); VRD1(6); \
    KRD(GL,0); GAPB2(o[0]=__builtin_amdgcn_mfma_f32_32x32x16_bf16(PAF(1),VFR(1),o[0],0,0,0), o[3]=__builtin_amdgcn_mfma_f32_32x32x16_bf16(PAF(0),VFR1(4),o[3],0,0,0), C0,8); VRD1(3); \
    KRD(GL,1); GAPB2(o[1]=__builtin_amdgcn_mfma_f32_32x32x16_bf16(PAF(1),VFR(5),o[1],0,0,0), o[2]=__builtin_amdgcn_mfma_f32_32x32x16_bf16(PAF(1),VFR1(1),o[2],0,0,0), C0,12); VRD1(7); \
    KRD(GL,2); GAPB2(o[0]=__builtin_amdgcn_mfma_f32_32x32x16_bf16(PAF(2),VFR(2),o[0],0,0,0), o[3]=__builtin_amdgcn_mfma_f32_32x32x16_bf16(PAF(1),VFR1(5),o[3],0,0,0), C1,0); \
    KRD(GL,3); GAPB2(o[1]=__builtin_amdgcn_mfma_f32_32x32x16_bf16(PAF(2),VFR(6),o[1],0,0,0), o[2]=__builtin_amdgcn_mfma_f32_32x32x16_bf16(PAF(2),VFR1(2),o[2],0,0,0), C1,4); \
    GAPB2(o[0]=__builtin_amdgcn_mfma_f32_32x32x16_bf16(PAF(3),VFR(3),o[0],0,0,0), o[3]=__builtin_amdgcn_mfma_f32_32x32x16_bf16(PAF(2),VFR1(6),o[3],0,0,0), C1,8); \
    GAPB2(o[1]=__builtin_amdgcn_mfma_f32_32x32x16_bf16(PAF(3),VFR(7),o[1],0,0,0), o[2]=__builtin_amdgcn_mfma_f32_32x32x16_bf16(PAF(3),VFR1(3),o[2],0,0,0), C1,12); \
    o[3]=__builtin_amdgcn_mfma_f32_32x32x16_bf16(PAF(3),VFR1(7),o[3],0,0,0); SBAR(); \
    }while(0)
  int t=1;
  #undef CMASK
  #define CMASK(P0,P1,t) do{int jb_=(t)-(NT-4); if(jb_>=0)cmask(P0,P1,jb_,qrel,hi);}while(0)
  for(;t+3<NT;t+=2){
    STEP(pB0,pB1,pA0,pA1,t,true,true,true);     WAIT_BAR(3); RESC(); ROT();
    STEP(pA0,pA1,pB0,pB1,t+1,true,true,true);   WAIT_BAR(3); RESC(); ROT();
  }
  #undef CMASK
  #define CMASK(P0,P1,t) do{int jb_=(t)-(NT-4); if(jb_>=0)cmask(P0,P1,jb_,qrel,hi);}while(0)
  #define ENDW(tt) do{ if((tt)+3<NT){WAIT_BAR(3);} else if((tt)+2<NT){WAIT_BAR(2);} else {WAIT_BAR(0);} }while(0)
  #define PVTAIL(P0,P1,slot) do{ float sacc=P0[0]+P0[1]; _Pragma("unroll") for(int r=2;r<16;++r)sacc+=P0[r]; _Pragma("unroll") for(int r=0;r<16;++r)sacc+=P1[r]; l_reg+=sacc; \
    pw0=(u32x4){PKW(P0,0),PKW(P0,2),PKW(P0,4),PKW(P0,6)};pw1=(u32x4){PKW(P0,8),PKW(P0,10),PKW(P0,12),PKW(P0,14)};pw2=(u32x4){PKW(P1,0),PKW(P1,2),PKW(P1,4),PKW(P1,6)};pw3=(u32x4){PKW(P1,8),PKW(P1,10),PKW(P1,12),PKW(P1,14)}; \
    SBAR(); pv(o,vb0+2*(slot),PAF(0),PAF(1),PAF(2),PAF(3)); }while(0)
  STEP(pB0,pB1,pA0,pA1,NT-3,false,true,true);  WAIT_BAR(2); ROT();
  int vslot=sl_prev;
  if(wid>=4){ STEP(pA0,pA1,pB0,pB1,NT-2,false,true,true); WAIT_BAR(0); ROT();
              if(wid>=6){ STEP(pB0,pB1,pA0,pA1,NT-1,false,false,false); vslot=sl_cur; }
              else { pB0=pA0; pB1=pA1; vslot=sl_prev; } }
  else { SBAR(); DMA_V(NT-1,sl_next); WAIT_BAR(0); }
  PVTAIL(pB0,pB1,vslot);
  #undef PVTAIL
  #undef PKW
  #undef PAF
  #undef VFR
  #undef PIN
  #undef MX3
  #undef GAPA
  #undef GAPB
  #undef EX
  #undef VRD
  #undef VRD1
  #undef VFR1
  #undef GAPB2
  #undef KRD
  #undef STEP
  #undef ENDW
  asm volatile("s_waitcnt lgkmcnt(0)\n\ts_barrier":::"memory");
  u32x4 o0v[2][4];
  if(MODE==1){ const bf16*Ow0=O+(rowbase+q0+wid*QBLK)*DM+hv*D;
    #pragma unroll
    for(int hf=0;hf<2;++hf)
      #pragma unroll
      for(int i=0;i<4;++i)o0v[hf][i]=*(const u32x4*)(Ow0+(long)(i*8+(lane>>3))*DM+hf*64+(lane&7)*8); }
  bf16x8 qn[4];
  if(has_next){
    const long nrow=(long)nb*SEQ;
    const bf16*nks=K+nrow*DM+nh*D+(long)lane*DM+wid*8;
    const bf16*nvs=V+nrow*DM+nhv*D+(long)(16*(wid&3)+(lane>>2))*DM+(wid>>2)*32+(lane&3)*8;
    glds16(nks,(unsigned)__builtin_amdgcn_readfirstlane(kdst));
    glds16(nvs,(unsigned)__builtin_amdgcn_readfirstlane(vdst)); glds16(nvs+64,(unsigned)__builtin_amdgcn_readfirstlane(vdst+SLOTB));
    glds16(nks+(long)KVBLK*DM,(unsigned)__builtin_amdgcn_readfirstlane(kdst+SLOTB));
    const bf16*nQw=Q+(nrow+nqb*QB+wid*QBLK)*DM+nh*D;
    #pragma unroll
    for(int d0=0;d0<4;++d0)qn[d0]=*reinterpret_cast<const bf16x8*>(&nQw[(long)r32*DM+d0*16+hi*8]);
  }
  {auto rr=__builtin_amdgcn_permlane32_swap(__float_as_uint(l_reg),__float_as_uint(l_reg),false,false);l_reg=__uint_as_float(rr[0])+__uint_as_float(rr[1]);}
  if(hi==0)wsf[32+r32]=l_reg;asm volatile("s_waitcnt lgkmcnt(0)":::"memory");
  float rli[16];
  #pragma unroll
  for(int r=0;r<16;++r)rli[r]=__builtin_amdgcn_rcpf(wsf[32+crow(r,hi)]);
  bf16*Ow=O+(rowbase+q0+wid*QBLK)*DM+hv*D;
  { bf16*stg=(bf16*)(shm+LDS_OST)+wid*2048;
    float cmb[2][4][8];
    #pragma unroll
    for(int hf=0;hf<2;++hf){
    #pragma unroll
    for(int r=0;r<16;++r){const int orow=crow(r,hi);
      #pragma unroll
      for(int d0=0;d0<2;++d0)stg[orow*64+d0*32+r32]=__float2bfloat16(o[2*hf+d0][r]*rli[r]);}
    asm volatile("s_waitcnt lgkmcnt(0)":::"memory");
    #pragma unroll
    for(int i=0;i<4;++i){const int row=i*8+(lane>>3),ch=lane&7; const u32x4 v=*(const u32x4*)(stg+row*64+ch*8);
      if(MODE==0){ ATTN_STORE16(Ow+(long)row*DM+hf*64+ch*8,v); }
      else { const u32x4 w=o0v[hf][i];
        cmb[hf][i][0]=__uint_as_float(w.x<<16)-lam*__uint_as_float(v.x<<16); cmb[hf][i][1]=__uint_as_float(w.x&0xffff0000u)-lam*__uint_as_float(v.x&0xffff0000u);
        cmb[hf][i][2]=__uint_as_float(w.y<<16)-lam*__uint_as_float(v.y<<16); cmb[hf][i][3]=__uint_as_float(w.y&0xffff0000u)-lam*__uint_as_float(v.y&0xffff0000u);
        cmb[hf][i][4]=__uint_as_float(w.z<<16)-lam*__uint_as_float(v.z<<16); cmb[hf][i][5]=__uint_as_float(w.z&0xffff0000u)-lam*__uint_as_float(v.z&0xffff0000u);
        cmb[hf][i][6]=__uint_as_float(w.w<<16)-lam*__uint_as_float(v.w<<16); cmb[hf][i][7]=__uint_as_float(w.w&0xffff0000u)-lam*__uint_as_float(v.w&0xffff0000u); } }
    asm volatile("s_waitcnt lgkmcnt(0)":::"memory"); }
    if(MODE==1){ bf16*Uw=OUT+(rowbase+q0+wid*QBLK)*DM+hv*D; const int ch=lane&7;
      #pragma unroll
      for(int i=0;i<4;++i){ float ss=0.f;
        #pragma unroll
        for(int hf=0;hf<2;++hf){
          #pragma unroll
          for(int e=0;e<8;++e)ss+=cmb[hf][i][e]*cmb[hf][i][e]; }
        ss+=__shfl_xor(ss,1);ss+=__shfl_xor(ss,2);ss+=__shfl_xor(ss,4);
        const float rstd=0.8f*__builtin_amdgcn_rsqf(ss*(1.0f/128.0f)+1e-6f);
        const int row=i*8+(lane>>3);
        #pragma unroll
        for(int hf=0;hf<2;++hf){ const float*g=sg+hf*64+ch*8; u32x4 w;
          w.x=cvtpk_s(cmb[hf][i][0]*rstd*g[0],cmb[hf][i][1]*rstd*g[1]); w.y=cvtpk_s(cmb[hf][i][2]*rstd*g[2],cmb[hf][i][3]*rstd*g[3]);
          w.z=cvtpk_s(cmb[hf][i][4]*rstd*g[4],cmb[hf][i][5]*rstd*g[5]); w.w=cvtpk_s(cmb[hf][i][6]*rstd*g[6],cmb[hf][i][7]*rstd*g[7]);
          ATTN_STORE16(Uw+(long)row*DM+hf*64+ch*8,w); } } } }
  __builtin_amdgcn_s_setprio(0);
  if(has_next){
    #pragma unroll
    for(int d0=0;d0<4;++d0)qr[d0]=qn[d0];
  }
  #undef DMA_K
  #undef DMA_V
  #undef CMASK
  #undef START
  #undef RESC
  #undef ROT
}
constexpr int ATTN_LDS_BYTES=LDS_BYTES;
struct AttnTensors { const bf16* Q; const bf16* K; const bf16* V; bf16* O0; bf16* OUT; const float* sg; float lam; };
struct AttnUnit { int bh; int qb; };
struct AttnOrder {
  int vcu, G;
  __device__ __forceinline__ bool next(int i,AttnUnit&u)const{ const int L=i*G+vcu; if(L>=BATCH*8*NQB)return false; const int j=L&3, ii=L>>8; u.bh=(L&255)>>2; u.qb=(ii==0)?15-j:(ii==1)?8+j:(ii==2)?7-j:j; return true; }
};
template<int THRL=8> __device__ __forceinline__ void attn_phase(char*lds,const AttnTensors&T,const AttnOrder&S){
  AttnUnit u,un; un.bh=0; un.qb=0; bf16x8 qr[4]; bool pre=false;
  for(int i=0;S.next(i,u);++i){
    const bool hn=S.next(i+1,un);
    const int b=u.bh>>3, h=u.bh&7, nb=un.bh>>3, nh=un.bh&7;
    attn_unit<THRL,0>(b,2*h,2*h,u.qb,T.Q,T.K,T.V,T.O0,T.OUT,T.lam,T.sg,lds, pre,true,b,2*h+1,2*h,u.qb,qr);
    attn_unit<THRL,1>(b,2*h+1,2*h,u.qb,T.Q,T.K,T.V,T.O0,T.OUT,T.lam,T.sg,lds, true,hn,nb,2*nh,2*nh,un.qb,qr);
    pre=true;
  }
  asm volatile("s_waitcnt vmcnt(0) lgkmcnt(0)\n\ts_barrier":::"memory");
}
#undef SBAR
#undef WAIT_BAR
}

constexpr int NWAVES = 8;
constexpr int BATCH = 8, T = 4096, D = 1024, FF = 4096, MEMLEN = 256;
constexpr int M = BATCH * T;
constexpr int MM = BATCH * MEMLEN;
constexpr int NPROJ1 = 7 * D;
constexpr int PROJW = 10 * D;
constexpr size_t MiB = 1u << 20;
constexpr size_t WS_CTL = 0, CTL_ZERO_BYTES = 128 * 1024;
constexpr size_t WS_WIN = 1 * MiB;
constexpr size_t WS_WA = 21 * MiB, WS_WC = 23 * MiB, WS_WM = 25 * MiB, WS_WO = 27 * MiB;
constexpr size_t WS_WKV = 29 * MiB;
constexpr size_t WS_W1 = 33 * MiB;
constexpr size_t WS_W2 = 41 * MiB;
constexpr size_t WS_MEMN = 49 * MiB;
constexpr size_t WS_KP = 53 * MiB;
constexpr size_t WS_VT = 57 * MiB;
constexpr size_t WS_STATS = 61 * MiB;
constexpr size_t REG = 64 * MiB;
constexpr size_t WS_R1 = 1 * REG;
constexpr size_t WS_R2 = 2 * REG;
constexpr size_t WS_R3 = 3 * REG;
constexpr size_t WS_R4 = 4 * REG;
constexpr size_t WS_R5 = 5 * REG;
constexpr size_t WS_R6 = 6 * REG;
constexpr size_t WS_R7 = 7 * REG;
constexpr size_t WS_XN8 = WS_R7;
constexpr size_t WS_W8 = WS_WIN;
constexpr size_t WS_XSC = 63 * MiB;
constexpr size_t WS_WSC = 63 * MiB + 256 * 1024;
constexpr int CW_WMAX = 16384;
constexpr size_t WS_END = 8 * REG;
constexpr int CW_BAR = 4096;

constexpr int RING_OFF = 0, RING_BYTES = 131072;
constexpr int LDSCTL_OFF = RING_BYTES, MISC_OFF = LDSCTL_OFF + 320;
constexpr int XCH_OFF = RING_BYTES + 1024;
constexpr int LDS_BYTES = 147456;
static_assert(XCH_OFF + 8192 <= LDS_BYTES, "LDS map");
#define GAS __attribute__((address_space(1)))
#define LAS __attribute__((address_space(3)))
typedef unsigned short bf16;
typedef unsigned v4u __attribute__((ext_vector_type(4)));
typedef float f32x4 __attribute__((ext_vector_type(4)));
typedef short bf16x8 __attribute__((ext_vector_type(8)));
typedef GAS unsigned gu32;
typedef GAS unsigned long long gu64;
#define RLX_AGENT __ATOMIC_RELAXED, __HIP_MEMORY_SCOPE_AGENT
#define LDS_WAIT() asm volatile("s_waitcnt lgkmcnt(0)" ::: "memory")
#define VM_WAIT() asm volatile("s_waitcnt vmcnt(0)" ::: "memory")
__device__ __forceinline__ unsigned long long rt() { return __builtin_amdgcn_s_memrealtime(); }
__device__ __forceinline__ unsigned f2bf(float f) { unsigned u = __builtin_bit_cast(unsigned, f); return (u + 0x7fffu + ((u >> 16) & 1u)) >> 16; }
__device__ __forceinline__ unsigned pk2(float lo, float hi) { return f2bf(lo) | (f2bf(hi) << 16); }

#define XB_TMO      128
#define XB_XCNT(j)  (256  + 64 * (j))
#define XB_XSUB(j)  (1280 + 64 * (j))
#define XB_XGEN(j)  (2304 + 64 * (j))
#define XB_TOP      3328
#define XB_TOPGEN   3392
#define XCD_BAR_WORDS 3456
#define XB_SPIN_CAP (1u << 18)

__device__ __forceinline__ unsigned xb_ld(unsigned* p)              { return __hip_atomic_load(p, __ATOMIC_RELAXED, __HIP_MEMORY_SCOPE_AGENT); }
__device__ __forceinline__ unsigned xb_add(unsigned* p, unsigned v) { return __hip_atomic_fetch_add(p, v, __ATOMIC_RELAXED, __HIP_MEMORY_SCOPE_AGENT); }
__device__ __forceinline__ unsigned xb_xcc_id() { return (unsigned)__builtin_amdgcn_s_getreg((3 << 11) | 20) & 0xFu; }
#define XB_SPIN(cond, bar) do { unsigned _sp = 0; while (cond) { __builtin_amdgcn_s_sleep(1); \
    if ((++_sp & 255u) == 0u) { if (xb_ld(&(bar)[XB_TMO])) break; if (_sp > XB_SPIN_CAP) { atomicAdd(&(bar)[XB_TMO], 1u); break; } } } } while (0)

struct XcdBarrier {
    unsigned* bar; unsigned x;
    volatile LAS unsigned* st;
};

__device__ __forceinline__ XcdBarrier xcd_barrier_post(unsigned* bar, volatile LAS unsigned* st) {
    XcdBarrier b; b.bar = bar; b.x = xb_xcc_id(); b.st = st;
    if (threadIdx.x == 0) (void)xb_add(&bar[XB_XCNT(b.x)], 1u);
    return b;
}
__device__ __forceinline__ void xcd_barrier_complete(unsigned* bar, unsigned x, unsigned& nloc, unsigned& nx) {
    const unsigned G = gridDim.x * gridDim.y * gridDim.z;
    unsigned sum, cnt, mine, sp = 0u;
    for (;;) {
        sum = 0u; cnt = 0u; mine = 0u;
#pragma unroll
        for (unsigned j = 0; j < 16; ++j) { const unsigned c = xb_ld(&bar[XB_XCNT(j)]); sum += c; cnt += (c > 0u) ? 1u : 0u; mine = (j == x) ? c : mine; }
        if (sum == G) break;
        __builtin_amdgcn_s_sleep(1);
        if ((++sp & 255u) == 0u) { if (xb_ld(&bar[XB_TMO])) break; if (sp > XB_SPIN_CAP) { atomicAdd(&bar[XB_TMO], 1u); break; } }
    }
    nloc = mine > 0u ? mine : 1u; nx = cnt > 0u ? cnt : 1u;
}

__device__ __forceinline__ void xcd_barrier(const XcdBarrier& b) {
    asm volatile("s_waitcnt vmcnt(0)" ::: "memory");
    __syncthreads();
    if (threadIdx.x == 0) {
        unsigned* bar = b.bar;
        __builtin_amdgcn_s_waitcnt(0);
        unsigned nloc = b.st[0], nx = b.st[1];
        if (nloc == 0u) { xcd_barrier_complete(bar, b.x, nloc, nx); b.st[0] = nloc; b.st[1] = nx; }
        const unsigned old = xb_add(&bar[XB_XSUB(b.x)], 1u);
        const unsigned gen = old / nloc;
        if (old + 1u == (gen + 1u) * nloc) {
            __builtin_amdgcn_fence(__ATOMIC_RELEASE, "agent");
            asm volatile("s_waitcnt vmcnt(0)" ::: "memory");
            const unsigned og = xb_add(&bar[XB_TOP], 1u);
            const unsigned tg = og / nx;
            if (og + 1u == (tg + 1u) * nx) xb_add(&bar[XB_TOPGEN], 1u);
            else XB_SPIN(xb_ld(&bar[XB_TOPGEN]) == tg, bar);
            __builtin_amdgcn_fence(__ATOMIC_ACQUIRE, "agent");
            xb_add(&bar[XB_XGEN(b.x)], 1u);
            asm volatile("s_waitcnt vmcnt(0)" ::: "memory");
        } else {
            XB_SPIN(xb_ld(&bar[XB_XGEN(b.x)]) == gen, bar);
            __builtin_amdgcn_fence(__ATOMIC_ACQUIRE, "agent");
            asm volatile("s_waitcnt vmcnt(0)" ::: "memory");
        }
    }
    __syncthreads();
}
struct Frame {
    LAS unsigned char* lds;
    volatile LAS unsigned* MISC;
    gu32* ctl;
    int wave;
    int vcu, G;
};
__device__ __forceinline__ float wave_sum(float v) {
#pragma unroll
    for (int o = 1; o < 64; o <<= 1) v += __shfl_xor(v, o);
    return v;
}
__device__ __forceinline__ void p0_transpose_item(const float* W, int K, int N, bf16* WT, int row_off, LAS float* scr, int item, int lane, const float* kgain = nullptr) {
    const int nblk = N / 32, kb = item / nblk, nb = item % nblk, k0 = 64 * kb, n0 = 32 * nb;
    float wv[32];
#pragma unroll
    for (int i = 0; i < 32; ++i) { const int kk = 2 * i + (lane >> 5); wv[i] = W[(size_t)(k0 + kk) * N + n0 + (lane & 31)]; }
#pragma unroll
    for (int i = 0; i < 32; ++i) { const int kk = 2 * i + (lane >> 5); float w = wv[i]; if (kgain) w *= kgain[k0 + kk]; scr[kk * 33 + (lane & 31)] = w; }
    LDS_WAIT(); asm volatile("" ::: "memory");
    const int c = lane & 7;
#pragma unroll
    for (int j = 0; j < 4; ++j) { const int n = (lane >> 3) + 8 * j; const LAS float* s = scr + (8 * c) * 33 + n;
        v4u o; o.x = pk2(s[0 * 33], s[1 * 33]); o.y = pk2(s[2 * 33], s[3 * 33]); o.z = pk2(s[4 * 33], s[5 * 33]); o.w = pk2(s[6 * 33], s[7 * 33]);
        *(GAS v4u*)(WT + (size_t)(row_off + n0 + n) * K + k0 + 8 * c) = o; }
    LDS_WAIT(); asm volatile("" ::: "memory");
}
__device__ __forceinline__ void p0_transpose_item_f8(const float* W, int N, int ncol0, unsigned char* W8T, int K, LAS float* scr, int kb, int nb, int lane, float mul) {
    const int k0 = 64 * kb, n0 = ncol0 + 32 * nb;
    float wv[32];
#pragma unroll
    for (int i = 0; i < 32; ++i) { const int kk = 2 * i + (lane >> 5); wv[i] = W[(size_t)(k0 + kk) * N + n0 + (lane & 31)]; }
#pragma unroll
    for (int i = 0; i < 32; ++i) { const int kk = 2 * i + (lane >> 5); scr[kk * 33 + (lane & 31)] = wv[i] * mul; }
    LDS_WAIT(); asm volatile("" ::: "memory");
    const int c = lane & 7;
#pragma unroll
    for (int j = 0; j < 4; ++j) { const int n = (lane >> 3) + 8 * j; const LAS float* sp = scr + (8 * c) * 33 + n;
        int lo = __builtin_amdgcn_cvt_pk_fp8_f32(sp[0 * 33], sp[1 * 33], 0, false); lo = __builtin_amdgcn_cvt_pk_fp8_f32(sp[2 * 33], sp[3 * 33], lo, true);
        int hi = __builtin_amdgcn_cvt_pk_fp8_f32(sp[4 * 33], sp[5 * 33], 0, false); hi = __builtin_amdgcn_cvt_pk_fp8_f32(sp[6 * 33], sp[7 * 33], hi, true);
        *(GAS unsigned long long*)(W8T + (size_t)(32 * nb + n) * K + k0 + 8 * c) = (unsigned long long)(unsigned)lo | ((unsigned long long)(unsigned)hi << 32); }
    LDS_WAIT(); asm volatile("" ::: "memory");
}
__device__ __forceinline__ void p0_colmax_item(const float* W, int N, int kb, int nb, unsigned* wmax, int lane) {
    const int k0 = 64 * kb, n0 = 32 * nb; float mx = 0.f;
    float wv[32];
#pragma unroll
    for (int i = 0; i < 32; ++i) wv[i] = W[(size_t)(k0 + 2 * i + (lane >> 5)) * N + n0 + (lane & 31)];
#pragma unroll
    for (int i = 0; i < 32; ++i) mx = __builtin_fmaxf(mx, __builtin_fabsf(wv[i]));
    mx = __builtin_fmaxf(mx, __shfl_xor(mx, 32));
    if (lane < 32) __hip_atomic_fetch_max(wmax + lane, __float_as_uint(mx), __ATOMIC_RELAXED, __HIP_MEMORY_SCOPE_AGENT);
}
__device__ __forceinline__ void p0_quant_item(const float* W, int N, int kb, int nb, unsigned char* W8T, unsigned* wmax, float* wsc, LAS float* scr, int lane) {
    const int k0 = 64 * kb, n0 = 32 * nb;
    float wv[32];
#pragma unroll
    for (int i = 0; i < 32; ++i) wv[i] = W[(size_t)(k0 + 2 * i + (lane >> 5)) * N + n0 + (lane & 31)];
#pragma unroll
    for (int i = 0; i < 32; ++i) scr[(2 * i + (lane >> 5)) * 33 + (lane & 31)] = wv[i];
    LDS_WAIT(); asm volatile("" ::: "memory");
    const int c = lane & 7;
#pragma unroll
    for (int j = 0; j < 4; ++j) { const int n = (lane >> 3) + 8 * j; const LAS float* sp = scr + (8 * c) * 33 + n;
        const float cm = __uint_as_float(__hip_atomic_load(wmax + n, __ATOMIC_RELAXED, __HIP_MEMORY_SCOPE_AGENT)); const float inv = cm > 0.f ? 127.0f / cm : 0.f;
        unsigned lo = 0u, hi = 0u;
#pragma unroll
        for (int e = 0; e < 4; ++e) { lo |= ((unsigned)(int)__builtin_rintf(sp[e * 33] * inv) & 0xffu) << (8 * e); hi |= ((unsigned)(int)__builtin_rintf(sp[(4 + e) * 33] * inv) & 0xffu) << (8 * e); }
        *(GAS unsigned long long*)(W8T + (size_t)n * 1024 + k0 + 8 * c) = (unsigned long long)lo | ((unsigned long long)hi << 32); }
    if (kb == 0 && lane < 32) wsc[lane] = __uint_as_float(__hip_atomic_load(wmax + lane, __ATOMIC_RELAXED, __HIP_MEMORY_SCOPE_AGENT)) * (1.0f / 127.0f);
    LDS_WAIT(); asm volatile("" ::: "memory");
}
__device__ __forceinline__ void rms_row2_to_i8(int lane, const float* xrow, const float* g, unsigned* o8row, float* xsc) {
    const GAS f32x4* xr = (const GAS f32x4*)xrow + lane; const GAS f32x4* gr = (const GAS f32x4*)g + lane;
    f32x4 v[8]; float s0 = 0.f, s1 = 0.f;
#pragma unroll
    for (int j = 0; j < 8; ++j) v[j] = xr[64 * j];
#pragma unroll
    for (int j = 0; j < 4; ++j) { s0 += (v[j].x * v[j].x + v[j].y * v[j].y) + (v[j].z * v[j].z + v[j].w * v[j].w); s1 += (v[4 + j].x * v[4 + j].x + v[4 + j].y * v[4 + j].y) + (v[4 + j].z * v[4 + j].z + v[4 + j].w * v[4 + j].w); }
#pragma unroll
    for (int o = 1; o < 64; o <<= 1) { s0 += __shfl_xor(s0, o); s1 += __shfl_xor(s1, o); }
    const float r0 = 1.f / sqrtf(s0 * (1.f / D) + 1e-6f), r1 = 1.f / sqrtf(s1 * (1.f / D) + 1e-6f);
    float a0 = 0.f, a1 = 0.f;
#pragma unroll
    for (int j = 0; j < 4; ++j) { const f32x4 gg = gr[64 * j]; v[j] = v[j] * gg * r0; v[4 + j] = v[4 + j] * gg * r1;
        a0 = __builtin_fmaxf(a0, __builtin_fmaxf(__builtin_fmaxf(__builtin_fabsf(v[j].x), __builtin_fabsf(v[j].y)), __builtin_fmaxf(__builtin_fabsf(v[j].z), __builtin_fabsf(v[j].w))));
        a1 = __builtin_fmaxf(a1, __builtin_fmaxf(__builtin_fmaxf(__builtin_fabsf(v[4 + j].x), __builtin_fabsf(v[4 + j].y)), __builtin_fmaxf(__builtin_fabsf(v[4 + j].z), __builtin_fabsf(v[4 + j].w)))); }
#pragma unroll
    for (int o = 1; o < 64; o <<= 1) { a0 = __builtin_fmaxf(a0, __shfl_xor(a0, o)); a1 = __builtin_fmaxf(a1, __shfl_xor(a1, o)); }
    const float i0 = a0 > 0.f ? 127.0f / a0 : 0.f, i1 = a1 > 0.f ? 127.0f / a1 : 0.f;
#pragma unroll
    for (int j = 0; j < 4; ++j) {
        const unsigned p0 = ((unsigned)(int)__builtin_rintf(v[j].x * i0) & 0xffu) | (((unsigned)(int)__builtin_rintf(v[j].y * i0) & 0xffu) << 8) | (((unsigned)(int)__builtin_rintf(v[j].z * i0) & 0xffu) << 16) | (((unsigned)(int)__builtin_rintf(v[j].w * i0) & 0xffu) << 24);
        const unsigned p1 = ((unsigned)(int)__builtin_rintf(v[4 + j].x * i1) & 0xffu) | (((unsigned)(int)__builtin_rintf(v[4 + j].y * i1) & 0xffu) << 8) | (((unsigned)(int)__builtin_rintf(v[4 + j].z * i1) & 0xffu) << 16) | (((unsigned)(int)__builtin_rintf(v[4 + j].w * i1) & 0xffu) << 24);
        ((GAS unsigned*)o8row)[lane + 64 * j] = p0; ((GAS unsigned*)o8row)[256 + lane + 64 * j] = p1; }
    if (lane == 0) { xsc[0] = a0 * (1.0f / 127.0f); xsc[1] = a1 * (1.0f / 127.0f); }
}
__device__ __forceinline__ void rms_row_to_bf16(int lane, const float* xrow, const float* g, bf16* orow) {
    const GAS f32x4* xr = (const GAS f32x4*)xrow + lane; const GAS f32x4* gr = (const GAS f32x4*)g + lane;
    f32x4 v[4]; float s = 0.f;
#pragma unroll
    for (int j = 0; j < 4; ++j) { v[j] = xr[64 * j]; s += (v[j].x * v[j].x + v[j].y * v[j].y) + (v[j].z * v[j].z + v[j].w * v[j].w); }
    const float rstd = 1.f / sqrtf(wave_sum(s) * (1.f / D) + 1e-6f);
    GAS unsigned long long* o8 = (GAS unsigned long long*)orow + lane;
#pragma unroll
    for (int j = 0; j < 4; ++j) { const f32x4 gg = gr[64 * j]; o8[64 * j] = (unsigned long long)pk2(v[j].x * rstd * gg.x, v[j].y * rstd * gg.y) | ((unsigned long long)pk2(v[j].z * rstd * gg.z, v[j].w * rstd * gg.w) << 32); }
}
__device__ __forceinline__ void rms_row2_to_bf16(int lane, const float* xrow, const float* g, bf16* orow, unsigned* o8row) {
    const GAS f32x4* xr = (const GAS f32x4*)xrow + lane; const GAS f32x4* gr = (const GAS f32x4*)g + lane;
    f32x4 v[8]; float s0 = 0.f, s1 = 0.f;
#pragma unroll
    for (int j = 0; j < 8; ++j) v[j] = xr[64 * j];
#pragma unroll
    for (int j = 0; j < 4; ++j) { s0 += (v[j].x * v[j].x + v[j].y * v[j].y) + (v[j].z * v[j].z + v[j].w * v[j].w); s1 += (v[4 + j].x * v[4 + j].x + v[4 + j].y * v[4 + j].y) + (v[4 + j].z * v[4 + j].z + v[4 + j].w * v[4 + j].w); }
#pragma unroll
    for (int o = 1; o < 64; o <<= 1) { s0 += __shfl_xor(s0, o); s1 += __shfl_xor(s1, o); }
    const float r0 = 1.f / sqrtf(s0 * (1.f / D) + 1e-6f), r1 = 1.f / sqrtf(s1 * (1.f / D) + 1e-6f);
    GAS unsigned long long* o8 = (GAS unsigned long long*)orow + lane;
#pragma unroll
    for (int j = 0; j < 4; ++j) { const f32x4 gg = gr[64 * j];
        o8[64 * j] = (unsigned long long)pk2(v[j].x * r0 * gg.x, v[j].y * r0 * gg.y) | ((unsigned long long)pk2(v[j].z * r0 * gg.z, v[j].w * r0 * gg.w) << 32);
        o8[64 * (4 + j)] = (unsigned long long)pk2(v[4 + j].x * r1 * gg.x, v[4 + j].y * r1 * gg.y) | ((unsigned long long)pk2(v[4 + j].z * r1 * gg.z, v[4 + j].w * r1 * gg.w) << 32);
        int p0 = __builtin_amdgcn_cvt_pk_fp8_f32(v[j].x * r0 * gg.x, v[j].y * r0 * gg.y, 0, false); p0 = __builtin_amdgcn_cvt_pk_fp8_f32(v[j].z * r0 * gg.z, v[j].w * r0 * gg.w, p0, true);
        int p1 = __builtin_amdgcn_cvt_pk_fp8_f32(v[4 + j].x * r1 * gg.x, v[4 + j].y * r1 * gg.y, 0, false); p1 = __builtin_amdgcn_cvt_pk_fp8_f32(v[4 + j].z * r1 * gg.z, v[4 + j].w * r1 * gg.w, p1, true);
        ((GAS unsigned*)o8row)[lane + 64 * j] = (unsigned)p0; ((GAS unsigned*)o8row)[256 + lane + 64 * j] = (unsigned)p1; }
}
__device__ __forceinline__ void unpack8f(const v4u w, float (&v)[8]) {
    v[0] = __uint_as_float(w.x << 16); v[1] = __uint_as_float(w.x & 0xffff0000u); v[2] = __uint_as_float(w.y << 16); v[3] = __uint_as_float(w.y & 0xffff0000u);
    v[4] = __uint_as_float(w.z << 16); v[5] = __uint_as_float(w.z & 0xffff0000u); v[6] = __uint_as_float(w.w << 16); v[7] = __uint_as_float(w.w & 0xffff0000u); }
__device__ __forceinline__ v4u pack8f(const float (&v)[8]) { v4u o; o.x = pk2(v[0], v[1]); o.y = pk2(v[2], v[3]); o.z = pk2(v[4], v[5]); o.w = pk2(v[6], v[7]); return o; }

struct Args { const float* in[24]; float* out; unsigned char* ws; int ph_lo, ph_hi; };
constexpr int N_PHASES = 9;

typedef const __attribute__((address_space(4))) Args KArgs;
__device__ __forceinline__ KArgs* ka_ptr() { KArgs* p = (KArgs*)__builtin_amdgcn_kernarg_segment_ptr(); asm volatile("" : "+s"(p)); return p; }
#define PHASE_PTRS const KArgs* KA = ka_ptr(); unsigned char* ws = KA->ws; const float* x = KA->in[0]; const float* mem = KA->in[1]; const float* norm_mix_g = KA->in[2]; const float* norm_mem_g = KA->in[3]; const float* w_in = KA->in[4]; const float* b_gate = KA->in[5]; const float* q_norm_g = KA->in[6]; const float* k_norm_g = KA->in[7]; const float* lam_q1 = KA->in[8]; const float* lam_k1 = KA->in[9]; const float* lam_q2 = KA->in[10]; const float* lam_k2 = KA->in[11]; const float* subln_g = KA->in[12]; const float* w_attn_o = KA->in[13]; const float* conv_w = KA->in[14]; const float* w_conv_o = KA->in[15]; const float* w_mem_kv = KA->in[16]; const float* mq_norm_g = KA->in[17]; const float* mk_norm_g = KA->in[18]; const float* w_mem_o = KA->in[19]; const float* w_o = KA->in[20]; const float* norm_mlp_g = KA->in[21]; const float* w_mlp_in = KA->in[22]; const float* w_mlp_out = KA->in[23]; float* out = KA->out; bf16* WinT = (bf16*)(ws + WS_WIN); bf16* WaT = (bf16*)(ws + WS_WA); bf16* WcT = (bf16*)(ws + WS_WC); bf16* WmT = (bf16*)(ws + WS_WM); bf16* WoT = (bf16*)(ws + WS_WO); bf16* WkvT = (bf16*)(ws + WS_WKV); bf16* W1T = (bf16*)(ws + WS_W1); bf16* W2T = (bf16*)(ws + WS_W2); float* STATS = (float*)(ws + WS_STATS); bf16* MEMN = (bf16*)(ws + WS_MEMN); bf16* KP = (bf16*)(ws + WS_KP); bf16* VT = (bf16*)(ws + WS_VT); bf16* R1 = (bf16*)(ws + WS_R1); bf16* R2 = (bf16*)(ws + WS_R2); bf16* R3 = (bf16*)(ws + WS_R3); bf16* R4 = (bf16*)(ws + WS_R4); bf16* R5 = (bf16*)(ws + WS_R5); bf16* R6 = (bf16*)(ws + WS_R6); bf16* R7 = (bf16*)(ws + WS_R7); bf16* D0 = (bf16*)out; bf16* D1 = (bf16*)out + (size_t)M * D;
__global__ void __launch_bounds__(NWAVES * 64, 2) hybrid_fwd(Args args) {
    extern __shared__ __attribute__((aligned(16))) unsigned char lds[];
    Frame F;
    F.lds = (LAS unsigned char*)lds;
    F.MISC = (volatile LAS unsigned*)(F.lds + MISC_OFF);
    F.wave = __builtin_amdgcn_readfirstlane((int)threadIdx.x >> 6);
    F.G = gridDim.x; { const int bx = blockIdx.x; F.vcu = (F.G % 8 == 0) ? (bx % 8) * (F.G / 8) + bx / 8 : bx; }
    F.ctl = (gu32*)(args.ws + WS_CTL);
    for (int u = ((int)threadIdx.x); u < (LDS_BYTES - LDSCTL_OFF) / 4; u += NWAVES * 64) ((LAS unsigned*)(F.lds + LDSCTL_OFF))[u] = 0u;
    __syncthreads();
    const int lo = args.ph_lo, hi = args.ph_hi;
    const bool multi = (hi - lo) > 1;
    XcdBarrier bar; bar.bar = (unsigned*)(F.ctl + CW_BAR); bar.x = 0; bar.st = nullptr;
    if (multi) bar = xcd_barrier_post((unsigned*)(F.ctl + CW_BAR), F.MISC + 8);
#ifndef REP_MASK
#define REP_MASK 0
#endif
#ifndef PH_MASK
#define PH_MASK 0x1ff
#endif
#define IN(k) (((PH_MASK >> (k)) & 1) && lo <= (k) && (k) < hi)
#define BOTH(k) (IN(k) && IN((k) + 1))
#define GRID_BAR() xcd_barrier(bar)
    PG8_LAS float* X0 = (PG8_LAS float*)(F.lds + XCH_OFF); PG8_LAS float* X1 = (PG8_LAS float*)(F.lds + XCH_OFF + 4096);
    const int gw = F.vcu * NWAVES + F.wave, NGW = F.G * NWAVES;
    LAS unsigned char* ring = F.lds + RING_OFF;
    const int cid = (int)blockIdx.x;
    typedef pg8::StaticOrder SO;

    if (IN(0)) for (int rep_ = 0; rep_ <= ((REP_MASK >> 0) & 1); ++rep_) { PHASE_PTRS if (rep_) { VM_WAIT(); __syncthreads(); }
        LAS float* scr = (LAS float*)(F.lds + RING_OFF + F.wave * 16384);
        constexpr int I_IN = (D / 64) * (PROJW / 32), I_KV = (D / 64) * (2 * D / 32);
        unsigned* WMAX = (unsigned*)F.ctl + CW_WMAX; unsigned char* W8 = ws + WS_W8; float* WSC = (float*)(ws + WS_WSC); float* XSC = (float*)(ws + WS_XSC);
        const int ln_ = (int)threadIdx.x & 63;
        for (int it = gw; it < I_IN + I_KV; it += NGW) {
            int r = it;
            if (r < I_KV) { p0_transpose_item(w_mem_kv, D, 2 * D, WkvT, 0, scr, r, ln_); continue; } r -= I_KV;
            { const int nb = r % (PROJW / 32), kb = r / (PROJW / 32);
                const int db = nb < 96 ? nb : nb < 128 ? 128 + 2 * (nb - 96) : nb < 160 ? 96 + (nb - 128) : nb < 192 ? 129 + 2 * (nb - 160) : nb;
                p0_colmax_item(w_in, PROJW, kb, nb, WMAX + 32 * db, ln_); }
        }
        for (int m = gw; m < MM; m += NGW) rms_row_to_bf16(ln_, mem + (size_t)m * D, norm_mem_g, MEMN + (size_t)m * D);
        for (int m = 2 * gw; m < M; m += 2 * NGW) rms_row2_to_i8(ln_, x + (size_t)m * D, norm_mix_g, (unsigned*)(ws + WS_XN8) + (size_t)m * (D / 4), XSC + m);
        if (multi) GRID_BAR();
        for (int it = gw; it < I_IN; it += NGW) {
            const int nb = it % (PROJW / 32), kb = it / (PROJW / 32);
            const int db = nb < 96 ? nb : nb < 128 ? 128 + 2 * (nb - 96) : nb < 160 ? 96 + (nb - 128) : nb < 192 ? 129 + 2 * (nb - 160) : nb;
            p0_quant_item(w_in, PROJW, kb, nb, W8 + (size_t)(32 * db) * 1024, WMAX + 32 * db, WSC + 32 * db, scr, ln_);
        }
        if (BOTH(0)) GRID_BAR();
    }
    if (IN(1)) for (int rep_ = 0; rep_ <= ((REP_MASK >> 1) & 1); ++rep_) { PHASE_PTRS if (rep_) { VM_WAIT(); __syncthreads(); }
#ifndef P1_SUB
#define P1_SUB 31
#endif
        if (P1_SUB & 1) { pg8::Gemm g{MEMN, WkvT, D, D, D, (long)256 * D, 0, (long)256 * D, 0}; SO S; S.init(MM, D, F.G, cid);
          pg8::EpiMemK E{KP, mq_norm_g, mk_norm_g, X0};
          pg8::gemm_phase<pg8::EpiMemK, SO, true, true>(ring, g, S, E); }
        if (P1_SUB & 2) { pg8::Gemm g{WkvT + (size_t)D * D, MEMN, D, D, D, (long)256 * D, 0, (long)256 * D, 0}; SO S; S.init(D, MM, F.G, (cid + 64) % F.G);
          pg8::EpiPlain E{VT, MM};
          pg8::gemm_phase<pg8::EpiPlain, SO, true, true>(ring, g, S, E); }
        const bf16* XN8 = (const bf16*)(ws + WS_XN8); const bf16* W8 = (const bf16*)(ws + WS_W8); const float* XSC = (const float*)(ws + WS_XSC); const float* WSC = (const float*)(ws + WS_WSC);
        if (P1_SUB & 4) { pg8::Gemm g{XN8, W8, D / 2, D / 2, D / 2, (long)256 * (D / 2), 0, (long)256 * (D / 2), 0}; SO S; S.init(M, 2 * D, F.G, cid);
          pg8::EpiQK E{R2, (size_t)M * D, q_norm_g, k_norm_g, XSC, WSC};
          pg8::gemm_phase<pg8::EpiQK, SO, true, false, false, false, true>(ring, g, S, E); }
        if (P1_SUB & 8) { pg8::Gemm g{XN8, W8 + (size_t)2 * D * (D / 2), D / 2, D / 2, D / 2, (long)256 * (D / 2), 0, (long)256 * (D / 2), 0}; SO S; S.init(M, 4 * D, F.G, cid);
          pg8::EpiP1b E{R4, R6, R5, XSC, WSC + 2 * D};
          pg8::gemm_phase<pg8::EpiP1b, SO, true, false, false, false, true>(ring, g, S, E); }
        if (P1_SUB & 16) { pg8::Gemm g{XN8, W8 + (size_t)6 * D * (D / 2), D / 2, D / 2, D / 2, (long)256 * (D / 2), 0, (long)256 * (D / 2), 0}; SO S; S.init(M, D, F.G, cid);
          pg8::EpiQm E{D0, X0, XSC, WSC + 6 * D};
          pg8::gemm_phase<pg8::EpiQm, SO, true, false, false, false, true>(ring, g, S, E); }
        {
            const int nk = (F.G >= 224) ? ((cid < 32 || (cid >= 192 && cid < 224)) ? -1 : (cid < 192 ? cid - 32 : cid - 64)) : cid;
            const int NH = (F.G >= 224) ? F.G - 64 : F.G;
            if (nk >= 0) {
                LAS float* scr = (LAS float*)(F.lds + RING_OFF + F.wave * 16384);
                constexpr int I_SQ = (D / 64) * (D / 32), I_1 = (D / 64) * (FF / 32), I_2 = (FF / 64) * (D / 32);
                constexpr int NIT2 = 4 * I_SQ + I_1 + I_2;
                for (int it = nk * NWAVES + F.wave; it < NIT2; it += NH * NWAVES) {
                    int r = it;
                    if (r < I_SQ) { p0_transpose_item(w_attn_o, D, D, WaT, 0, scr, r, ((int)threadIdx.x & 63)); continue; } r -= I_SQ;
                    if (r < I_SQ) { p0_transpose_item(w_conv_o, D, D, WcT, 0, scr, r, ((int)threadIdx.x & 63)); continue; } r -= I_SQ;
                    if (r < I_SQ) { p0_transpose_item(w_mem_o, D, D, WmT, 0, scr, r, ((int)threadIdx.x & 63)); continue; } r -= I_SQ;
                    if (r < I_SQ) { p0_transpose_item(w_o, D, D, WoT, 0, scr, r, ((int)threadIdx.x & 63)); continue; } r -= I_SQ;
                    if (r < I_1) { p0_transpose_item(w_mlp_in, D, FF, W1T, 0, scr, r, ((int)threadIdx.x & 63), norm_mlp_g); continue; } r -= I_1;
                    p0_transpose_item(w_mlp_out, FF, D, W2T, 0, scr, r, ((int)threadIdx.x & 63));
                }
            }
        }
        if (BOTH(1)) GRID_BAR();
    }
    if (IN(2)) for (int rep_ = 0; rep_ <= ((REP_MASK >> 2) & 1); ++rep_) { PHASE_PTRS if (rep_) { VM_WAIT(); __syncthreads(); }
#ifndef P2_SUB
#define P2_SUB 7
#endif
        if (P2_SUB & 1) {
            const int cg8 = (((int)threadIdx.x) & 127) * 8, sub = ((int)threadIdx.x) >> 7;
            float w0[8], w1[8], w2[8];
#pragma unroll
            for (int e = 0; e < 8; ++e) { w0[e] = conv_w[cg8 + e]; w1[e] = conv_w[D + cg8 + e]; w2[e] = conv_w[2 * D + cg8 + e]; }
            for (int it = F.vcu; it < M / 64; it += F.G) {
                const int r0 = it * 64 + sub * 16;
                float p2[8], p1[8];
                if ((r0 & (T - 1)) == 0) {
#pragma unroll
                    for (int e = 0; e < 8; ++e) { p2[e] = 0.f; p1[e] = 0.f; }
                } else {
                    unpack8f(*(const GAS v4u*)(R5 + (size_t)(r0 - 2) * D + cg8), p2); unpack8f(*(const GAS v4u*)(R5 + (size_t)(r0 - 1) * D + cg8), p1);
                }
#pragma unroll 4
                for (int r = 0; r < 16; ++r) {
                    const size_t off = (size_t)(r0 + r) * D + cg8;
                    float a[8], gb[8], y[8];
                    unpack8f(*(const GAS v4u*)(R5 + off), a); unpack8f(*(const GAS v4u*)(R6 + off), gb);
#pragma unroll
                    for (int e = 0; e < 8; ++e) { const float cur = a[e]; y[e] = gb[e] * (w0[e] * p2[e] + w1[e] * p1[e] + w2[e] * cur); p2[e] = p1[e]; p1[e] = cur; }
                    *(GAS v4u*)(D1 + off) = pack8f(y);
                }
            }
        }
        __syncthreads();
        if (P2_SUB & 2) { pg8::Gemm g{D0, KP, D, D, 256, (long)256 * D, 256, 256, (long)256 * D}; SO S; S.init(M, D, F.G, cid);
          pg8::EpiSoftmax E{D0, X0};
          pg8::gemm_phase<pg8::EpiSoftmax, SO, true, true>(ring, g, S, E); }
        VM_WAIT(); __syncthreads();
        if (P2_SUB & 4) { pg8::Gemm g{D0, VT, D, MM, 256, (long)256 * D, 256, (long)256 * MM, 256}; SO S; S.init(M, D, F.G, cid);
          pg8::EpiPlain E{D0, D};
          pg8::gemm_phase<pg8::EpiPlain, SO, true, true>(ring, g, S, E); }
    }
    if (IN(3)) for (int rep_ = 0; rep_ <= ((REP_MASK >> 3) & 1); ++rep_) { PHASE_PTRS if (rep_) { VM_WAIT(); __syncthreads(); }
        const int ln_ = (int)threadIdx.x & 63;
        const float d1 = wave_sum(lam_q1[ln_] * lam_k1[ln_]), d2 = wave_sum(lam_q2[ln_] * lam_k2[ln_]);
        const float lam = expf(d1) - expf(d2) + 0.2f;
        const attn_body::AttnTensors AT{(const attn_body::bf16*)R2, (const attn_body::bf16*)R3, (const attn_body::bf16*)R4, (attn_body::bf16*)R1, (attn_body::bf16*)R2, subln_g, lam};
        const attn_body::AttnOrder AS{F.vcu, F.G};
        attn_body::attn_phase<8>((char*)lds + RING_OFF, AT, AS);
        if (BOTH(3)) GRID_BAR();
    }
    if (IN(5)) for (int rep_ = 0; rep_ <= ((REP_MASK >> 5) & 1); ++rep_) { PHASE_PTRS if (rep_) { VM_WAIT(); __syncthreads(); }
        { pg8::Gemm g{(const bf16*)(ws + WS_XN8), (const bf16*)(ws + WS_W8) + (size_t)NPROJ1 * (D / 2), D / 2, D / 2, D / 2, (long)256 * (D / 2), 0, (long)256 * (D / 2), 0}; pg8::GateOrder S; S.base.init(M, D, F.G, cid);
          pg8::EpiGate E{R3, (size_t)M * D, b_gate, (const float*)(ws + WS_XSC), (const float*)(ws + WS_WSC) + NPROJ1};
          pg8::gemm_phase<pg8::EpiGate, pg8::GateOrder, true, false, false, false, true>(ring, g, S, E); }
        VM_WAIT(); __syncthreads();
        { pg8::Gemm g{R2, WaT, D, D, D, (long)256 * D, 0, (long)256 * D, 0, D1, D0, (long)(WS_WC - WS_WA) / 2}; pg8::SegOrder S; S.base.init(M, D, F.G, cid);
          pg8::EpiBranch3 E{R3, R4, R5, R6};
          pg8::gemm_phase<pg8::EpiBranch3, pg8::SegOrder, true, true, true>(ring, g, S, E); }
        if (BOTH(5)) GRID_BAR();
    }
    if (IN(6)) for (int rep_ = 0; rep_ <= ((REP_MASK >> 6) & 1); ++rep_) { PHASE_PTRS if (rep_) { VM_WAIT(); __syncthreads(); }
        { pg8::Gemm g{R6, WoT, D, D, D, (long)256 * D, 0, (long)256 * D, 0}; SO S; S.init(M, D, F.G, cid);
          pg8::EpiX1 E{x, out, R2, STATS};
          pg8::gemm_phase<pg8::EpiX1, SO, true, true>(ring, g, S, E); }
        if (BOTH(6)) GRID_BAR();
    }
    if (IN(7)) for (int rep_ = 0; rep_ <= ((REP_MASK >> 7) & 1); ++rep_) { PHASE_PTRS if (rep_) { VM_WAIT(); __syncthreads(); }
        { pg8::Gemm g{R2, W1T, D, D, D, (long)256 * D, 0, (long)256 * D, 0}; SO S; S.init(M, FF, F.G, cid);
          pg8::EpiRelu2P E{R3, FF};
          pg8::gemm_phase<pg8::EpiRelu2P, SO, true, true>(ring, g, S, E); }
        if (BOTH(7)) GRID_BAR();
    }
    if (IN(8)) for (int rep_ = 0; rep_ <= ((REP_MASK >> 8) & 1); ++rep_) { PHASE_PTRS if (rep_) { VM_WAIT(); __syncthreads(); }
        { pg8::Gemm g{R3, W2T, FF, FF, FF, (long)256 * FF, 0, (long)256 * FF, 0}; SO S; S.init(M, D, F.G, cid);
          pg8::EpiOutN E{out, out, STATS};
          pg8::gemm_phase<pg8::EpiOutN, SO, true, true>(ring, g, S, E); }
    }
    if (hi > N_PHASES) { const unsigned long long* ia = (const unsigned long long*)__builtin_amdgcn_implicitarg_ptr(); if (ia[11] == 1ull) __builtin_trap(); }
#undef IN
#undef BOTH
}

#ifndef MK_N_LAUNCHES
#define MK_N_LAUNCHES 1
#endif
extern "C" void kernel_launch(void* const* d_in, const int* in_sizes, int n_in, void* d_out, int out_size, void* d_ws, size_t ws_size, hipStream_t stream) {
    static int grid = 0;
    if (grid == 0) {
        if (n_in != 24 || in_sizes[0] != M * D || out_size != M * D || ws_size < WS_END) { fprintf(stderr, "kernel_launch: unexpected shapes (n_in %d, in0 %d, out %d, ws %zu); nothing launched\n", n_in, n_in > 0 ? in_sizes[0] : -1, out_size, ws_size); grid = -1; return; }
        int dev = 0, cus = 0, per_cu = 0;
        if (hipGetDevice(&dev) != hipSuccess || hipDeviceGetAttribute(&cus, hipDeviceAttributeMultiprocessorCount, dev) != hipSuccess) { grid = -1; return; }
        if (hipFuncSetAttribute((const void*)hybrid_fwd, hipFuncAttributeMaxDynamicSharedMemorySize, LDS_BYTES) != hipSuccess) { fprintf(stderr, "kernel_launch: hipFuncSetAttribute failed\n"); grid = -1; return; }
        if (hipOccupancyMaxActiveBlocksPerMultiprocessor(&per_cu, (const void*)hybrid_fwd, NWAVES * 64, LDS_BYTES) != hipSuccess || per_cu < 1) { fprintf(stderr, "kernel_launch: occupancy query says %d\n", per_cu); per_cu = 1; }
        (void)hipGetLastError();
        grid = cus * 1;
    }
    if (grid < 0) return;
    (void)hipMemsetAsync((char*)d_ws + WS_CTL, 0, CTL_ZERO_BYTES, stream);
    Args a{};
    for (int i = 0; i < 24; ++i) a.in[i] = (const float*)d_in[i];
    a.out = (float*)d_out; a.ws = (unsigned char*)d_ws;
    if (MK_N_LAUNCHES == 1) {
        a.ph_lo = 0; a.ph_hi = N_PHASES;
        void* kargs[] = {&a};
        hipError_t e = hipLaunchCooperativeKernel((const void*)hybrid_fwd, dim3(grid), dim3(NWAVES * 64), kargs, LDS_BYTES, stream);
        if (e != hipSuccess) fprintf(stderr, "kernel_launch: cooperative launch failed: %s (grid %d)\n", hipGetErrorString(e), grid);
    } else {
        for (int p = 0; p < N_PHASES; ++p) { a.ph_lo = p; a.ph_hi = p + 1; hipLaunchKernelGGL(hybrid_fwd, dim3(grid), dim3(NWAVES * 64), LDS_BYTES, stream, a); }
    }
}
```

```cpp
#include <hip/hip_runtime.h>
#include <hip/hip_cooperative_groups.h>
#include <hip/hip_bf16.h>
#include <cstdio>
#include <cstdint>
#include <cmath>
namespace cg = cooperative_groups;
namespace pg8 {
#define PG8_LAS __attribute__((address_space(3)))
typedef unsigned short bf16_t;
typedef short bf16x8 __attribute__((ext_vector_type(8)));
typedef float f32x4 __attribute__((ext_vector_type(4)));
typedef unsigned u32x4 __attribute__((ext_vector_type(4)));
constexpr int BM = 256, BK = 64, HALF = 128, HTB = HALF * BK * 2  , STAGE_BYTES = 8 * HTB, NXCD = 8, WGM = 8;

__host__ __device__ __forceinline__ int lds_byte(int r, int c) { const int st = (r >> 4) * 2 + (c >> 5), rr = r & 15, cc = c & 31, ob = rr * 64 + cc * 2; return st * 1024 + (ob ^ (((ob >> 9) & 1) << 5)); }
__host__ __device__ __forceinline__ void stage_rc(int b, int& R, int& C) { const int st = b / 1024, sb = b % 1024, swz = sb ^ (((sb >> 9) & 1) << 5); R = (st >> 1) * 16 + swz / 64; C = (st & 1) * 32 + (swz % 64) / 2; }
__host__ __device__ __forceinline__ int perm32(int rho) { const int n = rho >> 4, i = rho & 15; return 8 * (i >> 2) + 4 * n + (i & 3); }

struct Unit { int pm, pn, seg; };
struct Gemm { const bf16_t* A; const bf16_t* Bt; int lda, ldb, K; long sAm, sAn, sBn, sBb; const bf16_t* A1 = nullptr; const bf16_t* A2 = nullptr; long sBseg = 0; };

struct StaticOrder {
    int nM, nN, nwg, G, c;
    __host__ __device__ void init(int M, int N, int G_, int c_) { nM = M / BM; nN = N / BM; nwg = nM * nN; G = G_; c = c_; }
    __host__ __device__ bool next(int i, Unit& u) const {
        const long L = (long)i * G + c; if (L >= nwg) return false;
        int wgid = (int)L; { const int q = nwg / NXCD, r = nwg % NXCD, xcd = wgid % NXCD, off = wgid / NXCD; wgid = (xcd < r ? xcd * (q + 1) : r * (q + 1) + (xcd - r) * q) + off; }
        const int nig = WGM * nN, gid = wgid / nig, fm = gid * WGM, gsz = (nM - fm) < WGM ? (nM - fm) : WGM;
        u.pm = fm + ((wgid % nig) % gsz); u.pn = (wgid % nig) / gsz; u.seg = 0; return true;
    }
    __device__ __forceinline__ void a_ready(const Unit&) const {}
    __device__ __forceinline__ void done(const Unit&) const {}
};

struct SegOrder {
    StaticOrder base;
    __host__ __device__ bool next(int i, Unit& u) const { if (!base.next(i / 3, u)) return false; u.seg = i % 3; return true; }
    __device__ __forceinline__ void a_ready(const Unit&) const {}
    __device__ __forceinline__ void done(const Unit&) const {}
};
struct GateOrder {
    StaticOrder base;
    __host__ __device__ bool next(int i, Unit& u) const { if (!base.next(i / 3, u)) return false; u.pn += 4 * (i % 3); return true; }
    __device__ __forceinline__ void a_ready(const Unit&) const {}
    __device__ __forceinline__ void done(const Unit&) const {}
};
__device__ __forceinline__ unsigned cvt_pk_bf16(float lo, float hi) { unsigned r; asm volatile("v_cvt_pk_bf16_f32 %0, %1, %2" : "=v"(r) : "v"(lo), "v"(hi)); return r; }
__device__ __forceinline__ u32x4 pack8(const f32x4& v0, const f32x4& v1) { u32x4 w; w.x = cvt_pk_bf16(v0[0], v0[1]); w.y = cvt_pk_bf16(v0[2], v0[3]); w.z = cvt_pk_bf16(v1[0], v1[1]); w.w = cvt_pk_bf16(v1[2], v1[3]); return w; }
__device__ __forceinline__ void unpack8(const u32x4& w, f32x4& v0, f32x4& v1) {
    v0[0] = __uint_as_float(w.x << 16); v0[1] = __uint_as_float(w.x & 0xffff0000u); v0[2] = __uint_as_float(w.y << 16); v0[3] = __uint_as_float(w.y & 0xffff0000u);
    v1[0] = __uint_as_float(w.z << 16); v1[1] = __uint_as_float(w.z & 0xffff0000u); v1[2] = __uint_as_float(w.w << 16); v1[3] = __uint_as_float(w.w & 0xffff0000u); }
typedef f32x4 Acc[2][2][4][2];
typedef int v8i32 __attribute__((ext_vector_type(8))); typedef int v4i32 __attribute__((ext_vector_type(4)));
__device__ __forceinline__ v8i32 pg8_cat(bf16x8 lo, bf16x8 hi) { return __builtin_shufflevector(__builtin_bit_cast(v4i32, lo), __builtin_bit_cast(v4i32, hi), 0, 1, 2, 3, 4, 5, 6, 7); }
#define PG8_FOR_AM _Pragma("unroll") for (int ai = 0; ai < 2; ++ai) _Pragma("unroll") for (int m = 0; m < 4; ++m)
#define PG8_FOR_BN _Pragma("unroll") for (int bj = 0; bj < 2; ++bj) _Pragma("unroll") for (int n = 0; n < 2; ++n)
__device__ __forceinline__ float dot4(const f32x4& a) { return (a[0] * a[0] + a[1] * a[1]) + (a[2] * a[2] + a[3] * a[3]); }
__device__ __forceinline__ float sum4(const f32x4& a) { return (a[0] + a[1]) + (a[2] + a[3]); }
__device__ __forceinline__ void row_sum_xchg(float (&s)[2][4], PG8_LAS float* X, int wr, int wc, int fr, int fq) {
    PG8_FOR_AM { float v = s[ai][m]; v += __shfl_xor(v, 16); v += __shfl_xor(v, 32); if (fq == 0) X[(ai * HALF + wr * 64 + m * 16 + fr) * 4 + wc] = v; }
    asm volatile("s_waitcnt lgkmcnt(0)" ::: "memory"); __builtin_amdgcn_s_barrier(); asm volatile("" ::: "memory");
    PG8_FOR_AM { const f32x4 t = *(const PG8_LAS f32x4*)(X + (ai * HALF + wr * 64 + m * 16 + fr) * 4); s[ai][m] = (t[0] + t[1]) + (t[2] + t[3]); }
}
__device__ __forceinline__ void store_tile_bf16(const Acc& acc, bf16_t* base  , size_t ldc, int wr, int fr) {
    PG8_FOR_AM { bf16_t* rowp = base + (size_t)(ai * HALF + wr * 64 + m * 16 + fr) * ldc;
#pragma unroll
        for (int bj = 0; bj < 2; ++bj) *(u32x4*)(rowp + bj * 32) = pack8(acc[ai][bj][m][0], acc[ai][bj][m][1]); }
}
__device__ __forceinline__ void dequant_i8(Acc& acc, const float* sa, const float* sb, int wr, int wc, int fr, int fq) {
    float ra[2][4];
    PG8_FOR_AM ra[ai][m] = sa[ai * HALF + wr * 64 + m * 16 + fr];
#pragma unroll
    for (int bj = 0; bj < 2; ++bj) {
        const f32x4 c0 = *(const f32x4*)(sb + wc * 64 + bj * 32 + 8 * fq), c1 = *(const f32x4*)(sb + wc * 64 + bj * 32 + 8 * fq + 4);
        PG8_FOR_AM { const v4i32 q0 = __builtin_bit_cast(v4i32, acc[ai][bj][m][0]), q1 = __builtin_bit_cast(v4i32, acc[ai][bj][m][1]); f32x4 v0, v1;
            v0[0] = (float)q0[0]; v0[1] = (float)q0[1]; v0[2] = (float)q0[2]; v0[3] = (float)q0[3]; v1[0] = (float)q1[0]; v1[1] = (float)q1[1]; v1[2] = (float)q1[2]; v1[3] = (float)q1[3];
            acc[ai][bj][m][0] = v0 * c0 * ra[ai][m]; acc[ai][bj][m][1] = v1 * c1 * ra[ai][m]; }
    }
}
__device__ __forceinline__ void dequant_i8_cols(Acc& acc, const float* sb, int wc, int fq) {
#pragma unroll
    for (int bj = 0; bj < 2; ++bj) {
        const f32x4 c0 = *(const f32x4*)(sb + wc * 64 + bj * 32 + 8 * fq), c1 = *(const f32x4*)(sb + wc * 64 + bj * 32 + 8 * fq + 4);
        PG8_FOR_AM { const v4i32 q0 = __builtin_bit_cast(v4i32, acc[ai][bj][m][0]), q1 = __builtin_bit_cast(v4i32, acc[ai][bj][m][1]); f32x4 v0, v1;
            v0[0] = (float)q0[0]; v0[1] = (float)q0[1]; v0[2] = (float)q0[2]; v0[3] = (float)q0[3]; v1[0] = (float)q1[0]; v1[1] = (float)q1[1]; v1[2] = (float)q1[2]; v1[3] = (float)q1[3];
            acc[ai][bj][m][0] = v0 * c0; acc[ai][bj][m][1] = v1 * c1; }
    }
}
constexpr float LOG2E = 1.4426950408889634f;
constexpr float NORM_EPS = 1e-6f;
struct EpiQK {
    bf16_t* r0; size_t rstride; const float* qg; const float* kg; const float* sa; const float* sb;
    __device__ __forceinline__ void operator()(Acc& acc, const Unit& u, int wr, int wc, int fr, int fq) const {
        dequant_i8_cols(acc, sb + u.pn * BM, wc, fq);
        const int type = u.pn >> 2, colt = (u.pn & 3) * BM, c0 = wc * 64 + 8 * fq;
        const float* gp = type == 0 ? qg : kg; const float sc = type == 0 ? 0.125f * LOG2E : 1.0f;
        f32x4 gv[2][2];
        PG8_FOR_BN gv[bj][n] = *(const f32x4*)(gp + bj * 32 + 8 * fq + 4 * n) * sc;
        bf16_t* base = r0 + (size_t)type * rstride + (size_t)u.pm * BM * 1024 + colt + c0;
        PG8_FOR_AM { float ss = 0.f; PG8_FOR_BN ss += dot4(acc[ai][bj][m][n]);
            ss += __shfl_xor(ss, 16); ss += __shfl_xor(ss, 32);
            const float ra = sa[u.pm * BM + ai * HALF + wr * 64 + m * 16 + fr];
            const float rstd = __builtin_amdgcn_rsqf(ss * (1.0f / 64.0f) + NORM_EPS * __builtin_amdgcn_rcpf(ra * ra + 1e-30f));
            bf16_t* rowp = base + (size_t)(ai * HALF + wr * 64 + m * 16 + fr) * 1024;
#pragma unroll
            for (int bj = 0; bj < 2; ++bj) *(u32x4*)(rowp + bj * 32) = pack8(acc[ai][bj][m][0] * (gv[bj][0] * rstd), acc[ai][bj][m][1] * (gv[bj][1] * rstd)); }
    }
};
struct EpiP1b {
    bf16_t* rv; bf16_t* rgb; bf16_t* rin; const float* sa; const float* sb;
    __device__ __forceinline__ void operator()(Acc& acc, const Unit& u, int wr, int wc, int fr, int fq) const {
        dequant_i8(acc, sa + u.pm * BM, sb + u.pn * BM, wr, wc, fr, fq);
        if (u.pn < 8) {
            store_tile_bf16(acc, (u.pn < 4 ? rv : rgb) + (size_t)u.pm * BM * 1024 + (u.pn & 3) * BM + wc * 64 + 8 * fq, 1024, wr, fr);
        } else {
            bf16_t* base = rin + (size_t)u.pm * BM * 1024 + (u.pn - 8) * 128 + wc * 32 + 8 * fq;
            PG8_FOR_AM *(u32x4*)(base + (size_t)(ai * HALF + wr * 64 + m * 16 + fr) * 1024) = pack8(acc[ai][0][m][0] * acc[ai][1][m][0], acc[ai][0][m][1] * acc[ai][1][m][1]);
        }
    }
};
struct EpiQm {
    bf16_t* O; PG8_LAS float* X; const float* sa; const float* sb;
    __device__ __forceinline__ void operator()(Acc& acc, const Unit& u, int wr, int wc, int fr, int fq) const {
        dequant_i8_cols(acc, sb + u.pn * BM, wc, fq);
        float s[2][4];
        PG8_FOR_AM { float ss = 0.f; PG8_FOR_BN ss += dot4(acc[ai][bj][m][n]); s[ai][m] = ss; }
        row_sum_xchg(s, X, wr, wc, fr, fq);
        PG8_FOR_AM { const float ra = sa[u.pm * BM + ai * HALF + wr * 64 + m * 16 + fr]; const float rstd = __builtin_amdgcn_rsqf(s[ai][m] * (1.0f / 256.0f) + NORM_EPS * __builtin_amdgcn_rcpf(ra * ra + 1e-30f)); PG8_FOR_BN acc[ai][bj][m][n] = acc[ai][bj][m][n] * rstd; }
        asm volatile("s_waitcnt lgkmcnt(0)" ::: "memory"); __builtin_amdgcn_s_barrier(); asm volatile("" ::: "memory");
        store_tile_bf16(acc, O + (size_t)u.pm * BM * 1024 + u.pn * BM + wc * 64 + 8 * fq, 1024, wr, fr);
    }
};
struct EpiMemK {
    bf16_t* O; const float* gq; const float* gk; PG8_LAS float* X;
    __device__ __forceinline__ void operator()(Acc& acc, const Unit& u, int wr, int wc, int fr, int fq) const {
        const int c0 = wc * 64 + 8 * fq;
        f32x4 gv[2][2];
        PG8_FOR_BN gv[bj][n] = *(const f32x4*)(gq + c0 + bj * 32 + 4 * n) * *(const f32x4*)(gk + c0 + bj * 32 + 4 * n) * (LOG2E / 16.0f);
        float s[2][4];
        PG8_FOR_AM { float ss = 0.f; PG8_FOR_BN ss += dot4(acc[ai][bj][m][n]); s[ai][m] = ss; }
        row_sum_xchg(s, X, wr, wc, fr, fq);
        PG8_FOR_AM { const float rstd = __builtin_amdgcn_rsqf(s[ai][m] * (1.0f / 256.0f) + NORM_EPS); PG8_FOR_BN acc[ai][bj][m][n] = acc[ai][bj][m][n] * (gv[bj][n] * rstd); }
        asm volatile("s_waitcnt lgkmcnt(0)" ::: "memory"); __builtin_amdgcn_s_barrier(); asm volatile("" ::: "memory");
        store_tile_bf16(acc, O + (size_t)u.pm * BM * 1024 + u.pn * BM + c0, 1024, wr, fr);
    }
};
struct EpiPlain {
    bf16_t* O; int ldc;
    __device__ __forceinline__ void operator()(Acc& acc, const Unit& u, int wr, int wc, int fr, int fq) const {
        store_tile_bf16(acc, O + (size_t)u.pm * BM * ldc + u.pn * BM + wc * 64 + 8 * fq, ldc, wr, fr);
    }
};
struct EpiSoftmax {
    bf16_t* O; PG8_LAS float* X;
    __device__ __forceinline__ void operator()(Acc& acc, const Unit& u, int wr, int wc, int fr, int fq) const {
        float s[2][4];
        PG8_FOR_AM { float ss = 0.f; PG8_FOR_BN { f32x4& v = acc[ai][bj][m][n]; v[0] = __builtin_amdgcn_exp2f(v[0]); v[1] = __builtin_amdgcn_exp2f(v[1]); v[2] = __builtin_amdgcn_exp2f(v[2]); v[3] = __builtin_amdgcn_exp2f(v[3]); ss += sum4(v); } s[ai][m] = ss; }
        row_sum_xchg(s, X, wr, wc, fr, fq);
        PG8_FOR_AM { const float inv = __builtin_amdgcn_rcpf(s[ai][m]); PG8_FOR_BN acc[ai][bj][m][n] = acc[ai][bj][m][n] * inv; }
        asm volatile("s_waitcnt lgkmcnt(0)" ::: "memory"); __builtin_amdgcn_s_barrier(); asm volatile("" ::: "memory");
        store_tile_bf16(acc, O + (size_t)u.pm * BM * 1024 + u.pn * BM + wc * 64 + 8 * fq, 1024, wr, fr);
    }
};
struct EpiGate {
    bf16_t* g0; size_t gstride; const float* bias; const float* sa; const float* sb;
    __device__ __forceinline__ void operator()(Acc& acc, const Unit& u, int wr, int wc, int fr, int fq) const {
        dequant_i8(acc, sa + u.pm * BM, sb + u.pn * BM, wr, wc, fr, fq);
        const int br = u.pn >> 2, colt = (u.pn & 3) * BM, c0 = wc * 64 + 8 * fq;
        f32x4 bv[2][2];
        PG8_FOR_BN bv[bj][n] = *(const f32x4*)(bias + u.pn * BM + c0 + bj * 32 + 4 * n);
        PG8_FOR_AM PG8_FOR_BN { f32x4 v = acc[ai][bj][m][n] + bv[bj][n];
#pragma unroll
            for (int e = 0; e < 4; ++e) v[e] = __builtin_amdgcn_rcpf(1.0f + __builtin_amdgcn_exp2f(-LOG2E * v[e]));
            acc[ai][bj][m][n] = v; }
        store_tile_bf16(acc, g0 + (size_t)br * gstride + (size_t)u.pm * BM * 1024 + colt + c0, 1024, wr, fr);
    }
};
template <bool ACCUM> struct EpiBranch {
    const bf16_t* g; bf16_t* O;
    __device__ __forceinline__ void operator()(Acc& acc, const Unit& u, int wr, int wc, int fr, int fq) const {
        const size_t off0 = (size_t)u.pm * BM * 1024 + u.pn * BM + wc * 64 + 8 * fq + (size_t)(wr * 64 + fr) * 1024;
#pragma unroll
        for (int ai = 0; ai < 2; ++ai) {
            u32x4 gq[4][2], oq[4][2];
#pragma unroll
            for (int m = 0; m < 4; ++m)
#pragma unroll
                for (int bj = 0; bj < 2; ++bj) { gq[m][bj] = *(const u32x4*)(g + off0 + (size_t)(ai * HALF + m * 16) * 1024 + bj * 32);
                    if (ACCUM) oq[m][bj] = *(const u32x4*)(O + off0 + (size_t)(ai * HALF + m * 16) * 1024 + bj * 32); }
#pragma unroll
            for (int m = 0; m < 4; ++m)
#pragma unroll
                for (int bj = 0; bj < 2; ++bj) { f32x4 g0v, g1v; unpack8(gq[m][bj], g0v, g1v);
                    f32x4 v0 = acc[ai][bj][m][0] * g0v, v1 = acc[ai][bj][m][1] * g1v;
                    if (ACCUM) { f32x4 p0, p1; unpack8(oq[m][bj], p0, p1); v0 = v0 + p0; v1 = v1 + p1; }
                    *(u32x4*)(O + off0 + (size_t)(ai * HALF + m * 16) * 1024 + bj * 32) = pack8(v0, v1); }
        }
    }
};
struct EpiBranch3 {
    const bf16_t* g0; const bf16_t* g1; const bf16_t* g2; bf16_t* O;
    __device__ __forceinline__ void operator()(Acc& acc, const Unit& u, int wr, int wc, int fr, int fq) const {
        const size_t off0 = (size_t)u.pm * BM * 1024 + u.pn * BM + wc * 64 + 8 * fq + (size_t)(wr * 64 + fr) * 1024;
        const bf16_t* gn = u.seg == 0 ? g0 : u.seg == 1 ? g1 : g2;
        const bf16_t* gd = u.seg == 0 ? g1 : g2;
        const bool last = u.seg == 2;
#pragma unroll
        for (int ai = 0; ai < 2; ++ai) {
            u32x4 nq[4][2], dq[4][2];
#pragma unroll
            for (int m = 0; m < 4; ++m)
#pragma unroll
                for (int bj = 0; bj < 2; ++bj) { nq[m][bj] = *(const u32x4*)(gn + off0 + (size_t)(ai * HALF + m * 16) * 1024 + bj * 32);
                    if (!last) dq[m][bj] = *(const u32x4*)(gd + off0 + (size_t)(ai * HALF + m * 16) * 1024 + bj * 32); }
#pragma unroll
            for (int m = 0; m < 4; ++m)
#pragma unroll
                for (int bj = 0; bj < 2; ++bj) { f32x4 n0, n1; unpack8(nq[m][bj], n0, n1);
                    if (!last) { f32x4 d0, d1; unpack8(dq[m][bj], d0, d1);
#pragma unroll
                        for (int e = 0; e < 4; ++e) { n0[e] *= __builtin_amdgcn_rcpf(__builtin_fmaxf(d0[e], 1e-20f)); n1[e] *= __builtin_amdgcn_rcpf(__builtin_fmaxf(d1[e], 1e-20f)); } }
                    acc[ai][bj][m][0] = acc[ai][bj][m][0] * n0; acc[ai][bj][m][1] = acc[ai][bj][m][1] * n1;
                    if (last) *(u32x4*)(O + off0 + (size_t)(ai * HALF + m * 16) * 1024 + bj * 32) = pack8(acc[ai][bj][m][0], acc[ai][bj][m][1]); }
        }
    }
};
struct EpiResF32 {
    const float* base; float* out;
    __device__ __forceinline__ void operator()(Acc& acc, const Unit& u, int wr, int wc, int fr, int fq) const {
        const size_t off0 = (size_t)u.pm * BM * 1024 + u.pn * BM + wc * 64 + 8 * fq + (size_t)(wr * 64 + fr) * 1024;
#pragma unroll
        for (int ai = 0; ai < 2; ++ai) {
            f32x4 bv[4][2][2];
#pragma unroll
            for (int m = 0; m < 4; ++m) PG8_FOR_BN bv[m][bj][n] = *(const f32x4*)(base + off0 + (size_t)(ai * HALF + m * 16) * 1024 + bj * 32 + 4 * n);
#pragma unroll
            for (int m = 0; m < 4; ++m) PG8_FOR_BN *(f32x4*)(out + off0 + (size_t)(ai * HALF + m * 16) * 1024 + bj * 32 + 4 * n) = bv[m][bj][n] + acc[ai][bj][m][n];
        }
    }
};
struct EpiX1 {
    const float* base; float* out; bf16_t* xb; float* stats;
    __device__ __forceinline__ void operator()(Acc& acc, const Unit& u, int wr, int wc, int fr, int fq) const {
        const size_t off0 = (size_t)u.pm * BM * 1024 + u.pn * BM + wc * 64 + 8 * fq + (size_t)(wr * 64 + fr) * 1024;
#pragma unroll
        for (int ai = 0; ai < 2; ++ai) {
            f32x4 bv[4][2][2];
#pragma unroll
            for (int m = 0; m < 4; ++m) PG8_FOR_BN bv[m][bj][n] = *(const f32x4*)(base + off0 + (size_t)(ai * HALF + m * 16) * 1024 + bj * 32 + 4 * n);
#pragma unroll
            for (int m = 0; m < 4; ++m) { const size_t ro = off0 + (size_t)(ai * HALF + m * 16) * 1024; float ss = 0.f;
                PG8_FOR_BN { const f32x4 v = bv[m][bj][n] + acc[ai][bj][m][n]; acc[ai][bj][m][n] = v; ss += dot4(v); }
#pragma unroll
                for (int bj = 0; bj < 2; ++bj) *(u32x4*)(xb + ro + bj * 32) = pack8(acc[ai][bj][m][0], acc[ai][bj][m][1]);
                ss += __shfl_xor(ss, 16); ss += __shfl_xor(ss, 32);
                if (fq == 0) stats[(size_t)(u.pm * BM + ai * HALF + wr * 64 + m * 16 + fr) * 16 + u.pn * 4 + wc] = ss; }
        }
    }
};
struct EpiRelu2P {
    bf16_t* O; int ldc;
    __device__ __forceinline__ void operator()(Acc& acc, const Unit& u, int wr, int wc, int fr, int fq) const {
        bf16_t* base = O + (size_t)u.pm * BM * ldc + u.pn * BM + wc * 64 + 8 * fq;
        PG8_FOR_AM {
            PG8_FOR_BN { f32x4 v = acc[ai][bj][m][n];
#pragma unroll
                for (int e = 0; e < 4; ++e) { const float r = __builtin_fmaxf(v[e], 0.f); v[e] = r * r; }
                acc[ai][bj][m][n] = v; }
#pragma unroll
            for (int bj = 0; bj < 2; ++bj) *(u32x4*)(base + (size_t)(ai * HALF + wr * 64 + m * 16 + fr) * ldc + bj * 32) = pack8(acc[ai][bj][m][0], acc[ai][bj][m][1]); }
    }
};
struct EpiOutN {
    const bf16_t* xb; float* out; const float* stats;
    __device__ __forceinline__ void operator()(Acc& acc, const Unit& u, int wr, int wc, int fr, int fq) const {
        const size_t off0 = (size_t)u.pm * BM * 1024 + u.pn * BM + wc * 64 + 8 * fq + (size_t)(wr * 64 + fr) * 1024;
        float rs[2][4];
        PG8_FOR_AM rs[ai][m] = sum4(*(const f32x4*)(stats + (size_t)(u.pm * BM + ai * HALF + wr * 64 + m * 16 + fr) * 16 + 4 * fq));
#pragma unroll
        for (int ai = 0; ai < 2; ++ai) {
            u32x4 bq[4][2];
#pragma unroll
            for (int m = 0; m < 4; ++m)
#pragma unroll
                for (int bj = 0; bj < 2; ++bj) bq[m][bj] = *(const u32x4*)(xb + off0 + (size_t)(ai * HALF + m * 16) * 1024 + bj * 32);
#pragma unroll
            for (int m = 0; m < 4; ++m) { float t = rs[ai][m]; t += __shfl_xor(t, 16); t += __shfl_xor(t, 32);
                const float r2 = __builtin_amdgcn_rcpf(t * (1.0f / 1024.0f) + NORM_EPS);
#pragma unroll
                for (int bj = 0; bj < 2; ++bj) { f32x4 p0, p1; unpack8(bq[m][bj], p0, p1);
                    *(f32x4*)(out + off0 + (size_t)(ai * HALF + m * 16) * 1024 + bj * 32) = p0 + acc[ai][bj][m][0] * r2;
                    *(f32x4*)(out + off0 + (size_t)(ai * HALF + m * 16) * 1024 + bj * 32 + 4) = p1 + acc[ai][bj][m][1] * r2; } }
        }
    }
};
struct EpiRelu2N {
    bf16_t* O; int ldc; const float* stats;
    __device__ __forceinline__ void operator()(Acc& acc, const Unit& u, int wr, int wc, int fr, int fq) const {
        bf16_t* base = O + (size_t)u.pm * BM * ldc + u.pn * BM + wc * 64 + 8 * fq;
        float rs[2][4];
        PG8_FOR_AM rs[ai][m] = sum4(*(const f32x4*)(stats + (size_t)(u.pm * BM + ai * HALF + wr * 64 + m * 16 + fr) * 16 + 4 * fq));
        PG8_FOR_AM { float t = rs[ai][m]; t += __shfl_xor(t, 16); t += __shfl_xor(t, 32); rs[ai][m] = __builtin_amdgcn_rsqf(t * (1.0f / 1024.0f) + NORM_EPS); }
        PG8_FOR_AM { const float rstd = rs[ai][m];
            PG8_FOR_BN { f32x4 v = acc[ai][bj][m][n] * rstd;
#pragma unroll
                for (int e = 0; e < 4; ++e) { const float r = __builtin_fmaxf(v[e], 0.f); v[e] = r * r; }
                acc[ai][bj][m][n] = v; }
#pragma unroll
            for (int bj = 0; bj < 2; ++bj) *(u32x4*)(base + (size_t)(ai * HALF + wr * 64 + m * 16 + fr) * ldc + bj * 32) = pack8(acc[ai][bj][m][0], acc[ai][bj][m][1]); }
    }
};

template <class Epi, class Sched, bool ALIGN_EPI = false, bool SP2 = false, bool SEG3 = false, bool F8 = false, bool I8 = false>
__device__ __forceinline__ void gemm_phase(PG8_LAS unsigned char* lds, const Gemm g, const Sched& S, const Epi& E) {
    int tid_ = threadIdx.x; asm volatile("" : "+v"(tid_));
    const int tid = tid_, wid = __builtin_amdgcn_readfirstlane(tid >> 6), lane = tid & 63, wr = wid >> 2, wc = wid & 3, fr = lane & 15, fq = lane >> 4;
    const int K = g.K, nt = K / BK;
    unsigned voffA[2], voffB[2];
#pragma unroll
    for (int i = 0; i < 2; ++i) { int R, C; stage_rc(tid * 16 + i * 8192, R, C); const int Rb = 64 * (R >> 5) + perm32(R & 31);
        voffA[i] = (unsigned)(R * g.lda + C) * 2u; voffB[i] = (unsigned)(Rb * g.ldb + C) * 2u; }
    const size_t kstep = (size_t)(BK * 2);
    const size_t hstepA = (size_t)HALF * g.lda * 2;
    const size_t hstepB = (size_t)32 * g.ldb * 2;
    const unsigned ldsw = (unsigned)wid * 1024u;
    const int aoff = lds_byte(wr * 64 + fr, fq * 8), boff = lds_byte(wc * 32 + fr, fq * 8);
#define PG8_SA(b, h) (((b) * 2 + (h)) * HTB)
#define PG8_SB(b, h) ((4 + (b) * 2 + (h)) * HTB)
#define PG8_STAGE(bufoff, gbase, voff) do { _Pragma("unroll") for (int _i = 0; _i < 2; ++_i) \
        __builtin_amdgcn_global_load_lds((const unsigned*)((const char*)(gbase) + (voff)[_i]), (PG8_LAS unsigned*)(lds + (bufoff) + ldsw + _i * 8192), 16, 0, 0); } while (0)
#define PG8_LDA(dst, b, h) do { if constexpr (F8) { _Pragma("unroll") for (int m = 0; m < 4; ++m) dst##8[m] = pg8_cat(*(const PG8_LAS bf16x8*)(lds + PG8_SA(b, h) + aoff + m * 2048), *(const PG8_LAS bf16x8*)(lds + PG8_SA(b, h) + aoff + m * 2048 + 1024)); } \
        else { _Pragma("unroll") for (int m = 0; m < 4; ++m) _Pragma("unroll") for (int k = 0; k < 2; ++k) dst[m][k] = *(const PG8_LAS bf16x8*)(lds + PG8_SA(b, h) + aoff + m * 2048 + k * 1024); } } while (0)
#define PG8_LDB(dst, b, h) do { if constexpr (F8) { _Pragma("unroll") for (int n = 0; n < 2; ++n) dst##8[n] = pg8_cat(*(const PG8_LAS bf16x8*)(lds + PG8_SB(b, h) + boff + n * 2048), *(const PG8_LAS bf16x8*)(lds + PG8_SB(b, h) + boff + n * 2048 + 1024)); } \
        else { _Pragma("unroll") for (int n = 0; n < 2; ++n) _Pragma("unroll") for (int k = 0; k < 2; ++k) dst[n][k] = *(const PG8_LAS bf16x8*)(lds + PG8_SB(b, h) + boff + n * 2048 + k * 1024); } } while (0)
#define PG8_MMA(ai, bj, At, Bt) do { __builtin_amdgcn_s_setprio(1); _Pragma("unroll") for (int m = 0; m < 4; ++m) _Pragma("unroll") for (int n = 0; n < 2; ++n) { \
        if constexpr (F8) { asm volatile("v_mfma_f32_16x16x128_f8f6f4 %0, %1, %2, %0" : "+v"(acc[ai][bj][m][n]) : "v"(Bt##8[n]), "v"(At##8[m])); }     \
        else if constexpr (I8) { _Pragma("unroll") for (int k = 0; k < 2; ++k) acc[ai][bj][m][n] = __builtin_bit_cast(f32x4, __builtin_amdgcn_mfma_i32_16x16x64_i8(__builtin_bit_cast(v4i32, Bt[n][k]), __builtin_bit_cast(v4i32, At[m][k]), __builtin_bit_cast(v4i32, acc[ai][bj][m][n]), 0, 0, 0)); } \
        else { _Pragma("unroll") for (int k = 0; k < 2; ++k) acc[ai][bj][m][n] = __builtin_amdgcn_mfma_f32_16x16x32_bf16(Bt[n][k], At[m][k], acc[ai][bj][m][n], 0, 0, 0); } } __builtin_amdgcn_s_setprio(0); } while (0)
#define PG8_WAIT_V(n) asm volatile("s_waitcnt vmcnt(" #n ")" ::: "memory")
#define PG8_WAIT_L(n) asm volatile("s_waitcnt lgkmcnt(" #n ")" ::: "memory")
#define PG8_BAR __builtin_amdgcn_s_barrier()
#define PG8_SCHED __builtin_amdgcn_sched_barrier(0)
    Unit cur, nxt; int ui = 0;
    if (!S.next(0, cur)) return;
    f32x4 acc[2][2][4][2];
#pragma unroll
    for (int a = 0; a < 2; ++a)
#pragma unroll
        for (int b = 0; b < 2; ++b)
#pragma unroll
            for (int m = 0; m < 4; ++m)
#pragma unroll
                for (int n = 0; n < 2; ++n) acc[a][b][m][n] = (f32x4){0.f, 0.f, 0.f, 0.f};
    bf16x8 At[4][2], B0[2][2], B1[2][2]; v8i32 At8[4], B08[2], B18[2];
#define PG8_APTR(u) (const char*)((SEG3 ? ((u).seg == 0 ? g.A : (u).seg == 1 ? g.A1 : g.A2) : g.A) + (size_t)(u).pm * g.sAm + (size_t)(u).pn * g.sAn)
#define PG8_BPTR(u) (const char*)(g.Bt + (SEG3 ? (size_t)(u).seg * g.sBseg : (size_t)0) + (size_t)(u).pn * g.sBn + (size_t)((u).pm >> 4) * g.sBb)
    const char* cA = PG8_APTR(cur); const char* cB = PG8_BPTR(cur);
    S.a_ready(cur);
    if constexpr (SP2) {
        PG8_STAGE(PG8_SB(0, 0), cB, voffB); PG8_STAGE(PG8_SB(0, 1), cB + hstepB, voffB); PG8_STAGE(PG8_SA(0, 0), cA, voffA); PG8_STAGE(PG8_SA(0, 1), cA + hstepA, voffA);
        if (wr == 1) PG8_BAR;
        PG8_WAIT_V(2); PG8_BAR;
        PG8_STAGE(PG8_SB(1, 0), cB + kstep, voffB); PG8_STAGE(PG8_SA(1, 0), cA + kstep, voffA); PG8_STAGE(PG8_SB(1, 1), cB + hstepB + kstep, voffB);
        PG8_WAIT_V(6); PG8_BAR;
    } else {
        PG8_STAGE(PG8_SB(0, 0), cB, voffB); PG8_STAGE(PG8_SA(0, 0), cA, voffA); PG8_STAGE(PG8_SB(0, 1), cB + hstepB, voffB); PG8_STAGE(PG8_SA(0, 1), cA + hstepA, voffA);
        if (wr == 1) PG8_BAR;
        PG8_WAIT_V(4); PG8_BAR;
        PG8_STAGE(PG8_SB(1, 0), cB + kstep, voffB); PG8_STAGE(PG8_SA(1, 0), cA + kstep, voffA); PG8_STAGE(PG8_SB(1, 1), cB + hstepB + kstep, voffB);
        PG8_WAIT_V(6); PG8_BAR;
    }
    for (;;) {
        const bool has_next = S.next(ui + 1, nxt);
        const char* nA = has_next ? PG8_APTR(nxt) : cA; const char* nB = has_next ? PG8_BPTR(nxt) : cB;
#pragma nounroll
        for (int t = 0; t < nt; t += 2) {
            const bool last = (t == nt - 2);
            const char* a1 = cA + (size_t)(t + 1) * kstep;
            const char* a2 = last ? nA : cA + (size_t)(t + 2) * kstep; const char* b2 = last ? nB : cB + (size_t)(t + 2) * kstep;
            const char* a3 = a2 + kstep; const char* b3 = b2 + kstep;
            if (last && has_next) S.a_ready(nxt);
            if constexpr (SP2) {
            PG8_LDB(B0, 0, 0); PG8_LDB(B1, 0, 1); PG8_SCHED; PG8_LDA(At, 0, 0); PG8_STAGE(PG8_SA(1, 1), a1 + hstepA, voffA);
            PG8_WAIT_V(8); PG8_WAIT_L(0); PG8_BAR; PG8_MMA(0, 0, At, B0); PG8_MMA(0, 1, At, B1); PG8_BAR; PG8_SCHED;
            PG8_LDA(At, 0, 1); PG8_STAGE(PG8_SB(0, 0), b2, voffB); PG8_STAGE(PG8_SB(0, 1), b2 + hstepB, voffB); PG8_STAGE(PG8_SA(0, 0), a2, voffA);
            PG8_WAIT_V(8); PG8_WAIT_L(0); PG8_BAR; PG8_MMA(1, 0, At, B0); PG8_MMA(1, 1, At, B1); PG8_BAR; PG8_SCHED;
            PG8_LDB(B0, 1, 0); PG8_LDB(B1, 1, 1); PG8_SCHED; PG8_LDA(At, 1, 0); PG8_STAGE(PG8_SA(0, 1), a2 + hstepA, voffA);
            PG8_WAIT_V(8); PG8_WAIT_L(0); PG8_BAR; PG8_MMA(0, 0, At, B0); PG8_MMA(0, 1, At, B1); PG8_BAR; PG8_SCHED;
            PG8_LDA(At, 1, 1); PG8_STAGE(PG8_SB(1, 0), b3, voffB); PG8_STAGE(PG8_SB(1, 1), b3 + hstepB, voffB); PG8_STAGE(PG8_SA(1, 0), a3, voffA);
            PG8_WAIT_V(8); PG8_WAIT_L(0); PG8_BAR; PG8_MMA(1, 0, At, B0); PG8_MMA(1, 1, At, B1); PG8_BAR; PG8_SCHED;
            } else {
            PG8_LDB(B0, 0, 0); PG8_SCHED; PG8_LDA(At, 0, 0); PG8_STAGE(PG8_SA(1, 1), a1 + hstepA, voffA);
            PG8_WAIT_L(8); PG8_BAR; PG8_WAIT_L(0); PG8_MMA(0, 0, At, B0); PG8_BAR; PG8_SCHED;
            PG8_LDB(B1, 0, 1); PG8_STAGE(PG8_SB(0, 0), b2, voffB);
            PG8_BAR; PG8_WAIT_L(0); PG8_MMA(0, 1, At, B1); PG8_BAR;
            PG8_LDA(At, 0, 1); PG8_STAGE(PG8_SA(0, 0), a2, voffA);
            PG8_BAR; PG8_WAIT_L(0); PG8_MMA(1, 0, At, B0); PG8_BAR; PG8_SCHED;
            PG8_STAGE(PG8_SB(0, 1), b2 + hstepB, voffB);
            PG8_WAIT_V(6); PG8_BAR; PG8_MMA(1, 1, At, B1); PG8_BAR;
            PG8_LDB(B0, 1, 0); PG8_SCHED; PG8_LDA(At, 1, 0); PG8_STAGE(PG8_SA(0, 1), a2 + hstepA, voffA);
            PG8_WAIT_L(8); PG8_BAR; PG8_WAIT_L(0); PG8_MMA(0, 0, At, B0); PG8_BAR; PG8_SCHED;
            PG8_LDB(B1, 1, 1); PG8_STAGE(PG8_SB(1, 0), b3, voffB);
            PG8_BAR; PG8_WAIT_L(0); PG8_MMA(0, 1, At, B1); PG8_BAR;
            PG8_LDA(At, 1, 1); PG8_STAGE(PG8_SA(1, 0), a3, voffA);
            PG8_BAR; PG8_WAIT_L(0); PG8_MMA(1, 0, At, B0); PG8_BAR; PG8_SCHED;
            PG8_STAGE(PG8_SB(1, 1), b3 + hstepB, voffB);
            PG8_WAIT_V(6); PG8_BAR; PG8_MMA(1, 1, At, B1); PG8_BAR;
            }
        }
        if constexpr (ALIGN_EPI) { if (wr == 0) PG8_BAR; }
        E(acc, cur, wr, wc, fr, fq); S.done(cur);
        if (!has_next) break;
        if (!(SEG3 && cur.seg < 2))
#pragma unroll
        for (int a = 0; a < 2; ++a)
#pragma unroll
            for (int b = 0; b < 2; ++b)
#pragma unroll
                for (int m = 0; m < 4; ++m)
#pragma unroll
                    for (int n = 0; n < 2; ++n) acc[a][b][m][n] = (f32x4){0.f, 0.f, 0.f, 0.f};
        cur = nxt; cA = nA; cB = nB; ++ui;
        if constexpr (ALIGN_EPI) { if (wr == 1) PG8_BAR; }
    }
    PG8_WAIT_V(0);
    if constexpr (!ALIGN_EPI) { if (wr == 0) PG8_BAR; }
    PG8_BAR;
#undef PG8_APTR
#undef PG8_BPTR
#undef PG8_SA
#undef PG8_SB
#undef PG8_STAGE
#undef PG8_LDA
#undef PG8_LDB
#undef PG8_MMA
#undef PG8_WAIT_V
#undef PG8_WAIT_L
#undef PG8_BAR
#undef PG8_SCHED
}
}
#include <hip/hip_bf16.h>
#include <cmath>
namespace attn_body {
using bf16=__hip_bfloat16;
using bf16x8=__attribute__((ext_vector_type(8)))short;
using s16x4=__attribute__((ext_vector_type(4)))short;
using f32x16=__attribute__((ext_vector_type(16)))float;
using u32x4=__attribute__((ext_vector_type(4)))unsigned;
constexpr int BATCH=8,NHEAD=16,SEQ=4096,D=64,DM=NHEAD*D;
constexpr int NW=8,QBLK=32,QB=QBLK*NW,KVBLK=64,NQB=SEQ/QB;
constexpr int ATTN_PITCH=DM, ATTN_UNIT_ROWS=QB;
__device__ __forceinline__ int crow(int r,int hi){return (r&3)+8*(r>>2)+4*hi;}
#define SBAR() __builtin_amdgcn_sched_barrier(0)
__device__ __forceinline__ void cmask(f32x16&p0,f32x16&p1,int jb,int qrel,int hi){
  const float NEG=-INFINITY; int kb=64*jb+4*hi;
  #pragma unroll
  for(int r=0;r<16;++r){int kv=kb+(r&3)+8*(r>>2); if(kv>qrel)p0[r]=NEG; if(kv+32>qrel)p1[r]=NEG;}
}

constexpr int NSLOT=3, SLOTB=8192;
constexpr int VSLOTB=2*SLOTB;
constexpr int LDS_K=0, LDS_V=NSLOT*SLOTB, LDS_WS=LDS_V+NSLOT*VSLOTB, LDS_OST=LDS_WS+NW*64*4, LDS_BYTES=LDS_OST+NW*4096;
constexpr float C2=0.125f*1.4426950408889634f;
__device__ __forceinline__ void glds16(const void*gsrc,unsigned lds_dst){unsigned keep;
  asm volatile("s_mov_b32 %0, m0\n\ts_mov_b32 m0, %2\n\ts_nop 0\n\tglobal_load_lds_dwordx4 %1, off\n\ts_mov_b32 m0, %0":"=&s"(keep):"v"(gsrc),"s"(lds_dst):"memory");}
__device__ __forceinline__ float max3f(float a,float b,float c){float r;asm("v_max3_f32 %0, %1, %2, %3":"=v"(r):"v"(a),"v"(b),"v"(c));return r;}
__device__ __forceinline__ float max2f(float a,float b){float r;asm("v_max_f32_e32 %0, %1, %2":"=v"(r):"v"(a),"v"(b));return r;}
__device__ __forceinline__ float fadd_s(float a,float b){float r;asm("v_add_f32_e32 %0, %1, %2":"=v"(r):"v"(a),"v"(b));return r;}
__device__ __forceinline__ float fsub_s(float a,float b){float r;asm("v_sub_f32_e32 %0, %1, %2":"=v"(r):"v"(a),"v"(b));return r;}
typedef float f32x2_t __attribute__((ext_vector_type(2))); typedef __bf16 bf16x2_t __attribute__((ext_vector_type(2)));
__device__ __forceinline__ unsigned cvtpk_s(float lo,float hi){f32x2_t v={lo,hi};bf16x2_t b=__builtin_convertvector(v,bf16x2_t);return __builtin_bit_cast(unsigned,b);}
#define WAIT_BAR(N) asm volatile("s_waitcnt vmcnt(" #N ") lgkmcnt(0)\n\ts_barrier":::"memory")

__device__ __forceinline__ void qkt(f32x16&p0,f32x16&p1,const char*Kslot,const bf16x8*qr,const f32x16&negm,int r32,int hi){
  const char*kb=Kslot+hi*1024+r32*16;
  #pragma unroll
  for(int d0=0;d0<4;++d0){
    const bf16x8 b0=*reinterpret_cast<const bf16x8*>(kb+d0*2048);
    const bf16x8 b1=*reinterpret_cast<const bf16x8*>(kb+d0*2048+512);
    if(d0==0){p0=__builtin_amdgcn_mfma_f32_32x32x16_bf16(b0,qr[0],negm,0,0,0);p1=__builtin_amdgcn_mfma_f32_32x32x16_bf16(b1,qr[0],negm,0,0,0);}
    else{p0=__builtin_amdgcn_mfma_f32_32x32x16_bf16(b0,qr[d0],p0,0,0,0);p1=__builtin_amdgcn_mfma_f32_32x32x16_bf16(b1,qr[d0],p1,0,0,0);}}
}
typedef __attribute__((address_space(3))) const char* lds_cptr;
typedef short v4i16_t __attribute__((ext_vector_type(4)));
__device__ __forceinline__ void kload8(bf16x8*kf,lds_cptr kp){
  kf[0]=*(const __attribute__((address_space(3))) bf16x8*)(kp);      kf[1]=*(const __attribute__((address_space(3))) bf16x8*)(kp+512);
  kf[2]=*(const __attribute__((address_space(3))) bf16x8*)(kp+2048); kf[3]=*(const __attribute__((address_space(3))) bf16x8*)(kp+2560);
  kf[4]=*(const __attribute__((address_space(3))) bf16x8*)(kp+4096); kf[5]=*(const __attribute__((address_space(3))) bf16x8*)(kp+4608);
  kf[6]=*(const __attribute__((address_space(3))) bf16x8*)(kp+6144); kf[7]=*(const __attribute__((address_space(3))) bf16x8*)(kp+6656);
}
__device__ __forceinline__ void kload2(bf16x8*kf,lds_cptr kp,int j){ kf[2*j]=*(const __attribute__((address_space(3))) bf16x8*)(kp+j*2048); kf[2*j+1]=*(const __attribute__((address_space(3))) bf16x8*)(kp+j*2048+512); }
__device__ __forceinline__ s16x4 vtr(lds_cptr p){ return __builtin_bit_cast(s16x4,__builtin_amdgcn_ds_read_tr16_b64_v4i16((__attribute__((address_space(3))) v4i16_t*)p)); }
__device__ __forceinline__ float rowmax(const f32x16&p0,const f32x16&p1){
  float a=max3f(p0[0],p0[1],p1[0]),b=max3f(p0[2],p0[3],p1[1]);a=max3f(a,p1[2],p1[3]);
  #pragma unroll
  for(int r=4;r<16;r+=4){a=max3f(a,p0[r],p0[r+1]);b=max3f(b,p0[r+2],p0[r+3]);a=max3f(a,p1[r],p1[r+1]);b=max3f(b,p1[r+2],p1[r+3]);}
  const float m=max2f(a,b);
  auto rr=__builtin_amdgcn_permlane32_swap(__float_as_uint(m),__float_as_uint(m),false,false);
  return max2f(__uint_as_float(rr[0]),__uint_as_float(rr[1]));
}
__device__ __forceinline__ void pv(f32x16*o,int vb,bf16x8 pa0,bf16x8 pa1,bf16x8 pa2,bf16x8 pa3){
  #pragma unroll
  for(int d0=0;d0<4;++d0){s16x4 lo[4],hi[4];
    #pragma unroll
    for(int ks=0;ks<4;++ks){
      asm volatile("ds_read_b64_tr_b16 %0,%1 offset:%c2":"=&v"(lo[ks]):"v"(vb),"i"(d0*4096+ks*1024):"memory");
      asm volatile("ds_read_b64_tr_b16 %0,%1 offset:%c2":"=&v"(hi[ks]):"v"(vb),"i"(d0*4096+ks*1024+512):"memory");}
    asm volatile("s_waitcnt lgkmcnt(0)":::"memory");SBAR();
    #define PK(k) (bf16x8){lo[k][0],lo[k][1],lo[k][2],lo[k][3],hi[k][0],hi[k][1],hi[k][2],hi[k][3]}
    o[d0]=__builtin_amdgcn_mfma_f32_32x32x16_bf16(pa0,PK(0),o[d0],0,0,0);
    o[d0]=__builtin_amdgcn_mfma_f32_32x32x16_bf16(pa1,PK(1),o[d0],0,0,0);
    o[d0]=__builtin_amdgcn_mfma_f32_32x32x16_bf16(pa2,PK(2),o[d0],0,0,0);
    o[d0]=__builtin_amdgcn_mfma_f32_32x32x16_bf16(pa3,PK(3),o[d0],0,0,0);
    #undef PK
  }
}

#ifndef ATTN_STORE16
#define ATTN_STORE16(p,v) (*(u32x4*)(p)=(v))
#endif
template<int THRL,int MODE> __device__ __forceinline__ void attn_unit(int b,int h,int hv,int qb,const bf16*Q,const bf16*__restrict__ K,const bf16*__restrict__ V,bf16*O,bf16*OUT,float lam,const float*sg,char*shm,
    bool pre,bool has_next,int nb,int nh,int nhv,int nqb,bf16x8 (&qr)[4]){
  int tid_=threadIdx.x; asm volatile("":"+v"(tid_));
  const int tid=tid_,lane=tid&63,r32=lane&31,hi=lane>>5; const int wid=__builtin_amdgcn_readfirstlane(tid>>6);
  if(wid>=4)__builtin_amdgcn_s_setprio(1);
  const long rowbase=(long)b*SEQ; const int q0=qb*QB;
  const bf16*Qw=Q+(rowbase+q0+wid*QBLK)*DM+h*D;
  const bf16*Kh=K+rowbase*DM+h*D,*Vh=V+rowbase*DM+hv*D;
  const unsigned lds0=(unsigned)(uintptr_t)shm;
  float*wsf=(float*)(shm+LDS_WS)+wid*64;
  const bf16*ksrc=Kh+(long)lane*DM+wid*8;
  const bf16*vsrc=Vh+(long)(16*(wid&3)+(lane>>2))*DM+(wid>>2)*32+(lane&3)*8;
  const unsigned kdst=lds0+LDS_K+wid*1024, vdst=lds0+LDS_V+wid*1024;
  #define DMA_K(t,slot) glds16(ksrc+(long)(t)*KVBLK*DM,(unsigned)__builtin_amdgcn_readfirstlane(kdst+(slot)))
  #define DMA_V(t,slot) do{ glds16(vsrc+(long)(t)*KVBLK*DM,(unsigned)__builtin_amdgcn_readfirstlane(vdst+2*(slot))); glds16(vsrc+64+(long)(t)*KVBLK*DM,(unsigned)__builtin_amdgcn_readfirstlane(vdst+2*(slot)+SLOTB)); }while(0)
  const int vb0=(int)(lds0+LDS_V)+((lane>>4)&1)*32+(lane&3)*8+(4*hi+((lane&15)>>2))*64;
  const char*Kbase=shm+LDS_K; bf16x8 kf[8];
  const lds_cptr shm3=(lds_cptr)shm; const lds_cptr kp0=shm3+LDS_K+hi*1024+r32*16; const lds_cptr vp0=shm3+LDS_V+((lane>>4)&1)*32+(lane&3)*8+(4*hi+((lane&15)>>2))*64;
  const int NT=(q0+QB)/KVBLK;
  if(!pre){
  DMA_K(0,0);DMA_V(0,0);DMA_K(1,SLOTB);
  #pragma unroll
  for(int d0=0;d0<4;++d0)qr[d0]=*reinterpret_cast<const bf16x8*>(&Qw[(long)r32*DM+d0*16+hi*8]);
  }
  float l_reg=0.f;f32x16 o[4];o[0]=f32x16{};o[1]=f32x16{};o[2]=f32x16{};o[3]=f32x16{};const f32x16 negm=f32x16{};
  const int qrel=wid*QBLK+r32;
  #define CMASK(P0,P1,t) do{int jb_=(t)-(NT-4); if(jb_>=0)cmask(P0,P1,jb_,qrel,hi);}while(0)
  #define START(P0,P1) do{ _Pragma("unroll") for(int r=0;r<16;++r)P0[r]=__builtin_amdgcn_exp2f(P0[r]); }while(0)
  #define RESC() do{}while(0)
  f32x16 pA0,pA1,pB0,pB1;
  int sl_prev=0,sl_cur=0,sl_next=SLOTB;
  #define ROT() do{sl_prev=sl_cur;sl_cur=sl_next;sl_next=(sl_next==(NSLOT-1)*SLOTB)?0:sl_next+SLOTB;}while(0)
  DMA_K(2,2*SLOTB);
  WAIT_BAR(4);
  qkt(pA0,pA1,Kbase,qr,negm,r32,hi);asm volatile("s_nop 15\n\ts_nop 7":"+v"(pA0),"+v"(pA1));CMASK(pA0,pA1,0);
  START(pA0,pA1);
  _Pragma("unroll") for(int r=0;r<16;++r)pA1[r]=__builtin_amdgcn_exp2f(pA1[r]);
  WAIT_BAR(0);
  DMA_K(3,0);DMA_V(1,SLOTB);
  ROT();
  kload8(kf,kp0+sl_cur);
  WAIT_BAR(3);
  s16x4 vlo[8],vhi[8],wlo[8],whi[8]; u32x4 pw0,pw1,pw2,pw3;
  #define PKW(P,B) cvtpk_s(P[B],P[B+1])
  #define PAF(k) __builtin_bit_cast(bf16x8,pw##k)
  #define VFR(i) (bf16x8){vlo[i][0],vlo[i][1],vlo[i][2],vlo[i][3],vhi[i][0],vhi[i][1],vhi[i][2],vhi[i][3]}
  #define PIN(x) asm volatile("":"+v"(x))
  #define MX3(a,b,c) __builtin_fmaxf(__builtin_fmaxf((a),(b)),(c))
  #define GAPA(MF,A0,A1,A2,A3,W0,W1,PW) do{ MF; sacc+=A0; sacc+=A1; sacc+=A2; sacc+=A3; PIN(sacc); W0; W1; PIN(PW); SBAR(); }while(0)
  #define EX(v) __builtin_amdgcn_exp2f(v)
  #define GAPB(MF,X,B) do{ MF; X[B]=EX(X[B]); X[B+1]=EX(X[B+1]); X[B+2]=EX(X[B+2]); X[B+3]=EX(X[B+3]); PIN(X); SBAR(); }while(0)
  #define VRD(i) do{ vlo[i]=vtr(vp_+(((i)>>2)*4096+((i)&3)*1024)); vhi[i]=vtr(vp_+(((i)>>2)*4096+((i)&3)*1024+512)); }while(0)
  #define VRD1(i) do{ wlo[i]=vtr(vp_+(SLOTB+((i)>>2)*4096+((i)&3)*1024)); whi[i]=vtr(vp_+(SLOTB+((i)>>2)*4096+((i)&3)*1024+512)); SBAR(); }while(0)
  #define VFR1(i) (bf16x8){wlo[i][0],wlo[i][1],wlo[i][2],wlo[i][3],whi[i][0],whi[i][1],whi[i][2],whi[i][3]}
  #define GAPB2(MF,MG,X,B) do{ MF; MG; X[B]=EX(X[B]); X[B+1]=EX(X[B+1]); X[B+2]=EX(X[B+2]); X[B+3]=EX(X[B+3]); PIN(X); SBAR(); }while(0)
  #define KRD(G,j) do{ if(G){ kload2(kf,kp0+sl_next,j); SBAR(); } }while(0)
  #define STEP(C0,C1,P0,P1,t,GK,GV,GL) do{ SBAR(); \
    const lds_cptr vp_=vp0+2*sl_prev; \
    VRD(0); SBAR(); float sacc=(P0[0]+P0[1]); \
    GAPA(C0=__builtin_amdgcn_mfma_f32_32x32x16_bf16(kf[0],qr[0],negm,0,0,0), P0[2],P0[3],P0[4],P0[5],     pw0[0]=PKW(P0,0), pw0[1]=PKW(P0,2), pw0); \
    VRD(4); SBAR(); GAPA(C1=__builtin_amdgcn_mfma_f32_32x32x16_bf16(kf[1],qr[0],negm,0,0,0), P0[6],P0[7],P0[8],P0[9],     pw0[2]=PKW(P0,4), pw0[3]=PKW(P0,6), pw0); \
    VRD(1); SBAR(); GAPA(C0=__builtin_amdgcn_mfma_f32_32x32x16_bf16(kf[2],qr[1],C0,0,0,0),   P0[10],P0[11],P0[12],P0[13], pw1[0]=PKW(P0,8), pw1[1]=PKW(P0,10), pw1); \
    VRD(5); SBAR(); GAPA(C1=__builtin_amdgcn_mfma_f32_32x32x16_bf16(kf[3],qr[1],C1,0,0,0),   P0[14],P0[15],P1[0],P1[1],   pw1[2]=PKW(P0,12),pw1[3]=PKW(P0,14), pw1); \
    VRD(2); SBAR(); GAPA(C0=__builtin_amdgcn_mfma_f32_32x32x16_bf16(kf[4],qr[2],C0,0,0,0),   P1[2],P1[3],P1[4],P1[5],     pw2[0]=PKW(P1,0), pw2[1]=PKW(P1,2), pw2); VRD1(0); \
    VRD(6); SBAR(); GAPA(C1=__builtin_amdgcn_mfma_f32_32x32x16_bf16(kf[5],qr[2],C1,0,0,0),   P1[6],P1[7],P1[8],P1[9],     pw2[2]=PKW(P1,4), pw2[3]=PKW(P1,6), pw2); VRD1(4); \
    VRD(3); SBAR(); GAPA(C0=__builtin_amdgcn_mfma_f32_32x32x16_bf16(kf[6],qr[3],C0,0,0,0),   P1[10],P1[11],P1[12],P1[13], pw3[0]=PKW(P1,8), pw3[1]=PKW(P1,10), pw3); VRD1(1); \
    VRD(7); SBAR(); GAPA(C1=__builtin_amdgcn_mfma_f32_32x32x16_bf16(kf[7],qr[3],C1,0,0,0),   P1[14],P1[15],0.f,0.f,       pw3[2]=PKW(P1,12),pw3[3]=PKW(P1,14), pw3); VRD1(5); \
    l_reg+=sacc; \
    if(GK){DMA_K((t)+3,sl_cur);} if(GV){DMA_V((t)+1,sl_next);} \
    CMASK(C0,C1,t); \
    SBAR(); \
      \
    GAPB(o[0]=__builtin_amdgcn_mfma_f32_32x32x16_bf16(PAF(0),VFR(0),o[0],0,0,0), C0,0); VRD1(2); \
    GAPB2(o[1]=__builtin_amdgcn_mfma_f32_32x32x16_bf16(PAF(0),VFR(4),o[1],0,0,0), o[2]=__builtin_amdgcn_mfma_f32_32x32x16_bf16(PAF(0),VFR1(0),o[2],0,0,0), C0,4); VRD1(6); \
    KRD(GL,0); GAPB2(o[0]=__builtin_amdgcn_mfma_f32_32x32x16_bf16(PAF(1),VFR(1),o[0],0,0,0), o[3]=__builtin_amdgcn_mfma_f32_32x32x16_bf16(PAF(0),VFR1(4),o[3],0,0,0), C0,8); VRD1(3); \
    KRD(GL,1); GAPB2(o[1]=__builtin_amdgcn_mfma_f32_32x32x16_bf16(PAF(1),VFR(5),o[1],0,0,0), o[2]=__builtin_amdgcn_mfma_f32_32x32x16_bf16(PAF(1),VFR1(1),o[2],0,0,0), C0,12); VRD1(7); \
    KRD(GL,2); GAPB2(o[0]=__builtin_amdgcn_mfma_f32_32x32x16_bf16(PAF(2),VFR(2),o[0],0,0,0), o[3]=__builtin_amdgcn_mfma_f32_32x32x16_bf16(PAF(1),VFR1(5),o[3],0,0,0), C1,0); \
    KRD(GL,3); GAPB2(o[1]=__builtin_amdgcn_mfma_f32_32x32x16_bf16(PAF(2),VFR(6),o[1],0,0,0), o[2]=__builtin_amdgcn_mfma_f32_32x32x16_bf16(PAF(2),VFR1(2),o[2],0,0,0), C1,4); \
    GAPB2(o[0]=__builtin_amdgcn_mfma_f32_32x32x16_bf16(PAF(3),VFR(3),o[0],0,0,0), o[3]=__builtin_amdgcn_mfma_f32_32x32x16_bf16(PAF(2),VFR1(6),o[3],0,0,0), C1,8); \
    GAPB2(o[1]=__builtin_amdgcn_mfma_f32_32x32x16_bf16(PAF(3),VFR(7),o[1],0,0,0), o[2]=__builtin_amdgcn_mfma_f32_32x32x16_bf16(PAF(3),VFR1(3),o[2],0,0,0), C1,12); \
    o[3]=__builtin_amdgcn_mfma_f32_32x32x16_bf16(PAF(3),VFR1(7),o[3],0,0,0); SBAR(); \
    }while(0)
  int t=1;
  #undef CMASK
  #define CMASK(P0,P1,t) do{int jb_=(t)-(NT-4); if(jb_>=0)cmask(P0,P1,jb_,qrel,hi);}while(0)
  for(;t+3<NT;t+=2){
    STEP(pB0,pB1,pA0,pA1,t,true,true,true);     WAIT_BAR(3); RESC(); ROT();
    STEP(pA0,pA1,pB0,pB1,t+1,true,true,true);   WAIT_BAR(3); RESC(); ROT();
  }
  #undef CMASK
  #define CMASK(P0,P1,t) do{int jb_=(t)-(NT-4); if(jb_>=0)cmask(P0,P1,jb_,qrel,hi);}while(0)
  #define ENDW(tt) do{ if((tt)+3<NT){WAIT_BAR(3);} else if((tt)+2<NT){WAIT_BAR(2);} else {WAIT_BAR(0);} }while(0)
  #define PVTAIL(P0,P1,slot) do{ float sacc=P0[0]+P0[1]; _Pragma("unroll") for(int r=2;r<16;++r)sacc+=P0[r]; _Pragma("unroll") for(int r=0;r<16;++r)sacc+=P1[r]; l_reg+=sacc; \
    pw0=(u32x4){PKW(P0,0),PKW(P0,2),PKW(P0,4),PKW(P0,6)};pw1=(u32x4){PKW(P0,8),PKW(P0,10),PKW(P0,12),PKW(P0,14)};pw2=(u32x4){PKW(P1,0),PKW(P1,2),PKW(P1,4),PKW(P1,6)};pw3=(u32x4){PKW(P1,8),PKW(P1,10),PKW(P1,12),PKW(P1,14)}; \
    SBAR(); pv(o,vb0+2*(slot),PAF(0),PAF(1),PAF(2),PAF(3)); }while(0)
  STEP(pB0,pB1,pA0,pA1,NT-3,false,true,true);  WAIT_BAR(2); ROT();
  int vslot=sl_prev;
  if(wid>=4){ STEP(pA0,pA1,pB0,pB1,NT-2,false,true,true); WAIT_BAR(0); ROT();
              if(wid>=6){ STEP(pB0,pB1,pA0,pA1,NT-1,false,false,false); vslot=sl_cur; }
              else { pB0=pA0; pB1=pA1; vslot=sl_prev; } }
  else { SBAR(); DMA_V(NT-1,sl_next); WAIT_BAR(0); }
  PVTAIL(pB0,pB1,vslot);
  #undef PVTAIL
  #undef PKW
  #undef PAF
  #undef VFR
  #undef PIN
  #undef MX3
  #undef GAPA
  #undef GAPB
  #undef EX
  #undef VRD
  #undef VRD1
  #undef VFR1
  #undef GAPB2
  #undef KRD
  #undef STEP
  #undef ENDW
  asm volatile("s_waitcnt lgkmcnt(0)\n\ts_barrier":::"memory");
  u32x4 o0v[2][4];
  if(MODE==1){ const bf16*Ow0=O+(rowbase+q0+wid*QBLK)*DM+hv*D;
    #pragma unroll
    for(int hf=0;hf<2;++hf)
      #pragma unroll
      for(int i=0;i<4;++i)o0v[hf][i]=*(const u32x4*)(Ow0+(long)(i*8+(lane>>3))*DM+hf*64+(lane&7)*8); }
  bf16x8 qn[4];
  if(has_next){
    const long nrow=(long)nb*SEQ;
    const bf16*nks=K+nrow*DM+nh*D+(long)lane*DM+wid*8;
    const bf16*nvs=V+nrow*DM+nhv*D+(long)(16*(wid&3)+(lane>>2))*DM+(wid>>2)*32+(lane&3)*8;
    glds16(nks,(unsigned)__builtin_amdgcn_readfirstlane(kdst));
    glds16(nvs,(unsigned)__builtin_amdgcn_readfirstlane(vdst)); glds16(nvs+64,(unsigned)__builtin_amdgcn_readfirstlane(vdst+SLOTB));
    glds16(nks+(long)KVBLK*DM,(unsigned)__builtin_amdgcn_readfirstlane(kdst+SLOTB));
    const bf16*nQw=Q+(nrow+nqb*QB+wid*QBLK)*DM+nh*D;
    #pragma unroll
    for(int d0=0;d0<4;++d0)qn[d0]=*reinterpret_cast<const bf16x8*>(&nQw[(long)r32*DM+d0*16+hi*8]);
  }
  {auto rr=__builtin_amdgcn_permlane32_swap(__float_as_uint(l_reg),__float_as_uint(l_reg),false,false);l_reg=__uint_as_float(rr[0])+__uint_as_float(rr[1]);}
  if(hi==0)wsf[32+r32]=l_reg;asm volatile("s_waitcnt lgkmcnt(0)":::"memory");
  float rli[16];
  #pragma unroll
  for(int r=0;r<16;++r)rli[r]=__builtin_amdgcn_rcpf(wsf[32+crow(r,hi)]);
  bf16*Ow=O+(rowbase+q0+wid*QBLK)*DM+hv*D;
  { bf16*stg=(bf16*)(shm+LDS_OST)+wid*2048;
    float cmb[2][4][8];
    #pragma unroll
    for(int hf=0;hf<2;++hf){
    #pragma unroll
    for(int r=0;r<16;++r){const int orow=crow(r,hi);
      #pragma unroll
      for(int d0=0;d0<2;++d0)stg[orow*64+d0*32+r32]=__float2bfloat16(o[2*hf+d0][r]*rli[r]);}
    asm volatile("s_waitcnt lgkmcnt(0)":::"memory");
    #pragma unroll
    for(int i=0;i<4;++i){const int row=i*8+(lane>>3),ch=lane&7; const u32x4 v=*(const u32x4*)(stg+row*64+ch*8);
      if(MODE==0){ ATTN_STORE16(Ow+(long)row*DM+hf*64+ch*8,v); }
      else { const u32x4 w=o0v[hf][i];
        cmb[hf][i][0]=__uint_as_float(w.x<<16)-lam*__uint_as_float(v.x<<16); cmb[hf][i][1]=__uint_as_float(w.x&0xffff0000u)-lam*__uint_as_float(v.x&0xffff0000u);
        cmb[hf][i][2]=__uint_as_float(w.y<<16)-lam*__uint_as_float(v.y<<16); cmb[hf][i][3]=__uint_as_float(w.y&0xffff0000u)-lam*__uint_as_float(v.y&0xffff0000u);
        cmb[hf][i][4]=__uint_as_float(w.z<<16)-lam*__uint_as_float(v.z<<16); cmb[hf][i][5]=__uint_as_float(w.z&0xffff0000u)-lam*__uint_as_float(v.z&0xffff0000u);
        cmb[hf][i][6]=__uint_as_float(w.w<<16)-lam*__uint_as_float(v.w<<16); cmb[hf][i][7]=__uint_as_float(w.w&0xffff0000u)-lam*__uint_as_float(v.w&0xffff0000u); } }
    asm volatile("s_waitcnt lgkmcnt(0)":::"memory"); }
    if(MODE==1){ bf16*Uw=OUT+(rowbase+q0+wid*QBLK)*DM+hv*D; const int ch=lane&7;
      #pragma unroll
      for(int i=0;i<4;++i){ float ss=0.f;
        #pragma unroll
        for(int hf=0;hf<2;++hf){
          #pragma unroll
          for(int e=0;e<8;++e)ss+=cmb[hf][i][e]*cmb[hf][i][e]; }
        ss+=__shfl_xor(ss,1);ss+=__shfl_xor(ss,2);ss+=__shfl_xor(ss,4);
        const float rstd=0.8f*__builtin_amdgcn_rsqf(ss*(1.0f/128.0f)+1e-6f);
        const int row=i*8+(lane>>3);
        #pragma unroll
        for(int hf=0;hf<2;++hf){ const float*g=sg+hf*64+ch*8; u32x4 w;
          w.x=cvtpk_s(cmb[hf][i][0]*rstd*g[0],cmb[hf][i][1]*rstd*g[1]); w.y=cvtpk_s(cmb[hf][i][2]*rstd*g[2],cmb[hf][i][3]*rstd*g[3]);
          w.z=cvtpk_s(cmb[hf][i][4]*rstd*g[4],cmb[hf][i][5]*rstd*g[5]); w.w=cvtpk_s(cmb[hf][i][6]*rstd*g[6],cmb[hf][i][7]*rstd*g[7]);
          ATTN_STORE16(Uw+(long)row*DM+hf*64+ch*8,w); } } } }
  __builtin_amdgcn_s_setprio(0);
  if(has_next){
    #pragma unroll
    for(int d0=0;d0<4;++d0)qr[d0]=qn[d0];
  }
  #undef DMA_K
  #undef DMA_V
  #undef CMASK
  #undef START
  #undef RESC
  #undef ROT
}
constexpr int ATTN_LDS_BYTES=LDS_BYTES;
struct AttnTensors { const bf16* Q; const bf16* K; const bf16* V; bf16* O0; bf16* OUT; const float* sg; float lam; };
struct AttnUnit { int bh; int qb; };
struct AttnOrder {
  int vcu, G;
  __device__ __forceinline__ bool next(int i,AttnUnit&u)const{ const int L=i*G+vcu; if(L>=BATCH*8*NQB)return false; const int j=L&3, ii=L>>8; u.bh=(L&255)>>2; u.qb=(ii==0)?15-j:(ii==1)?8+j:(ii==2)?7-j:j; return true; }
};
template<int THRL=8> __device__ __forceinline__ void attn_phase(char*lds,const AttnTensors&T,const AttnOrder&S){
  AttnUnit u,un; un.bh=0; un.qb=0; bf16x8 qr[4]; bool pre=false;
  for(int i=0;S.next(i,u);++i){
    const bool hn=S.next(i+1,un);
    const int b=u.bh>>3, h=u.bh&7, nb=un.bh>>3, nh=un.bh&7;
    attn_unit<THRL,0>(b,2*h,2*h,u.qb,T.Q,T.K,T.V,T.O0,T.OUT,T.lam,T.sg,lds, pre,true,b,2*h+1,2*h,u.qb,qr);
    attn_unit<THRL,1>(b,2*h+1,2*h,u.qb,T.Q,T.K,T.V,T.O0,T.OUT,T.lam,T.sg,lds, true,hn,nb,2*nh,2*nh,un.qb,qr);
    pre=true;
  }
  asm volatile("s_waitcnt vmcnt(0) lgkmcnt(0)\n\ts_barrier":::"memory");
}
#undef SBAR
#undef WAIT_BAR
}

constexpr int NWAVES = 8;
constexpr int BATCH = 8, T = 4096, D = 1024, FF = 4096, MEMLEN = 256;
constexpr int M = BATCH * T;
constexpr int MM = BATCH * MEMLEN;
constexpr int NPROJ1 = 7 * D;
constexpr int PROJW = 10 * D;
constexpr size_t MiB = 1u << 20;
constexpr size_t WS_CTL = 0, CTL_ZERO_BYTES = 128 * 1024;
constexpr size_t WS_WIN = 1 * MiB;
constexpr size_t WS_WA = 21 * MiB, WS_WC = 23 * MiB, WS_WM = 25 * MiB, WS_WO = 27 * MiB;
constexpr size_t WS_WKV = 29 * MiB;
constexpr size_t WS_W1 = 33 * MiB;
constexpr size_t WS_W2 = 41 * MiB;
constexpr size_t WS_MEMN = 49 * MiB;
constexpr size_t WS_KP = 53 * MiB;
constexpr size_t WS_VT = 57 * MiB;
constexpr size_t WS_STATS = 61 * MiB;
constexpr size_t REG = 64 * MiB;
constexpr size_t WS_R1 = 1 * REG;
constexpr size_t WS_R2 = 2 * REG;
constexpr size_t WS_R3 = 3 * REG;
constexpr size_t WS_R4 = 4 * REG;
constexpr size_t WS_R5 = 5 * REG;
constexpr size_t WS_R6 = 6 * REG;
constexpr size_t WS_R7 = 7 * REG;
constexpr size_t WS_XN8 = WS_R7;
constexpr size_t WS_W8 = WS_WIN;
constexpr size_t WS_XSC = 63 * MiB;
constexpr size_t WS_WSC = 63 * MiB + 256 * 1024;
constexpr int CW_WMAX = 16384;
constexpr size_t WS_END = 8 * REG;
constexpr int CW_BAR = 4096;

constexpr int RING_OFF = 0, RING_BYTES = 131072;
constexpr int LDSCTL_OFF = RING_BYTES, MISC_OFF = LDSCTL_OFF + 320;
constexpr int XCH_OFF = RING_BYTES + 1024;
constexpr int LDS_BYTES = 147456;
static_assert(XCH_OFF + 8192 <= LDS_BYTES, "LDS map");
#define GAS __attribute__((address_space(1)))
#define LAS __attribute__((address_space(3)))
typedef unsigned short bf16;
typedef unsigned v4u __attribute__((ext_vector_type(4)));
typedef float f32x4 __attribute__((ext_vector_type(4)));
typedef short bf16x8 __attribute__((ext_vector_type(8)));
typedef GAS unsigned gu32;
typedef GAS unsigned long long gu64;
#define RLX_AGENT __ATOMIC_RELAXED, __HIP_MEMORY_SCOPE_AGENT
#define LDS_WAIT() asm volatile("s_waitcnt lgkmcnt(0)" ::: "memory")
#define VM_WAIT() asm volatile("s_waitcnt vmcnt(0)" ::: "memory")
__device__ __forceinline__ unsigned long long rt() { return __builtin_amdgcn_s_memrealtime(); }
__device__ __forceinline__ unsigned f2bf(float f) { unsigned u = __builtin_bit_cast(unsigned, f); return (u + 0x7fffu + ((u >> 16) & 1u)) >> 16; }
__device__ __forceinline__ unsigned pk2(float lo, float hi) { return f2bf(lo) | (f2bf(hi) << 16); }

#define XB_TMO      128
#define XB_XCNT(j)  (256  + 64 * (j))
#define XB_XSUB(j)  (1280 + 64 * (j))
#define XB_XGEN(j)  (2304 + 64 * (j))
#define XB_TOP      3328
#define XB_TOPGEN   3392
#define XCD_BAR_WORDS 3456
#define XB_SPIN_CAP (1u << 18)

__device__ __forceinline__ unsigned xb_ld(unsigned* p)              { return __hip_atomic_load(p, __ATOMIC_RELAXED, __HIP_MEMORY_SCOPE_AGENT); }
__device__ __forceinline__ unsigned xb_add(unsigned* p, unsigned v) { return __hip_atomic_fetch_add(p, v, __ATOMIC_RELAXED, __HIP_MEMORY_SCOPE_AGENT); }
__device__ __forceinline__ unsigned xb_xcc_id() { return (unsigned)__builtin_amdgcn_s_getreg((3 << 11) | 20) & 0xFu; }
#define XB_SPIN(cond, bar) do { unsigned _sp = 0; while (cond) { __builtin_amdgcn_s_sleep(1); \
    if ((++_sp & 255u) == 0u) { if (xb_ld(&(bar)[XB_TMO])) break; if (_sp > XB_SPIN_CAP) { atomicAdd(&(bar)[XB_TMO], 1u); break; } } } } while (0)

struct XcdBarrier {
    unsigned* bar; unsigned x;
    volatile LAS unsigned* st;
};

__device__ __forceinline__ XcdBarrier xcd_barrier_post(unsigned* bar, volatile LAS unsigned* st) {
    XcdBarrier b; b.bar = bar; b.x = xb_xcc_id(); b.st = st;
    if (threadIdx.x == 0) (void)xb_add(&bar[XB_XCNT(b.x)], 1u);
    return b;
}
__device__ __forceinline__ void xcd_barrier_complete(unsigned* bar, unsigned x, unsigned& nloc, unsigned& nx) {
    const unsigned G = gridDim.x * gridDim.y * gridDim.z;
    unsigned sum, cnt, mine, sp = 0u;
    for (;;) {
        sum = 0u; cnt = 0u; mine = 0u;
#pragma unroll
        for (unsigned j = 0; j < 16; ++j) { const unsigned c = xb_ld(&bar[XB_XCNT(j)]); sum += c; cnt += (c > 0u) ? 1u : 0u; mine = (j == x) ? c : mine; }
        if (sum == G) break;
        __builtin_amdgcn_s_sleep(1);
        if ((++sp & 255u) == 0u) { if (xb_ld(&bar[XB_TMO])) break; if (sp > XB_SPIN_CAP) { atomicAdd(&bar[XB_TMO], 1u); break; } }
    }
    nloc = mine > 0u ? mine : 1u; nx = cnt > 0u ? cnt : 1u;
}

__device__ __forceinline__ void xcd_barrier(const XcdBarrier& b) {
    asm volatile("s_waitcnt vmcnt(0)" ::: "memory");
    __syncthreads();
    if (threadIdx.x == 0) {
        unsigned* bar = b.bar;
        __builtin_amdgcn_s_waitcnt(0);
        unsigned nloc = b.st[0], nx = b.st[1];
        if (nloc == 0u) { xcd_barrier_complete(bar, b.x, nloc, nx); b.st[0] = nloc; b.st[1] = nx; }
        const unsigned old = xb_add(&bar[XB_XSUB(b.x)], 1u);
        const unsigned gen = old / nloc;
        if (old + 1u == (gen + 1u) * nloc) {
            __builtin_amdgcn_fence(__ATOMIC_RELEASE, "agent");
            asm volatile("s_waitcnt vmcnt(0)" ::: "memory");
            const unsigned og = xb_add(&bar[XB_TOP], 1u);
            const unsigned tg = og / nx;
            if (og + 1u == (tg + 1u) * nx) xb_add(&bar[XB_TOPGEN], 1u);
            else XB_SPIN(xb_ld(&bar[XB_TOPGEN]) == tg, bar);
            __builtin_amdgcn_fence(__ATOMIC_ACQUIRE, "agent");
            xb_add(&bar[XB_XGEN(b.x)], 1u);
            asm volatile("s_waitcnt vmcnt(0)" ::: "memory");
        } else {
            XB_SPIN(xb_ld(&bar[XB_XGEN(b.x)]) == gen, bar);
            __builtin_amdgcn_fence(__ATOMIC_ACQUIRE, "agent");
            asm volatile("s_waitcnt vmcnt(0)" ::: "memory");
        }
    }
    __syncthreads();
}
struct Frame {
    LAS unsigned char* lds;
    volatile LAS unsigned* MISC;
    gu32* ctl;
    int wave;
    int vcu, G;
};
__device__ __forceinline__ float wave_sum(float v) {
#pragma unroll
    for (int o = 1; o < 64; o <<= 1) v += __shfl_xor(v, o);
    return v;
}
__device__ __forceinline__ void p0_transpose_item(const float* W, int K, int N, bf16* WT, int row_off, LAS float* scr, int item, int lane, const float* kgain = nullptr) {
    const int nblk = N / 32, kb = item / nblk, nb = item % nblk, k0 = 64 * kb, n0 = 32 * nb;
    float wv[32];
#pragma unroll
    for (int i = 0; i < 32; ++i) { const int kk = 2 * i + (lane >> 5); wv[i] = W[(size_t)(k0 + kk) * N + n0 + (lane & 31)]; }
#pragma unroll
    for (int i = 0; i < 32; ++i) { const int kk = 2 * i + (lane >> 5); float w = wv[i]; if (kgain) w *= kgain[k0 + kk]; scr[kk * 33 + (lane & 31)] = w; }
    LDS_WAIT(); asm volatile("" ::: "memory");
    const int c = lane & 7;
#pragma unroll
    for (int j = 0; j < 4; ++j) { const int n = (lane >> 3) + 8 * j; const LAS float* s = scr + (8 * c) * 33 + n;
        v4u o; o.x = pk2(s[0 * 33], s[1 * 33]); o.y = pk2(s[2 * 33], s[3 * 33]); o.z = pk2(s[4 * 33], s[5 * 33]); o.w = pk2(s[6 * 33], s[7 * 33]);
        *(GAS v4u*)(WT + (size_t)(row_off + n0 + n) * K + k0 + 8 * c) = o; }
    LDS_WAIT(); asm volatile("" ::: "memory");
}
__device__ __forceinline__ void p0_transpose_item_f8(const float* W, int N, int ncol0, unsigned char* W8T, int K, LAS float* scr, int kb, int nb, int lane, float mul) {
    const int k0 = 64 * kb, n0 = ncol0 + 32 * nb;
    float wv[32];
#pragma unroll
    for (int i = 0; i < 32; ++i) { const int kk = 2 * i + (lane >> 5); wv[i] = W[(size_t)(k0 + kk) * N + n0 + (lane & 31)]; }
#pragma unroll
    for (int i = 0; i < 32; ++i) { const int kk = 2 * i + (lane >> 5); scr[kk * 33 + (lane & 31)] = wv[i] * mul; }
    LDS_WAIT(); asm volatile("" ::: "memory");
    const int c = lane & 7;
#pragma unroll
    for (int j = 0; j < 4; ++j) { const int n = (lane >> 3) + 8 * j; const LAS float* sp = scr + (8 * c) * 33 + n;
        int lo = __builtin_amdgcn_cvt_pk_fp8_f32(sp[0 * 33], sp[1 * 33], 0, false); lo = __builtin_amdgcn_cvt_pk_fp8_f32(sp[2 * 33], sp[3 * 33], lo, true);
        int hi = __builtin_amdgcn_cvt_pk_fp8_f32(sp[4 * 33], sp[5 * 33], 0, false); hi = __builtin_amdgcn_cvt_pk_fp8_f32(sp[6 * 33], sp[7 * 33], hi, true);
        *(GAS unsigned long long*)(W8T + (size_t)(32 * nb + n) * K + k0 + 8 * c) = (unsigned long long)(unsigned)lo | ((unsigned long long)(unsigned)hi << 32); }
    LDS_WAIT(); asm volatile("" ::: "memory");
}
__device__ __forceinline__ void p0_colmax_item(const float* W, int N, int kb, int nb, unsigned* wmax, int lane) {
    const int k0 = 64 * kb, n0 = 32 * nb; float mx = 0.f;
    float wv[32];
#pragma unroll
    for (int i = 0; i < 32; ++i) wv[i] = W[(size_t)(k0 + 2 * i + (lane >> 5)) * N + n0 + (lane & 31)];
#pragma unroll
    for (int i = 0; i < 32; ++i) mx = __builtin_fmaxf(mx, __builtin_fabsf(wv[i]));
    mx = __builtin_fmaxf(mx, __shfl_xor(mx, 32));
    if (lane < 32) __hip_atomic_fetch_max(wmax + lane, __float_as_uint(mx), __ATOMIC_RELAXED, __HIP_MEMORY_SCOPE_AGENT);
}
__device__ __forceinline__ void p0_quant_item(const float* W, int N, int kb, int nb, unsigned char* W8T, unsigned* wmax, float* wsc, LAS float* scr, int lane) {
    const int k0 = 64 * kb, n0 = 32 * nb;
    float wv[32];
#pragma unroll
    for (int i = 0; i < 32; ++i) wv[i] = W[(size_t)(k0 + 2 * i + (lane >> 5)) * N + n0 + (lane & 31)];
#pragma unroll
    for (int i = 0; i < 32; ++i) scr[(2 * i + (lane >> 5)) * 33 + (lane & 31)] = wv[i];
    LDS_WAIT(); asm volatile("" ::: "memory");
    const int c = lane & 7;
#pragma unroll
    for (int j = 0; j < 4; ++j) { const int n = (lane >> 3) + 8 * j; const LAS float* sp = scr + (8 * c) * 33 + n;
        const float cm = __uint_as_float(__hip_atomic_load(wmax + n, __ATOMIC_RELAXED, __HIP_MEMORY_SCOPE_AGENT)); const float inv = cm > 0.f ? 127.0f / cm : 0.f;
        unsigned lo = 0u, hi = 0u;
#pragma unroll
        for (int e = 0; e < 4; ++e) { lo |= ((unsigned)(int)__builtin_rintf(sp[e * 33] * inv) & 0xffu) << (8 * e); hi |= ((unsigned)(int)__builtin_rintf(sp[(4 + e) * 33] * inv) & 0xffu) << (8 * e); }
        *(GAS unsigned long long*)(W8T + (size_t)n * 1024 + k0 + 8 * c) = (unsigned long long)lo | ((unsigned long long)hi << 32); }
    if (kb == 0 && lane < 32) wsc[lane] = __uint_as_float(__hip_atomic_load(wmax + lane, __ATOMIC_RELAXED, __HIP_MEMORY_SCOPE_AGENT)) * (1.0f / 127.0f);
    LDS_WAIT(); asm volatile("" ::: "memory");
}
__device__ __forceinline__ void rms_row2_to_i8(int lane, const float* xrow, const float* g, unsigned* o8row, float* xsc) {
    const GAS f32x4* xr = (const GAS f32x4*)xrow + lane; const GAS f32x4* gr = (const GAS f32x4*)g + lane;
    f32x4 v[8]; float s0 = 0.f, s1 = 0.f;
#pragma unroll
    for (int j = 0; j < 8; ++j) v[j] = xr[64 * j];
#pragma unroll
    for (int j = 0; j < 4; ++j) { s0 += (v[j].x * v[j].x + v[j].y * v[j].y) + (v[j].z * v[j].z + v[j].w * v[j].w); s1 += (v[4 + j].x * v[4 + j].x + v[4 + j].y * v[4 + j].y) + (v[4 + j].z * v[4 + j].z + v[4 + j].w * v[4 + j].w); }
#pragma unroll
    for (int o = 1; o < 64; o <<= 1) { s0 += __shfl_xor(s0, o); s1 += __shfl_xor(s1, o); }
    const float r0 = 1.f / sqrtf(s0 * (1.f / D) + 1e-6f), r1 = 1.f / sqrtf(s1 * (1.f / D) + 1e-6f);
    float a0 = 0.f, a1 = 0.f;
#pragma unroll
    for (int j = 0; j < 4; ++j) { const f32x4 gg = gr[64 * j]; v[j] = v[j] * gg * r0; v[4 + j] = v[4 + j] * gg * r1;
        a0 = __builtin_fmaxf(a0, __builtin_fmaxf(__builtin_fmaxf(__builtin_fabsf(v[j].x), __builtin_fabsf(v[j].y)), __builtin_fmaxf(__builtin_fabsf(v[j].z), __builtin_fabsf(v[j].w))));
        a1 = __builtin_fmaxf(a1, __builtin_fmaxf(__builtin_fmaxf(__builtin_fabsf(v[4 + j].x), __builtin_fabsf(v[4 + j].y)), __builtin_fmaxf(__builtin_fabsf(v[4 + j].z), __builtin_fabsf(v[4 + j].w)))); }
#pragma unroll
    for (int o = 1; o < 64; o <<= 1) { a0 = __builtin_fmaxf(a0, __shfl_xor(a0, o)); a1 = __builtin_fmaxf(a1, __shfl_xor(a1, o)); }
    const float i0 = a0 > 0.f ? 127.0f / a0 : 0.f, i1 = a1 > 0.f ? 127.0f / a1 : 0.f;
#pragma unroll
    for (int j = 0; j < 4; ++j) {
        const unsigned p0 = ((unsigned)(int)__builtin_rintf(v[j].x * i0) & 0xffu) | (((unsigned)(int)__builtin_rintf(v[j].y * i0) & 0xffu) << 8) | (((unsigned)(int)__builtin_rintf(v[j].z * i0) & 0xffu) << 16) | (((unsigned)(int)__builtin_rintf(v[j].w * i0) & 0xffu) << 24);
        const unsigned p1 = ((unsigned)(int)__builtin_rintf(v[4 + j].x * i1) & 0xffu) | (((unsigned)(int)__builtin_rintf(v[4 + j].y * i1) & 0xffu) << 8) | (((unsigned)(int)__builtin_rintf(v[4 + j].z * i1) & 0xffu) << 16) | (((unsigned)(int)__builtin_rintf(v[4 + j].w * i1) & 0xffu) << 24);
        ((GAS unsigned*)o8row)[lane + 64 * j] = p0; ((GAS unsigned*)o8row)[256 + lane + 64 * j] = p1; }
    if (lane == 0) { xsc[0] = a0 * (1.0f / 127.0f); xsc[1] = a1 * (1.0f / 127.0f); }
}
__device__ __forceinline__ void rms_row_to_bf16(int lane, const float* xrow, const float* g, bf16* orow) {
    const GAS f32x4* xr = (const GAS f32x4*)xrow + lane; const GAS f32x4* gr = (const GAS f32x4*)g + lane;
    f32x4 v[4]; float s = 0.f;
#pragma unroll
    for (int j = 0; j < 4; ++j) { v[j] = xr[64 * j]; s += (v[j].x * v[j].x + v[j].y * v[j].y) + (v[j].z * v[j].z + v[j].w * v[j].w); }
    const float rstd = 1.f / sqrtf(wave_sum(s) * (1.f / D) + 1e-6f);
    GAS unsigned long long* o8 = (GAS unsigned long long*)orow + lane;
#pragma unroll
    for (int j = 0; j < 4; ++j) { const f32x4 gg = gr[64 * j]; o8[64 * j] = (unsigned long long)pk2(v[j].x * rstd * gg.x, v[j].y * rstd * gg.y) | ((unsigned long long)pk2(v[j].z * rstd * gg.z, v[j].w * rstd * gg.w) << 32); }
}
__device__ __forceinline__ void rms_row2_to_bf16(int lane, const float* xrow, const float* g, bf16* orow, unsigned* o8row) {
    const GAS f32x4* xr = (const GAS f32x4*)xrow + lane; const GAS f32x4* gr = (const GAS f32x4*)g + lane;
    f32x4 v[8]; float s0 = 0.f, s1 = 0.f;
#pragma unroll
    for (int j = 0; j < 8; ++j) v[j] = xr[64 * j];
#pragma unroll
    for (int j = 0; j < 4; ++j) { s0 += (v[j].x * v[j].x + v[j].y * v[j].y) + (v[j].z * v[j].z + v[j].w * v[j].w); s1 += (v[4 + j].x * v[4 + j].x + v[4 + j].y * v[4 + j].y) + (v[4 + j].z * v[4 + j].z + v[4 + j].w * v[4 + j].w); }
#pragma unroll
    for (int o = 1; o < 64; o <<= 1) { s0 += __shfl_xor(s0, o); s1 += __shfl_xor(s1, o); }
    const float r0 = 1.f / sqrtf(s0 * (1.f / D) + 1e-6f), r1 = 1.f / sqrtf(s1 * (1.f / D) + 1e-6f);
    GAS unsigned long long* o8 = (GAS unsigned long long*)orow + lane;
#pragma unroll
    for (int j = 0; j < 4; ++j) { const f32x4 gg = gr[64 * j];
        o8[64 * j] = (unsigned long long)pk2(v[j].x * r0 * gg.x, v[j].y * r0 * gg.y) | ((unsigned long long)pk2(v[j].z * r0 * gg.z, v[j].w * r0 * gg.w) << 32);
        o8[64 * (4 + j)] = (unsigned long long)pk2(v[4 + j].x * r1 * gg.x, v[4 + j].y * r1 * gg.y) | ((unsigned long long)pk2(v[4 + j].z * r1 * gg.z, v[4 + j].w * r1 * gg.w) << 32);
        int p0 = __builtin_amdgcn_cvt_pk_fp8_f32(v[j].x * r0 * gg.x, v[j].y * r0 * gg.y, 0, false); p0 = __builtin_amdgcn_cvt_pk_fp8_f32(v[j].z * r0 * gg.z, v[j].w * r0 * gg.w, p0, true);
        int p1 = __builtin_amdgcn_cvt_pk_fp8_f32(v[4 + j].x * r1 * gg.x, v[4 + j].y * r1 * gg.y, 0, false); p1 = __builtin_amdgcn_cvt_pk_fp8_f32(v[4 + j].z * r1 * gg.z, v[4 + j].w * r1 * gg.w, p1, true);
        ((GAS unsigned*)o8row)[lane + 64 * j] = (unsigned)p0; ((GAS unsigned*)o8row)[256 + lane + 64 * j] = (unsigned)p1; }
}
__device__ __forceinline__ void unpack8f(const v4u w, float (&v)[8]) {
    v[0] = __uint_as_float(w.x << 16); v[1] = __uint_as_float(w.x & 0xffff0000u); v[2] = __uint_as_float(w.y << 16); v[3] = __uint_as_float(w.y & 0xffff0000u);
    v[4] = __uint_as_float(w.z << 16); v[5] = __uint_as_float(w.z & 0xffff0000u); v[6] = __uint_as_float(w.w << 16); v[7] = __uint_as_float(w.w & 0xffff0000u); }
__device__ __forceinline__ v4u pack8f(const float (&v)[8]) { v4u o; o.x = pk2(v[0], v[1]); o.y = pk2(v[2], v[3]); o.z = pk2(v[4], v[5]); o.w = pk2(v[6], v[7]); return o; }

struct Args { const float* in[24]; float* out; unsigned char* ws; int ph_lo, ph_hi; };
constexpr int N_PHASES = 9;

typedef const __attribute__((address_space(4))) Args KArgs;
__device__ __forceinline__ KArgs* ka_ptr() { KArgs* p = (KArgs*)__builtin_amdgcn_kernarg_segment_ptr(); asm volatile("" : "+s"(p)); return p; }
#define PHASE_PTRS const KArgs* KA = ka_ptr(); unsigned char* ws = KA->ws; const float* x = KA->in[0]; const float* mem = KA->in[1]; const float* norm_mix_g = KA->in[2]; const float* norm_mem_g = KA->in[3]; const float* w_in = KA->in[4]; const float* b_gate = KA->in[5]; const float* q_norm_g = KA->in[6]; const float* k_norm_g = KA->in[7]; const float* lam_q1 = KA->in[8]; const float* lam_k1 = KA->in[9]; const float* lam_q2 = KA->in[10]; const float* lam_k2 = KA->in[11]; const float* subln_g = KA->in[12]; const float* w_attn_o = KA->in[13]; const float* conv_w = KA->in[14]; const float* w_conv_o = KA->in[15]; const float* w_mem_kv = KA->in[16]; const float* mq_norm_g = KA->in[17]; const float* mk_norm_g = KA->in[18]; const float* w_mem_o = KA->in[19]; const float* w_o = KA->in[20]; const float* norm_mlp_g = KA->in[21]; const float* w_mlp_in = KA->in[22]; const float* w_mlp_out = KA->in[23]; float* out = KA->out; bf16* WinT = (bf16*)(ws + WS_WIN); bf16* WaT = (bf16*)(ws + WS_WA); bf16* WcT = (bf16*)(ws + WS_WC); bf16* WmT = (bf16*)(ws + WS_WM); bf16* WoT = (bf16*)(ws + WS_WO); bf16* WkvT = (bf16*)(ws + WS_WKV); bf16* W1T = (bf16*)(ws + WS_W1); bf16* W2T = (bf16*)(ws + WS_W2); float* STATS = (float*)(ws + WS_STATS); bf16* MEMN = (bf16*)(ws + WS_MEMN); bf16* KP = (bf16*)(ws + WS_KP); bf16* VT = (bf16*)(ws + WS_VT); bf16* R1 = (bf16*)(ws + WS_R1); bf16* R2 = (bf16*)(ws + WS_R2); bf16* R3 = (bf16*)(ws + WS_R3); bf16* R4 = (bf16*)(ws + WS_R4); bf16* R5 = (bf16*)(ws + WS_R5); bf16* R6 = (bf16*)(ws + WS_R6); bf16* R7 = (bf16*)(ws + WS_R7); bf16* D0 = (bf16*)out; bf16* D1 = (bf16*)out + (size_t)M * D;
__global__ void __launch_bounds__(NWAVES * 64, 2) hybrid_fwd(Args args) {
    extern __shared__ __attribute__((aligned(16))) unsigned char lds[];
    Frame F;
    F.lds = (LAS unsigned char*)lds;
    F.MISC = (volatile LAS unsigned*)(F.lds + MISC_OFF);
    F.wave = __builtin_amdgcn_readfirstlane((int)threadIdx.x >> 6);
    F.G = gridDim.x; { const int bx = blockIdx.x; F.vcu = (F.G % 8 == 0) ? (bx % 8) * (F.G / 8) + bx / 8 : bx; }
    F.ctl = (gu32*)(args.ws + WS_CTL);
    for (int u = ((int)threadIdx.x); u < (LDS_BYTES - LDSCTL_OFF) / 4; u += NWAVES * 64) ((LAS unsigned*)(F.lds + LDSCTL_OFF))[u] = 0u;
    __syncthreads();
    const int lo = args.ph_lo, hi = args.ph_hi;
    const bool multi = (hi - lo) > 1;
    XcdBarrier bar; bar.bar = (unsigned*)(F.ctl + CW_BAR); bar.x = 0; bar.st = nullptr;
    if (multi) bar = xcd_barrier_post((unsigned*)(F.ctl + CW_BAR), F.MISC + 8);
#ifndef REP_MASK
#define REP_MASK 0
#endif
#ifndef PH_MASK
#define PH_MASK 0x1ff
#endif
#define IN(k) (((PH_MASK >> (k)) & 1) && lo <= (k) && (k) < hi)
#define BOTH(k) (IN(k) && IN((k) + 1))
#define GRID_BAR() xcd_barrier(bar)
    PG8_LAS float* X0 = (PG8_LAS float*)(F.lds + XCH_OFF); PG8_LAS float* X1 = (PG8_LAS float*)(F.lds + XCH_OFF + 4096);
    const int gw = F.vcu * NWAVES + F.wave, NGW = F.G * NWAVES;
    LAS unsigned char* ring = F.lds + RING_OFF;
    const int cid = (int)blockIdx.x;
    typedef pg8::StaticOrder SO;

    if (IN(0)) for (int rep_ = 0; rep_ <= ((REP_MASK >> 0) & 1); ++rep_) { PHASE_PTRS if (rep_) { VM_WAIT(); __syncthreads(); }
        LAS float* scr = (LAS float*)(F.lds + RING_OFF + F.wave * 16384);
        constexpr int I_IN = (D / 64) * (PROJW / 32), I_KV = (D / 64) * (2 * D / 32);
        unsigned* WMAX = (unsigned*)F.ctl + CW_WMAX; unsigned char* W8 = ws + WS_W8; float* WSC = (float*)(ws + WS_WSC); float* XSC = (float*)(ws + WS_XSC);
        const int ln_ = (int)threadIdx.x & 63;
        for (int it = gw; it < I_IN + I_KV; it += NGW) {
            int r = it;
            if (r < I_KV) { p0_transpose_item(w_mem_kv, D, 2 * D, WkvT, 0, scr, r, ln_); continue; } r -= I_KV;
            { const int nb = r % (PROJW / 32), kb = r / (PROJW / 32);
                const int db = nb < 96 ? nb : nb < 128 ? 128 + 2 * (nb - 96) : nb < 160 ? 96 + (nb - 128) : nb < 192 ? 129 + 2 * (nb - 160) : nb;
                p0_colmax_item(w_in, PROJW, kb, nb, WMAX + 32 * db, ln_); }
        }
        for (int m = gw; m < MM; m += NGW) rms_row_to_bf16(ln_, mem + (size_t)m * D, norm_mem_g, MEMN + (size_t)m * D);
        for (int m = 2 * gw; m < M; m += 2 * NGW) rms_row2_to_i8(ln_, x + (size_t)m * D, norm_mix_g, (unsigned*)(ws + WS_XN8) + (size_t)m * (D / 4), XSC + m);
        if (multi) GRID_BAR();
        for (int it = gw; it < I_IN; it += NGW) {
            const int nb = it % (PROJW / 32), kb = it / (PROJW / 32);
            const int db = nb < 96 ? nb : nb < 128 ? 128 + 2 * (nb - 96) : nb < 160 ? 96 + (nb - 128) : nb < 192 ? 129 + 2 * (nb - 160) : nb;
            p0_quant_item(w_in, PROJW, kb, nb, W8 + (size_t)(32 * db) * 1024, WMAX + 32 * db, WSC + 32 * db, scr, ln_);
        }
        if (BOTH(0)) GRID_BAR();
    }
    if (IN(1)) for (int rep_ = 0; rep_ <= ((REP_MASK >> 1) & 1); ++rep_) { PHASE_PTRS if (rep_) { VM_WAIT(); __syncthreads(); }
#ifndef P1_SUB
#define P1_SUB 31
#endif
        if (P1_SUB & 1) { pg8::Gemm g{MEMN, WkvT, D, D, D, (long)256 * D, 0, (long)256 * D, 0}; SO S; S.init(MM, D, F.G, cid);
          pg8::EpiMemK E{KP, mq_norm_g, mk_norm_g, X0};
          pg8::gemm_phase<pg8::EpiMemK, SO, true, true>(ring, g, S, E); }
        if (P1_SUB & 2) { pg8::Gemm g{WkvT + (size_t)D * D, MEMN, D, D, D, (long)256 * D, 0, (long)256 * D, 0}; SO S; S.init(D, MM, F.G, (cid + 64) % F.G);
          pg8::EpiPlain E{VT, MM};
          pg8::gemm_phase<pg8::EpiPlain, SO, true, true>(ring, g, S, E); }
        const bf16* XN8 = (const bf16*)(ws + WS_XN8); const bf16* W8 = (const bf16*)(ws + WS_W8); const float* XSC = (const float*)(ws + WS_XSC); const float* WSC = (const float*)(ws + WS_WSC);
        if (P1_SUB & 4) { pg8::Gemm g{XN8, W8, D / 2, D / 2, D / 2, (long)256 * (D / 2), 0, (long)256 * (D / 2), 0}; SO S; S.init(M, 2 * D, F.G, cid);
          pg8::EpiQK E{R2, (size_t)M * D, q_norm_g, k_norm_g, XSC, WSC};
          pg8::gemm_phase<pg8::EpiQK, SO, true, true, false, false, true>(ring, g, S, E); }
        if (P1_SUB & 8) { pg8::Gemm g{XN8, W8 + (size_t)2 * D * (D / 2), D / 2, D / 2, D / 2, (long)256 * (D / 2), 0, (long)256 * (D / 2), 0}; SO S; S.init(M, 4 * D, F.G, cid);
          pg8::EpiP1b E{R4, R6, R5, XSC, WSC + 2 * D};
          pg8::gemm_phase<pg8::EpiP1b, SO, true, true, false, false, true>(ring, g, S, E); }
        if (P1_SUB & 16) { pg8::Gemm g{XN8, W8 + (size_t)6 * D * (D / 2), D / 2, D / 2, D / 2, (long)256 * (D / 2), 0, (long)256 * (D / 2), 0}; SO S; S.init(M, D, F.G, cid);
          pg8::EpiQm E{D0, X0, XSC, WSC + 6 * D};
          pg8::gemm_phase<pg8::EpiQm, SO, true, true, false, false, true>(ring, g, S, E); }
        {
            const int nk = (F.G >= 224) ? ((cid < 32 || (cid >= 192 && cid < 224)) ? -1 : (cid < 192 ? cid - 32 : cid - 64)) : cid;
            const int NH = (F.G >= 224) ? F.G - 64 : F.G;
            if (nk >= 0) {
                LAS float* scr = (LAS float*)(F.lds + RING_OFF + F.wave * 16384);
                constexpr int I_SQ = (D / 64) * (D / 32), I_1 = (D / 64) * (FF / 32), I_2 = (FF / 64) * (D / 32);
                constexpr int NIT2 = 4 * I_SQ + I_1 + I_2;
                for (int it = nk * NWAVES + F.wave; it < NIT2; it += NH * NWAVES) {
                    int r = it;
                    if (r < I_SQ) { p0_transpose_item(w_attn_o, D, D, WaT, 0, scr, r, ((int)threadIdx.x & 63)); continue; } r -= I_SQ;
                    if (r < I_SQ) { p0_transpose_item(w_conv_o, D, D, WcT, 0, scr, r, ((int)threadIdx.x & 63)); continue; } r -= I_SQ;
                    if (r < I_SQ) { p0_transpose_item(w_mem_o, D, D, WmT, 0, scr, r, ((int)threadIdx.x & 63)); continue; } r -= I_SQ;
                    if (r < I_SQ) { p0_transpose_item(w_o, D, D, WoT, 0, scr, r, ((int)threadIdx.x & 63)); continue; } r -= I_SQ;
                    if (r < I_1) { p0_transpose_item(w_mlp_in, D, FF, W1T, 0, scr, r, ((int)threadIdx.x & 63), norm_mlp_g); continue; } r -= I_1;
                    p0_transpose_item(w_mlp_out, FF, D, W2T, 0, scr, r, ((int)threadIdx.x & 63));
                }
            }
        }
        if (BOTH(1)) GRID_BAR();
    }
    if (IN(2)) for (int rep_ = 0; rep_ <= ((REP_MASK >> 2) & 1); ++rep_) { PHASE_PTRS if (rep_) { VM_WAIT(); __syncthreads(); }
#ifndef P2_SUB
#define P2_SUB 7
#endif
        if (P2_SUB & 1) {
            const int cg8 = (((int)threadIdx.x) & 127) * 8, sub = ((int)threadIdx.x) >> 7;
            float w0[8], w1[8], w2[8];
#pragma unroll
            for (int e = 0; e < 8; ++e) { w0[e] = conv_w[cg8 + e]; w1[e] = conv_w[D + cg8 + e]; w2[e] = conv_w[2 * D + cg8 + e]; }
            for (int it = F.vcu; it < M / 64; it += F.G) {
                const int r0 = it * 64 + sub * 16;
                float p2[8], p1[8];
                if ((r0 & (T - 1)) == 0) {
#pragma unroll
                    for (int e = 0; e < 8; ++e) { p2[e] = 0.f; p1[e] = 0.f; }
                } else {
                    unpack8f(*(const GAS v4u*)(R5 + (size_t)(r0 - 2) * D + cg8), p2); unpack8f(*(const GAS v4u*)(R5 + (size_t)(r0 - 1) * D + cg8), p1);
                }
#pragma unroll 4
                for (int r = 0; r < 16; ++r) {
                    const size_t off = (size_t)(r0 + r) * D + cg8;
                    float a[8], gb[8], y[8];
                    unpack8f(*(const GAS v4u*)(R5 + off), a); unpack8f(*(const GAS v4u*)(R6 + off), gb);
#pragma unroll
                    for (int e = 0; e < 8; ++e) { const float cur = a[e]; y[e] = gb[e] * (w0[e] * p2[e] + w1[e] * p1[e] + w2[e] * cur); p2[e] = p1[e]; p1[e] = cur; }
                    *(GAS v4u*)(D1 + off) = pack8f(y);
                }
            }
        }
        __syncthreads();
        if (P2_SUB & 2) { pg8::Gemm g{D0, KP, D, D, 256, (long)256 * D, 256, 256, (long)256 * D}; SO S; S.init(M, D, F.G, cid);
          pg8::EpiSoftmax E{D0, X0};
          pg8::gemm_phase<pg8::EpiSoftmax, SO, true, true>(ring, g, S, E); }
        VM_WAIT(); __syncthreads();
        if (P2_SUB & 4) { pg8::Gemm g{D0, VT, D, MM, 256, (long)256 * D, 256, (long)256 * MM, 256}; SO S; S.init(M, D, F.G, cid);
          pg8::EpiPlain E{D0, D};
          pg8::gemm_phase<pg8::EpiPlain, SO, true, true>(ring, g, S, E); }
    }
    if (IN(3)) for (int rep_ = 0; rep_ <= ((REP_MASK >> 3) & 1); ++rep_) { PHASE_PTRS if (rep_) { VM_WAIT(); __syncthreads(); }
        const int ln_ = (int)threadIdx.x & 63;
        const float d1 = wave_sum(lam_q1[ln_] * lam_k1[ln_]), d2 = wave_sum(lam_q2[ln_] * lam_k2[ln_]);
        const float lam = expf(d1) - expf(d2) + 0.2f;
        const attn_body::AttnTensors AT{(const attn_body::bf16*)R2, (const attn_body::bf16*)R3, (const attn_body::bf16*)R4, (attn_body::bf16*)R1, (attn_body::bf16*)R2, subln_g, lam};
        const attn_body::AttnOrder AS{F.vcu, F.G};
        attn_body::attn_phase<8>((char*)lds + RING_OFF, AT, AS);
        if (BOTH(3)) GRID_BAR();
    }
    if (IN(5)) for (int rep_ = 0; rep_ <= ((REP_MASK >> 5) & 1); ++rep_) { PHASE_PTRS if (rep_) { VM_WAIT(); __syncthreads(); }
        { pg8::Gemm g{(const bf16*)(ws + WS_XN8), (const bf16*)(ws + WS_W8) + (size_t)NPROJ1 * (D / 2), D / 2, D / 2, D / 2, (long)256 * (D / 2), 0, (long)256 * (D / 2), 0}; pg8::GateOrder S; S.base.init(M, D, F.G, cid);
          pg8::EpiGate E{R3, (size_t)M * D, b_gate, (const float*)(ws + WS_XSC), (const float*)(ws + WS_WSC) + NPROJ1};
          pg8::gemm_phase<pg8::EpiGate, pg8::GateOrder, true, true, false, false, true>(ring, g, S, E); }
        VM_WAIT(); __syncthreads();
        { pg8::Gemm g{R2, WaT, D, D, D, (long)256 * D, 0, (long)256 * D, 0, D1, D0, (long)(WS_WC - WS_WA) / 2}; pg8::SegOrder S; S.base.init(M, D, F.G, cid);
          pg8::EpiBranch3 E{R3, R4, R5, R6};
          pg8::gemm_phase<pg8::EpiBranch3, pg8::SegOrder, true, true, true>(ring, g, S, E); }
        if (BOTH(5)) GRID_BAR();
    }
    if (IN(6)) for (int rep_ = 0; rep_ <= ((REP_MASK >> 6) & 1); ++rep_) { PHASE_PTRS if (rep_) { VM_WAIT(); __syncthreads(); }
        { pg8::Gemm g{R6, WoT, D, D, D, (long)256 * D, 0, (long)256 * D, 0}; SO S; S.init(M, D, F.G, cid);
          pg8::EpiX1 E{x, out, R2, STATS};
          pg8::gemm_phase<pg8::EpiX1, SO, true, true>(ring, g, S, E); }
        if (BOTH(6)) GRID_BAR();
    }
    if (IN(7)) for (int rep_ = 0; rep_ <= ((REP_MASK >> 7) & 1); ++rep_) { PHASE_PTRS if (rep_) { VM_WAIT(); __syncthreads(); }
        { pg8::Gemm g{R2, W1T, D, D, D, (long)256 * D, 0, (long)256 * D, 0}; SO S; S.init(M, FF, F.G, cid);
          pg8::EpiRelu2P E{R3, FF};
          pg8::gemm_phase<pg8::EpiRelu2P, SO, true, true>(ring, g, S, E); }
        if (BOTH(7)) GRID_BAR();
    }
    if (IN(8)) for (int rep_ = 0; rep_ <= ((REP_MASK >> 8) & 1); ++rep_) { PHASE_PTRS if (rep_) { VM_WAIT(); __syncthreads(); }
        { pg8::Gemm g{R3, W2T, FF, FF, FF, (long)256 * FF, 0, (long)256 * FF, 0}; SO S; S.init(M, D, F.G, cid);
          pg8::EpiOutN E{R2, out, STATS};
          pg8::gemm_phase<pg8::EpiOutN, SO, true, true>(ring, g, S, E); }
    }
    if (hi > N_PHASES) { const unsigned long long* ia = (const unsigned long long*)__builtin_amdgcn_implicitarg_ptr(); if (ia[11] == 1ull) __builtin_trap(); }
#undef IN
#undef BOTH
}

#ifndef MK_N_LAUNCHES
#define MK_N_LAUNCHES 1
#endif
extern "C" void kernel_launch(void* const* d_in, const int* in_sizes, int n_in, void* d_out, int out_size, void* d_ws, size_t ws_size, hipStream_t stream) {
    static int grid = 0;
    if (grid == 0) {
        if (n_in != 24 || in_sizes[0] != M * D || out_size != M * D || ws_size < WS_END) { fprintf(stderr, "kernel_launch: unexpected shapes (n_in %d, in0 %d, out %d, ws %zu); nothing launched\n", n_in, n_in > 0 ? in_sizes[0] : -1, out_size, ws_size); grid = -1; return; }
        int dev = 0, cus = 0, per_cu = 0;
        if (hipGetDevice(&dev) != hipSuccess || hipDeviceGetAttribute(&cus, hipDeviceAttributeMultiprocessorCount, dev) != hipSuccess) { grid = -1; return; }
        if (hipFuncSetAttribute((const void*)hybrid_fwd, hipFuncAttributeMaxDynamicSharedMemorySize, LDS_BYTES) != hipSuccess) { fprintf(stderr, "kernel_launch: hipFuncSetAttribute failed\n"); grid = -1; return; }
        if (hipOccupancyMaxActiveBlocksPerMultiprocessor(&per_cu, (const void*)hybrid_fwd, NWAVES * 64, LDS_BYTES) != hipSuccess || per_cu < 1) { fprintf(stderr, "kernel_launch: occupancy query says %d\n", per_cu); per_cu = 1; }
        (void)hipGetLastError();
        grid = cus * 1;
    }
    if (grid < 0) return;
    (void)hipMemsetAsync((char*)d_ws + WS_CTL, 0, CTL_ZERO_BYTES, stream);
    Args a{};
    for (int i = 0; i < 24; ++i) a.in[i] = (const float*)d_in[i];
    a.out = (float*)d_out; a.ws = (unsigned char*)d_ws;
    if (MK_N_LAUNCHES == 1) {
        a.ph_lo = 0; a.ph_hi = N_PHASES;
        void* kargs[] = {&a};
        hipError_t e = hipLaunchCooperativeKernel((const void*)hybrid_fwd, dim3(grid), dim3(NWAVES * 64), kargs, LDS_BYTES, stream);
        if (e != hipSuccess) fprintf(stderr, "kernel_launch: cooperative launch failed: %s (grid %d)\n", hipGetErrorString(e), grid);
    } else {
        for (int p = 0; p < N_PHASES; ++p) { a.ph_lo = p; a.ph_hi = p + 1; hipLaunchKernelGGL(hybrid_fwd, dim3(grid), dim3(NWAVES * 64), LDS_BYTES, stream, a); }
    }
}
```

```cpp
#include <hip/hip_runtime.h>
#include <hip/hip_cooperative_groups.h>
#include <hip/hip_bf16.h>
#include <cstdio>
#include <cstdint>
#include <cmath>
namespace cg = cooperative_groups;
namespace pg8 {
#define PG8_LAS __attribute__((address_space(3)))
typedef unsigned short bf16_t;
typedef short bf16x8 __attribute__((ext_vector_type(8)));
typedef float f32x4 __attribute__((ext_vector_type(4)));
typedef unsigned u32x4 __attribute__((ext_vector_type(4)));
constexpr int BM = 256, BK = 64, HALF = 128, HTB = HALF * BK * 2  , STAGE_BYTES = 8 * HTB, NXCD = 8, WGM = 8;

__host__ __device__ __forceinline__ int lds_byte(int r, int c) { const int st = (r >> 4) * 2 + (c >> 5), rr = r & 15, cc = c & 31, ob = rr * 64 + cc * 2; return st * 1024 + (ob ^ (((ob >> 9) & 1) << 5)); }
__host__ __device__ __forceinline__ void stage_rc(int b, int& R, int& C) { const int st = b / 1024, sb = b % 1024, swz = sb ^ (((sb >> 9) & 1) << 5); R = (st >> 1) * 16 + swz / 64; C = (st & 1) * 32 + (swz % 64) / 2; }
__host__ __device__ __forceinline__ int perm32(int rho) { const int n = rho >> 4, i = rho & 15; return 8 * (i >> 2) + 4 * n + (i & 3); }

struct Unit { int pm, pn, seg; };
struct Gemm { const bf16_t* A; const bf16_t* Bt; int lda, ldb, K; long sAm, sAn, sBn, sBb; const bf16_t* A1 = nullptr; const bf16_t* A2 = nullptr; long sBseg = 0; };

struct StaticOrder {
    int nM, nN, nwg, G, c;
    __host__ __device__ void init(int M, int N, int G_, int c_) { nM = M / BM; nN = N / BM; nwg = nM * nN; G = G_; c = c_; }
    __host__ __device__ bool next(int i, Unit& u) const {
        const long L = (long)i * G + c; if (L >= nwg) return false;
        int wgid = (int)L; { const int q = nwg / NXCD, r = nwg % NXCD, xcd = wgid % NXCD, off = wgid / NXCD; wgid = (xcd < r ? xcd * (q + 1) : r * (q + 1) + (xcd - r) * q) + off; }
        const int nig = WGM * nN, gid = wgid / nig, fm = gid * WGM, gsz = (nM - fm) < WGM ? (nM - fm) : WGM;
        u.pm = fm + ((wgid % nig) % gsz); u.pn = (wgid % nig) / gsz; u.seg = 0; return true;
    }
    __device__ __forceinline__ void a_ready(const Unit&) const {}
    __device__ __forceinline__ void done(const Unit&) const {}
};

struct SegOrder {
    StaticOrder base;
    __host__ __device__ bool next(int i, Unit& u) const { if (!base.next(i / 3, u)) return false; u.seg = i % 3; return true; }
    __device__ __forceinline__ void a_ready(const Unit&) const {}
    __device__ __forceinline__ void done(const Unit&) const {}
};
struct GateOrder {
    StaticOrder base;
    __host__ __device__ bool next(int i, Unit& u) const { if (!base.next(i / 3, u)) return false; u.pn += 4 * (i % 3); return true; }
    __device__ __forceinline__ void a_ready(const Unit&) const {}
    __device__ __forceinline__ void done(const Unit&) const {}
};
__device__ __forceinline__ unsigned cvt_pk_bf16(float lo, float hi) { unsigned r; asm volatile("v_cvt_pk_bf16_f32 %0, %1, %2" : "=v"(r) : "v"(lo), "v"(hi)); return r; }
__device__ __forceinline__ u32x4 pack8(const f32x4& v0, const f32x4& v1) { u32x4 w; w.x = cvt_pk_bf16(v0[0], v0[1]); w.y = cvt_pk_bf16(v0[2], v0[3]); w.z = cvt_pk_bf16(v1[0], v1[1]); w.w = cvt_pk_bf16(v1[2], v1[3]); return w; }
__device__ __forceinline__ void unpack8(const u32x4& w, f32x4& v0, f32x4& v1) {
    v0[0] = __uint_as_float(w.x << 16); v0[1] = __uint_as_float(w.x & 0xffff0000u); v0[2] = __uint_as_float(w.y << 16); v0[3] = __uint_as_float(w.y & 0xffff0000u);
    v1[0] = __uint_as_float(w.z << 16); v1[1] = __uint_as_float(w.z & 0xffff0000u); v1[2] = __uint_as_float(w.w << 16); v1[3] = __uint_as_float(w.w & 0xffff0000u); }
typedef f32x4 Acc[2][2][4][2];
typedef int v8i32 __attribute__((ext_vector_type(8))); typedef int v4i32 __attribute__((ext_vector_type(4)));
__device__ __forceinline__ v8i32 pg8_cat(bf16x8 lo, bf16x8 hi) { return __builtin_shufflevector(__builtin_bit_cast(v4i32, lo), __builtin_bit_cast(v4i32, hi), 0, 1, 2, 3, 4, 5, 6, 7); }
#define PG8_FOR_AM _Pragma("unroll") for (int ai = 0; ai < 2; ++ai) _Pragma("unroll") for (int m = 0; m < 4; ++m)
#define PG8_FOR_BN _Pragma("unroll") for (int bj = 0; bj < 2; ++bj) _Pragma("unroll") for (int n = 0; n < 2; ++n)
__device__ __forceinline__ float dot4(const f32x4& a) { return (a[0] * a[0] + a[1] * a[1]) + (a[2] * a[2] + a[3] * a[3]); }
__device__ __forceinline__ float sum4(const f32x4& a) { return (a[0] + a[1]) + (a[2] + a[3]); }
__device__ __forceinline__ void row_sum_xchg(float (&s)[2][4], PG8_LAS float* X, int wr, int wc, int fr, int fq) {
    PG8_FOR_AM { float v = s[ai][m]; v += __shfl_xor(v, 16); v += __shfl_xor(v, 32); if (fq == 0) X[(ai * HALF + wr * 64 + m * 16 + fr) * 4 + wc] = v; }
    asm volatile("s_waitcnt lgkmcnt(0)" ::: "memory"); __builtin_amdgcn_s_barrier(); asm volatile("" ::: "memory");
    PG8_FOR_AM { const f32x4 t = *(const PG8_LAS f32x4*)(X + (ai * HALF + wr * 64 + m * 16 + fr) * 4); s[ai][m] = (t[0] + t[1]) + (t[2] + t[3]); }
}
__device__ __forceinline__ void store_tile_bf16(const Acc& acc, bf16_t* base  , size_t ldc, int wr, int fr) {
    PG8_FOR_AM { bf16_t* rowp = base + (size_t)(ai * HALF + wr * 64 + m * 16 + fr) * ldc;
#pragma unroll
        for (int bj = 0; bj < 2; ++bj) *(u32x4*)(rowp + bj * 32) = pack8(acc[ai][bj][m][0], acc[ai][bj][m][1]); }
}
__device__ __forceinline__ void dequant_i8(Acc& acc, const float* sa, const float* sb, int wr, int wc, int fr, int fq) {
    float ra[2][4];
    PG8_FOR_AM ra[ai][m] = sa[ai * HALF + wr * 64 + m * 16 + fr];
#pragma unroll
    for (int bj = 0; bj < 2; ++bj) {
        const f32x4 c0 = *(const f32x4*)(sb + wc * 64 + bj * 32 + 8 * fq), c1 = *(const f32x4*)(sb + wc * 64 + bj * 32 + 8 * fq + 4);
        PG8_FOR_AM { const v4i32 q0 = __builtin_bit_cast(v4i32, acc[ai][bj][m][0]), q1 = __builtin_bit_cast(v4i32, acc[ai][bj][m][1]); f32x4 v0, v1;
            v0[0] = (float)q0[0]; v0[1] = (float)q0[1]; v0[2] = (float)q0[2]; v0[3] = (float)q0[3]; v1[0] = (float)q1[0]; v1[1] = (float)q1[1]; v1[2] = (float)q1[2]; v1[3] = (float)q1[3];
            acc[ai][bj][m][0] = v0 * c0 * ra[ai][m]; acc[ai][bj][m][1] = v1 * c1 * ra[ai][m]; }
    }
}
__device__ __forceinline__ void dequant_i8_cols(Acc& acc, const float* sb, int wc, int fq) {
#pragma unroll
    for (int bj = 0; bj < 2; ++bj) {
        const f32x4 c0 = *(const f32x4*)(sb + wc * 64 + bj * 32 + 8 * fq), c1 = *(const f32x4*)(sb + wc * 64 + bj * 32 + 8 * fq + 4);
        PG8_FOR_AM { const v4i32 q0 = __builtin_bit_cast(v4i32, acc[ai][bj][m][0]), q1 = __builtin_bit_cast(v4i32, acc[ai][bj][m][1]); f32x4 v0, v1;
            v0[0] = (float)q0[0]; v0[1] = (float)q0[1]; v0[2] = (float)q0[2]; v0[3] = (float)q0[3]; v1[0] = (float)q1[0]; v1[1] = (float)q1[1]; v1[2] = (float)q1[2]; v1[3] = (float)q1[3];
            acc[ai][bj][m][0] = v0 * c0; acc[ai][bj][m][1] = v1 * c1; }
    }
}
constexpr float LOG2E = 1.4426950408889634f;
constexpr float NORM_EPS = 1e-6f;
struct EpiQK {
    bf16_t* r0; size_t rstride; const float* qg; const float* kg; const float* sa; const float* sb;
    __device__ __forceinline__ void operator()(Acc& acc, const Unit& u, int wr, int wc, int fr, int fq) const {
        dequant_i8_cols(acc, sb + u.pn * BM, wc, fq);
        const int type = u.pn >> 2, colt = (u.pn & 3) * BM, c0 = wc * 64 + 8 * fq;
        const float* gp = type == 0 ? qg : kg; const float sc = type == 0 ? 0.125f * LOG2E : 1.0f;
        f32x4 gv[2][2];
        PG8_FOR_BN gv[bj][n] = *(const f32x4*)(gp + bj * 32 + 8 * fq + 4 * n) * sc;
        bf16_t* base = r0 + (size_t)type * rstride + (size_t)u.pm * BM * 1024 + colt + c0;
        PG8_FOR_AM { float ss = 0.f; PG8_FOR_BN ss += dot4(acc[ai][bj][m][n]);
            ss += __shfl_xor(ss, 16); ss += __shfl_xor(ss, 32);
            const float ra = sa[u.pm * BM + ai * HALF + wr * 64 + m * 16 + fr];
            const float rstd = __builtin_amdgcn_rsqf(ss * (1.0f / 64.0f) + NORM_EPS * __builtin_amdgcn_rcpf(ra * ra + 1e-30f));
            bf16_t* rowp = base + (size_t)(ai * HALF + wr * 64 + m * 16 + fr) * 1024;
#pragma unroll
            for (int bj = 0; bj < 2; ++bj) *(u32x4*)(rowp + bj * 32) = pack8(acc[ai][bj][m][0] * (gv[bj][0] * rstd), acc[ai][bj][m][1] * (gv[bj][1] * rstd)); }
    }
};
struct EpiP1b {
    bf16_t* rv; bf16_t* rgb; bf16_t* rin; const float* sa; const float* sb;
    __device__ __forceinline__ void operator()(Acc& acc, const Unit& u, int wr, int wc, int fr, int fq) const {
        dequant_i8(acc, sa + u.pm * BM, sb + u.pn * BM, wr, wc, fr, fq);
        if (u.pn < 8) {
            store_tile_bf16(acc, (u.pn < 4 ? rv : rgb) + (size_t)u.pm * BM * 1024 + (u.pn & 3) * BM + wc * 64 + 8 * fq, 1024, wr, fr);
        } else {
            bf16_t* base = rin + (size_t)u.pm * BM * 1024 + (u.pn - 8) * 128 + wc * 32 + 8 * fq;
            PG8_FOR_AM *(u32x4*)(base + (size_t)(ai * HALF + wr * 64 + m * 16 + fr) * 1024) = pack8(acc[ai][0][m][0] * acc[ai][1][m][0], acc[ai][0][m][1] * acc[ai][1][m][1]);
        }
    }
};
struct EpiQm {
    bf16_t* O; PG8_LAS float* X; const float* sa; const float* sb;
    __device__ __forceinline__ void operator()(Acc& acc, const Unit& u, int wr, int wc, int fr, int fq) const {
        dequant_i8_cols(acc, sb + u.pn * BM, wc, fq);
        float s[2][4];
        PG8_FOR_AM { float ss = 0.f; PG8_FOR_BN ss += dot4(acc[ai][bj][m][n]); s[ai][m] = ss; }
        row_sum_xchg(s, X, wr, wc, fr, fq);
        PG8_FOR_AM { const float ra = sa[u.pm * BM + ai * HALF + wr * 64 + m * 16 + fr]; const float rstd = __builtin_amdgcn_rsqf(s[ai][m] * (1.0f / 256.0f) + NORM_EPS * __builtin_amdgcn_rcpf(ra * ra + 1e-30f)); PG8_FOR_BN acc[ai][bj][m][n] = acc[ai][bj][m][n] * rstd; }
        asm volatile("s_waitcnt lgkmcnt(0)" ::: "memory"); __builtin_amdgcn_s_barrier(); asm volatile("" ::: "memory");
        store_tile_bf16(acc, O + (size_t)u.pm * BM * 1024 + u.pn * BM + wc * 64 + 8 * fq, 1024, wr, fr);
    }
};
struct EpiMemK {
    bf16_t* O; const float* gq; const float* gk; PG8_LAS float* X;
    __device__ __forceinline__ void operator()(Acc& acc, const Unit& u, int wr, int wc, int fr, int fq) const {
        const int c0 = wc * 64 + 8 * fq;
        f32x4 gv[2][2];
        PG8_FOR_BN gv[bj][n] = *(const f32x4*)(gq + c0 + bj * 32 + 4 * n) * *(const f32x4*)(gk + c0 + bj * 32 + 4 * n) * (LOG2E / 16.0f);
        float s[2][4];
        PG8_FOR_AM { float ss = 0.f; PG8_FOR_BN ss += dot4(acc[ai][bj][m][n]); s[ai][m] = ss; }
        row_sum_xchg(s, X, wr, wc, fr, fq);
        PG8_FOR_AM { const float rstd = __builtin_amdgcn_rsqf(s[ai][m] * (1.0f / 256.0f) + NORM_EPS); PG8_FOR_BN acc[ai][bj][m][n] = acc[ai][bj][m][n] * (gv[bj][n] * rstd); }
        asm volatile("s_waitcnt lgkmcnt(0)" ::: "memory"); __builtin_amdgcn_s_barrier(); asm volatile("" ::: "memory");
        store_tile_bf16(acc, O + (size_t)u.pm * BM * 1024 + u.pn * BM + c0, 1024, wr, fr);
    }
};
struct EpiPlain {
    bf16_t* O; int ldc;
    __device__ __forceinline__ void operator()(Acc& acc, const Unit& u, int wr, int wc, int fr, int fq) const {
        store_tile_bf16(acc, O + (size_t)u.pm * BM * ldc + u.pn * BM + wc * 64 + 8 * fq, ldc, wr, fr);
    }
};
struct EpiSoftmax {
    bf16_t* O; PG8_LAS float* X;
    __device__ __forceinline__ void operator()(Acc& acc, const Unit& u, int wr, int wc, int fr, int fq) const {
        float s[2][4];
        PG8_FOR_AM { float ss = 0.f; PG8_FOR_BN { f32x4& v = acc[ai][bj][m][n]; v[0] = __builtin_amdgcn_exp2f(v[0]); v[1] = __builtin_amdgcn_exp2f(v[1]); v[2] = __builtin_amdgcn_exp2f(v[2]); v[3] = __builtin_amdgcn_exp2f(v[3]); ss += sum4(v); } s[ai][m] = ss; }
        row_sum_xchg(s, X, wr, wc, fr, fq);
        PG8_FOR_AM { const float inv = __builtin_amdgcn_rcpf(s[ai][m]); PG8_FOR_BN acc[ai][bj][m][n] = acc[ai][bj][m][n] * inv; }
        asm volatile("s_waitcnt lgkmcnt(0)" ::: "memory"); __builtin_amdgcn_s_barrier(); asm volatile("" ::: "memory");
        store_tile_bf16(acc, O + (size_t)u.pm * BM * 1024 + u.pn * BM + wc * 64 + 8 * fq, 1024, wr, fr);
    }
};
struct EpiGate {
    unsigned char* g0; size_t gstride; const float* bias; const float* sa; const float* sb;
    __device__ __forceinline__ void operator()(Acc& acc, const Unit& u, int wr, int wc, int fr, int fq) const {
        dequant_i8(acc, sa + u.pm * BM, sb + u.pn * BM, wr, wc, fr, fq);
        const int br = u.pn >> 2, colt = (u.pn & 3) * BM, c0 = wc * 64 + 8 * fq;
        f32x4 bv[2][2];
        PG8_FOR_BN bv[bj][n] = *(const f32x4*)(bias + u.pn * BM + c0 + bj * 32 + 4 * n);
        unsigned char* base = g0 + (size_t)br * gstride + (size_t)u.pm * BM * 1024 + colt + c0;
        PG8_FOR_AM {
#pragma unroll
            for (int bj = 0; bj < 2; ++bj) { unsigned w[2];
#pragma unroll
                for (int n = 0; n < 2; ++n) { const f32x4 v = acc[ai][bj][m][n] + bv[bj][n]; w[n] = 0u;
#pragma unroll
                    for (int e = 0; e < 4; ++e) { const float gsig = __builtin_amdgcn_rcpf(1.0f + __builtin_amdgcn_exp2f(-LOG2E * v[e]));
                        w[n] |= (unsigned)__builtin_fmaxf(__builtin_rintf(gsig * 255.0f), 1.0f) << (8 * e); } }
                *(unsigned long long*)(base + (size_t)(ai * HALF + wr * 64 + m * 16 + fr) * 1024 + bj * 32) = (unsigned long long)w[0] | ((unsigned long long)w[1] << 32); } }
    }
};
template <bool ACCUM> struct EpiBranch {
    const bf16_t* g; bf16_t* O;
    __device__ __forceinline__ void operator()(Acc& acc, const Unit& u, int wr, int wc, int fr, int fq) const {
        const size_t off0 = (size_t)u.pm * BM * 1024 + u.pn * BM + wc * 64 + 8 * fq + (size_t)(wr * 64 + fr) * 1024;
#pragma unroll
        for (int ai = 0; ai < 2; ++ai) {
            u32x4 gq[4][2], oq[4][2];
#pragma unroll
            for (int m = 0; m < 4; ++m)
#pragma unroll
                for (int bj = 0; bj < 2; ++bj) { gq[m][bj] = *(const u32x4*)(g + off0 + (size_t)(ai * HALF + m * 16) * 1024 + bj * 32);
                    if (ACCUM) oq[m][bj] = *(const u32x4*)(O + off0 + (size_t)(ai * HALF + m * 16) * 1024 + bj * 32); }
#pragma unroll
            for (int m = 0; m < 4; ++m)
#pragma unroll
                for (int bj = 0; bj < 2; ++bj) { f32x4 g0v, g1v; unpack8(gq[m][bj], g0v, g1v);
                    f32x4 v0 = acc[ai][bj][m][0] * g0v, v1 = acc[ai][bj][m][1] * g1v;
                    if (ACCUM) { f32x4 p0, p1; unpack8(oq[m][bj], p0, p1); v0 = v0 + p0; v1 = v1 + p1; }
                    *(u32x4*)(O + off0 + (size_t)(ai * HALF + m * 16) * 1024 + bj * 32) = pack8(v0, v1); }
        }
    }
};
struct EpiBranch3 {
    const unsigned char* g0; const unsigned char* g1; const unsigned char* g2; bf16_t* O;
    __device__ __forceinline__ void operator()(Acc& acc, const Unit& u, int wr, int wc, int fr, int fq) const {
        const size_t off0 = (size_t)u.pm * BM * 1024 + u.pn * BM + wc * 64 + 8 * fq + (size_t)(wr * 64 + fr) * 1024;
        const unsigned char* gn = u.seg == 0 ? g0 : u.seg == 1 ? g1 : g2;
        const unsigned char* gd = u.seg == 0 ? g1 : g2;
        const bool last = u.seg == 2;
        typedef unsigned long long u64;
#pragma unroll
        for (int ai = 0; ai < 2; ++ai) {
            u64 nq[4][2], dq[4][2];
#pragma unroll
            for (int m = 0; m < 4; ++m)
#pragma unroll
                for (int bj = 0; bj < 2; ++bj) { nq[m][bj] = *(const u64*)(gn + off0 + (size_t)(ai * HALF + m * 16) * 1024 + bj * 32);
                    if (!last) dq[m][bj] = *(const u64*)(gd + off0 + (size_t)(ai * HALF + m * 16) * 1024 + bj * 32); }
#pragma unroll
            for (int m = 0; m < 4; ++m)
#pragma unroll
                for (int bj = 0; bj < 2; ++bj) { f32x4 n0, n1;
#pragma unroll
                    for (int e = 0; e < 4; ++e) { n0[e] = (float)(unsigned)((nq[m][bj] >> (8 * e)) & 0xffu); n1[e] = (float)(unsigned)((nq[m][bj] >> (32 + 8 * e)) & 0xffu); }
                    if (!last) {
#pragma unroll
                        for (int e = 0; e < 4; ++e) { n0[e] *= __builtin_amdgcn_rcpf((float)(unsigned)((dq[m][bj] >> (8 * e)) & 0xffu)); n1[e] *= __builtin_amdgcn_rcpf((float)(unsigned)((dq[m][bj] >> (32 + 8 * e)) & 0xffu)); }
                    } else { n0 = n0 * (1.0f / 255.0f); n1 = n1 * (1.0f / 255.0f); }
                    acc[ai][bj][m][0] = acc[ai][bj][m][0] * n0; acc[ai][bj][m][1] = acc[ai][bj][m][1] * n1;
                    if (last) *(u32x4*)(O + off0 + (size_t)(ai * HALF + m * 16) * 1024 + bj * 32) = pack8(acc[ai][bj][m][0], acc[ai][bj][m][1]); }
        }
    }
};
struct EpiResF32 {
    const float* base; float* out;
    __device__ __forceinline__ void operator()(Acc& acc, const Unit& u, int wr, int wc, int fr, int fq) const {
        const size_t off0 = (size_t)u.pm * BM * 1024 + u.pn * BM + wc * 64 + 8 * fq + (size_t)(wr * 64 + fr) * 1024;
#pragma unroll
        for (int ai = 0; ai < 2; ++ai) {
            f32x4 bv[4][2][2];
#pragma unroll
            for (int m = 0; m < 4; ++m) PG8_FOR_BN bv[m][bj][n] = *(const f32x4*)(base + off0 + (size_t)(ai * HALF + m * 16) * 1024 + bj * 32 + 4 * n);
#pragma unroll
            for (int m = 0; m < 4; ++m) PG8_FOR_BN *(f32x4*)(out + off0 + (size_t)(ai * HALF + m * 16) * 1024 + bj * 32 + 4 * n) = bv[m][bj][n] + acc[ai][bj][m][n];
        }
    }
};
struct EpiX1 {
    const float* base; float* out; bf16_t* xb; float* stats;
    __device__ __forceinline__ void operator()(Acc& acc, const Unit& u, int wr, int wc, int fr, int fq) const {
        const size_t off0 = (size_t)u.pm * BM * 1024 + u.pn * BM + wc * 64 + 8 * fq + (size_t)(wr * 64 + fr) * 1024;
#pragma unroll
        for (int ai = 0; ai < 2; ++ai) {
            f32x4 bv[4][2][2];
#pragma unroll
            for (int m = 0; m < 4; ++m) PG8_FOR_BN bv[m][bj][n] = *(const f32x4*)(base + off0 + (size_t)(ai * HALF + m * 16) * 1024 + bj * 32 + 4 * n);
#pragma unroll
            for (int m = 0; m < 4; ++m) { const size_t ro = off0 + (size_t)(ai * HALF + m * 16) * 1024; float ss = 0.f;
                PG8_FOR_BN { const f32x4 v = bv[m][bj][n] + acc[ai][bj][m][n]; acc[ai][bj][m][n] = v; ss += dot4(v); }
#pragma unroll
                for (int bj = 0; bj < 2; ++bj) *(u32x4*)(xb + ro + bj * 32) = pack8(acc[ai][bj][m][0], acc[ai][bj][m][1]);
                ss += __shfl_xor(ss, 16); ss += __shfl_xor(ss, 32);
                if (fq == 0) stats[(size_t)(u.pm * BM + ai * HALF + wr * 64 + m * 16 + fr) * 16 + u.pn * 4 + wc] = ss; }
        }
    }
};
struct EpiRelu2P {
    bf16_t* O; int ldc;
    __device__ __forceinline__ void operator()(Acc& acc, const Unit& u, int wr, int wc, int fr, int fq) const {
        bf16_t* base = O + (size_t)u.pm * BM * ldc + u.pn * BM + wc * 64 + 8 * fq;
        PG8_FOR_AM {
            PG8_FOR_BN { f32x4 v = acc[ai][bj][m][n];
#pragma unroll
                for (int e = 0; e < 4; ++e) { const float r = __builtin_fmaxf(v[e], 0.f); v[e] = r * r; }
                acc[ai][bj][m][n] = v; }
#pragma unroll
            for (int bj = 0; bj < 2; ++bj) *(u32x4*)(base + (size_t)(ai * HALF + wr * 64 + m * 16 + fr) * ldc + bj * 32) = pack8(acc[ai][bj][m][0], acc[ai][bj][m][1]); }
    }
};
struct EpiOutN {
    const bf16_t* xb; float* out; const float* stats;
    __device__ __forceinline__ void operator()(Acc& acc, const Unit& u, int wr, int wc, int fr, int fq) const {
        const size_t off0 = (size_t)u.pm * BM * 1024 + u.pn * BM + wc * 64 + 8 * fq + (size_t)(wr * 64 + fr) * 1024;
        float rs[2][4];
        PG8_FOR_AM rs[ai][m] = sum4(*(const f32x4*)(stats + (size_t)(u.pm * BM + ai * HALF + wr * 64 + m * 16 + fr) * 16 + 4 * fq));
#pragma unroll
        for (int ai = 0; ai < 2; ++ai) {
            u32x4 bq[4][2];
#pragma unroll
            for (int m = 0; m < 4; ++m)
#pragma unroll
                for (int bj = 0; bj < 2; ++bj) bq[m][bj] = *(const u32x4*)(xb + off0 + (size_t)(ai * HALF + m * 16) * 1024 + bj * 32);
#pragma unroll
            for (int m = 0; m < 4; ++m) { float t = rs[ai][m]; t += __shfl_xor(t, 16); t += __shfl_xor(t, 32);
                const float r2 = __builtin_amdgcn_rcpf(t * (1.0f / 1024.0f) + NORM_EPS);
#pragma unroll
                for (int bj = 0; bj < 2; ++bj) { f32x4 p0, p1; unpack8(bq[m][bj], p0, p1);
                    *(f32x4*)(out + off0 + (size_t)(ai * HALF + m * 16) * 1024 + bj * 32) = p0 + acc[ai][bj][m][0] * r2;
                    *(f32x4*)(out + off0 + (size_t)(ai * HALF + m * 16) * 1024 + bj * 32 + 4) = p1 + acc[ai][bj][m][1] * r2; } }
        }
    }
};
struct EpiRelu2N {
    bf16_t* O; int ldc; const float* stats;
    __device__ __forceinline__ void operator()(Acc& acc, const Unit& u, int wr, int wc, int fr, int fq) const {
        bf16_t* base = O + (size_t)u.pm * BM * ldc + u.pn * BM + wc * 64 + 8 * fq;
        float rs[2][4];
        PG8_FOR_AM rs[ai][m] = sum4(*(const f32x4*)(stats + (size_t)(u.pm * BM + ai * HALF + wr * 64 + m * 16 + fr) * 16 + 4 * fq));
        PG8_FOR_AM { float t = rs[ai][m]; t += __shfl_xor(t, 16); t += __shfl_xor(t, 32); rs[ai][m] = __builtin_amdgcn_rsqf(t * (1.0f / 1024.0f) + NORM_EPS); }
        PG8_FOR_AM { const float rstd = rs[ai][m];
            PG8_FOR_BN { f32x4 v = acc[ai][bj][m][n] * rstd;
#pragma unroll
                for (int e = 0; e < 4; ++e) { const float r = __builtin_fmaxf(v[e], 0.f); v[e] = r * r; }
                acc[ai][bj][m][n] = v; }
#pragma unroll
            for (int bj = 0; bj < 2; ++bj) *(u32x4*)(base + (size_t)(ai * HALF + wr * 64 + m * 16 + fr) * ldc + bj * 32) = pack8(acc[ai][bj][m][0], acc[ai][bj][m][1]); }
    }
};

template <class Epi, class Sched, bool ALIGN_EPI = false, bool SP2 = false, bool SEG3 = false, bool F8 = false, bool I8 = false>
__device__ __forceinline__ void gemm_phase(PG8_LAS unsigned char* lds, const Gemm g, const Sched& S, const Epi& E) {
    int tid_ = threadIdx.x; asm volatile("" : "+v"(tid_));
    const int tid = tid_, wid = __builtin_amdgcn_readfirstlane(tid >> 6), lane = tid & 63, wr = wid >> 2, wc = wid & 3, fr = lane & 15, fq = lane >> 4;
    const int K = g.K, nt = K / BK;
    unsigned voffA[2], voffB[2];
#pragma unroll
    for (int i = 0; i < 2; ++i) { int R, C; stage_rc(tid * 16 + i * 8192, R, C); const int Rb = 64 * (R >> 5) + perm32(R & 31);
        voffA[i] = (unsigned)(R * g.lda + C) * 2u; voffB[i] = (unsigned)(Rb * g.ldb + C) * 2u; }
    const size_t kstep = (size_t)(BK * 2);
    const size_t hstepA = (size_t)HALF * g.lda * 2;
    const size_t hstepB = (size_t)32 * g.ldb * 2;
    const unsigned ldsw = (unsigned)wid * 1024u;
    const int aoff = lds_byte(wr * 64 + fr, fq * 8), boff = lds_byte(wc * 32 + fr, fq * 8);
#define PG8_SA(b, h) (((b) * 2 + (h)) * HTB)
#define PG8_SB(b, h) ((4 + (b) * 2 + (h)) * HTB)
#define PG8_STAGE(bufoff, gbase, voff) do { _Pragma("unroll") for (int _i = 0; _i < 2; ++_i) \
        __builtin_amdgcn_global_load_lds((const unsigned*)((const char*)(gbase) + (voff)[_i]), (PG8_LAS unsigned*)(lds + (bufoff) + ldsw + _i * 8192), 16, 0, 0); } while (0)
#define PG8_LDA(dst, b, h) do { if constexpr (F8) { _Pragma("unroll") for (int m = 0; m < 4; ++m) dst##8[m] = pg8_cat(*(const PG8_LAS bf16x8*)(lds + PG8_SA(b, h) + aoff + m * 2048), *(const PG8_LAS bf16x8*)(lds + PG8_SA(b, h) + aoff + m * 2048 + 1024)); } \
        else { _Pragma("unroll") for (int m = 0; m < 4; ++m) _Pragma("unroll") for (int k = 0; k < 2; ++k) dst[m][k] = *(const PG8_LAS bf16x8*)(lds + PG8_SA(b, h) + aoff + m * 2048 + k * 1024); } } while (0)
#define PG8_LDB(dst, b, h) do { if constexpr (F8) { _Pragma("unroll") for (int n = 0; n < 2; ++n) dst##8[n] = pg8_cat(*(const PG8_LAS bf16x8*)(lds + PG8_SB(b, h) + boff + n * 2048), *(const PG8_LAS bf16x8*)(lds + PG8_SB(b, h) + boff + n * 2048 + 1024)); } \
        else { _Pragma("unroll") for (int n = 0; n < 2; ++n) _Pragma("unroll") for (int k = 0; k < 2; ++k) dst[n][k] = *(const PG8_LAS bf16x8*)(lds + PG8_SB(b, h) + boff + n * 2048 + k * 1024); } } while (0)
#define PG8_MMA(ai, bj, At, Bt) do { __builtin_amdgcn_s_setprio(1); _Pragma("unroll") for (int m = 0; m < 4; ++m) _Pragma("unroll") for (int n = 0; n < 2; ++n) { \
        if constexpr (F8) { asm volatile("v_mfma_f32_16x16x128_f8f6f4 %0, %1, %2, %0" : "+v"(acc[ai][bj][m][n]) : "v"(Bt##8[n]), "v"(At##8[m])); }     \
        else if constexpr (I8) { _Pragma("unroll") for (int k = 0; k < 2; ++k) acc[ai][bj][m][n] = __builtin_bit_cast(f32x4, __builtin_amdgcn_mfma_i32_16x16x64_i8(__builtin_bit_cast(v4i32, Bt[n][k]), __builtin_bit_cast(v4i32, At[m][k]), __builtin_bit_cast(v4i32, acc[ai][bj][m][n]), 0, 0, 0)); } \
        else { _Pragma("unroll") for (int k = 0; k < 2; ++k) acc[ai][bj][m][n] = __builtin_amdgcn_mfma_f32_16x16x32_bf16(Bt[n][k], At[m][k], acc[ai][bj][m][n], 0, 0, 0); } } __builtin_amdgcn_s_setprio(0); } while (0)
#define PG8_WAIT_V(n) asm volatile("s_waitcnt vmcnt(" #n ")" ::: "memory")
#define PG8_WAIT_L(n) asm volatile("s_waitcnt lgkmcnt(" #n ")" ::: "memory")
#define PG8_BAR __builtin_amdgcn_s_barrier()
#define PG8_SCHED __builtin_amdgcn_sched_barrier(0)
    Unit cur, nxt; int ui = 0;
    if (!S.next(0, cur)) return;
    f32x4 acc[2][2][4][2];
#pragma unroll
    for (int a = 0; a < 2; ++a)
#pragma unroll
        for (int b = 0; b < 2; ++b)
#pragma unroll
            for (int m = 0; m < 4; ++m)
#pragma unroll
                for (int n = 0; n < 2; ++n) acc[a][b][m][n] = (f32x4){0.f, 0.f, 0.f, 0.f};
    bf16x8 At[4][2], B0[2][2], B1[2][2]; v8i32 At8[4], B08[2], B18[2];
#define PG8_APTR(u) (const char*)((SEG3 ? ((u).seg == 0 ? g.A : (u).seg == 1 ? g.A1 : g.A2) : g.A) + (size_t)(u).pm * g.sAm + (size_t)(u).pn * g.sAn)
#define PG8_BPTR(u) (const char*)(g.Bt + (SEG3 ? (size_t)(u).seg * g.sBseg : (size_t)0) + (size_t)(u).pn * g.sBn + (size_t)((u).pm >> 4) * g.sBb)
    const char* cA = PG8_APTR(cur); const char* cB = PG8_BPTR(cur);
    S.a_ready(cur);
    if constexpr (SP2) {
        PG8_STAGE(PG8_SB(0, 0), cB, voffB); PG8_STAGE(PG8_SB(0, 1), cB + hstepB, voffB); PG8_STAGE(PG8_SA(0, 0), cA, voffA); PG8_STAGE(PG8_SA(0, 1), cA + hstepA, voffA);
        if (wr == 1) PG8_BAR;
        PG8_WAIT_V(2); PG8_BAR;
        PG8_STAGE(PG8_SB(1, 0), cB + kstep, voffB); PG8_STAGE(PG8_SA(1, 0), cA + kstep, voffA); PG8_STAGE(PG8_SB(1, 1), cB + hstepB + kstep, voffB);
        PG8_WAIT_V(6); PG8_BAR;
    } else {
        PG8_STAGE(PG8_SB(0, 0), cB, voffB); PG8_STAGE(PG8_SA(0, 0), cA, voffA); PG8_STAGE(PG8_SB(0, 1), cB + hstepB, voffB); PG8_STAGE(PG8_SA(0, 1), cA + hstepA, voffA);
        if (wr == 1) PG8_BAR;
        PG8_WAIT_V(4); PG8_BAR;
        PG8_STAGE(PG8_SB(1, 0), cB + kstep, voffB); PG8_STAGE(PG8_SA(1, 0), cA + kstep, voffA); PG8_STAGE(PG8_SB(1, 1), cB + hstepB + kstep, voffB);
        PG8_WAIT_V(6); PG8_BAR;
    }
    for (;;) {
        const bool has_next = S.next(ui + 1, nxt);
        const char* nA = has_next ? PG8_APTR(nxt) : cA; const char* nB = has_next ? PG8_BPTR(nxt) : cB;
#pragma nounroll
        for (int t = 0; t < nt; t += 2) {
            const bool last = (t == nt - 2);
            const char* a1 = cA + (size_t)(t + 1) * kstep;
            const char* a2 = last ? nA : cA + (size_t)(t + 2) * kstep; const char* b2 = last ? nB : cB + (size_t)(t + 2) * kstep;
            const char* a3 = a2 + kstep; const char* b3 = b2 + kstep;
            if (last && has_next) S.a_ready(nxt);
            if constexpr (SP2) {
            PG8_LDB(B0, 0, 0); PG8_LDB(B1, 0, 1); PG8_SCHED; PG8_LDA(At, 0, 0); PG8_STAGE(PG8_SA(1, 1), a1 + hstepA, voffA);
            PG8_WAIT_V(8); PG8_WAIT_L(0); PG8_BAR; PG8_MMA(0, 0, At, B0); PG8_MMA(0, 1, At, B1); PG8_BAR; PG8_SCHED;
            PG8_LDA(At, 0, 1); PG8_STAGE(PG8_SB(0, 0), b2, voffB); PG8_STAGE(PG8_SB(0, 1), b2 + hstepB, voffB); PG8_STAGE(PG8_SA(0, 0), a2, voffA);
            PG8_WAIT_V(8); PG8_WAIT_L(0); PG8_BAR; PG8_MMA(1, 0, At, B0); PG8_MMA(1, 1, At, B1); PG8_BAR; PG8_SCHED;
            PG8_LDB(B0, 1, 0); PG8_LDB(B1, 1, 1); PG8_SCHED; PG8_LDA(At, 1, 0); PG8_STAGE(PG8_SA(0, 1), a2 + hstepA, voffA);
            PG8_WAIT_V(8); PG8_WAIT_L(0); PG8_BAR; PG8_MMA(0, 0, At, B0); PG8_MMA(0, 1, At, B1); PG8_BAR; PG8_SCHED;
            PG8_LDA(At, 1, 1); PG8_STAGE(PG8_SB(1, 0), b3, voffB); PG8_STAGE(PG8_SB(1, 1), b3 + hstepB, voffB); PG8_STAGE(PG8_SA(1, 0), a3, voffA);
            PG8_WAIT_V(8); PG8_WAIT_L(0); PG8_BAR; PG8_MMA(1, 0, At, B0); PG8_MMA(1, 1, At, B1); PG8_BAR; PG8_SCHED;
            } else {
            PG8_LDB(B0, 0, 0); PG8_SCHED; PG8_LDA(At, 0, 0); PG8_STAGE(PG8_SA(1, 1), a1 + hstepA, voffA);
            PG8_WAIT_L(8); PG8_BAR; PG8_WAIT_L(0); PG8_MMA(0, 0, At, B0); PG8_BAR; PG8_SCHED;
            PG8_LDB(B1, 0, 1); PG8_STAGE(PG8_SB(0, 0), b2, voffB);
            PG8_BAR; PG8_WAIT_L(0); PG8_MMA(0, 1, At, B1); PG8_BAR;
            PG8_LDA(At, 0, 1); PG8_STAGE(PG8_SA(0, 0), a2, voffA);
            PG8_BAR; PG8_WAIT_L(0); PG8_MMA(1, 0, At, B0); PG8_BAR; PG8_SCHED;
            PG8_STAGE(PG8_SB(0, 1), b2 + hstepB, voffB);
            PG8_WAIT_V(6); PG8_BAR; PG8_MMA(1, 1, At, B1); PG8_BAR;
            PG8_LDB(B0, 1, 0); PG8_SCHED; PG8_LDA(At, 1, 0); PG8_STAGE(PG8_SA(0, 1), a2 + hstepA, voffA);
            PG8_WAIT_L(8); PG8_BAR; PG8_WAIT_L(0); PG8_MMA(0, 0, At, B0); PG8_BAR; PG8_SCHED;
            PG8_LDB(B1, 1, 1); PG8_STAGE(PG8_SB(1, 0), b3, voffB);
            PG8_BAR; PG8_WAIT_L(0); PG8_MMA(0, 1, At, B1); PG8_BAR;
            PG8_LDA(At, 1, 1); PG8_STAGE(PG8_SA(1, 0), a3, voffA);
            PG8_BAR; PG8_WAIT_L(0); PG8_MMA(1, 0, At, B0); PG8_BAR; PG8_SCHED;
            PG8_STAGE(PG8_SB(1, 1), b3 + hstepB, voffB);
            PG8_WAIT_V(6); PG8_BAR; PG8_MMA(1, 1, At, B1); PG8_BAR;
            }
        }
        if constexpr (ALIGN_EPI) { if (wr == 0) PG8_BAR; }
        E(acc, cur, wr, wc, fr, fq); S.done(cur);
        if (!has_next) break;
        if (!(SEG3 && cur.seg < 2))
#pragma unroll
        for (int a = 0; a < 2; ++a)
#pragma unroll
            for (int b = 0; b < 2; ++b)
#pragma unroll
                for (int m = 0; m < 4; ++m)
#pragma unroll
                    for (int n = 0; n < 2; ++n) acc[a][b][m][n] = (f32x4){0.f, 0.f, 0.f, 0.f};
        cur = nxt; cA = nA; cB = nB; ++ui;
        if constexpr (ALIGN_EPI) { if (wr == 1) PG8_BAR; }
    }
    PG8_WAIT_V(0);
    if constexpr (!ALIGN_EPI) { if (wr == 0) PG8_BAR; }
    PG8_BAR;
#undef PG8_APTR
#undef PG8_BPTR
#undef PG8_SA
#undef PG8_SB
#undef PG8_STAGE
#undef PG8_LDA
#undef PG8_LDB
#undef PG8_MMA
#undef PG8_WAIT_V
#undef PG8_WAIT_L
#undef PG8_BAR
#undef PG8_SCHED
}
}
#include <hip/hip_bf16.h>
#include <cmath>
namespace attn_body {
using bf16=__hip_bfloat16;
using bf16x8=__attribute__((ext_vector_type(8)))short;
using s16x4=__attribute__((ext_vector_type(4)))short;
using f32x16=__attribute__((ext_vector_type(16)))float;
using u32x4=__attribute__((ext_vector_type(4)))unsigned;
constexpr int BATCH=8,NHEAD=16,SEQ=4096,D=64,DM=NHEAD*D;
constexpr int NW=8,QBLK=32,QB=QBLK*NW,KVBLK=64,NQB=SEQ/QB;
constexpr int ATTN_PITCH=DM, ATTN_UNIT_ROWS=QB;
__device__ __forceinline__ int crow(int r,int hi){return (r&3)+8*(r>>2)+4*hi;}
#define SBAR() __builtin_amdgcn_sched_barrier(0)
__device__ __forceinline__ void cmask(f32x16&p0,f32x16&p1,int jb,int qrel,int hi){
  const float NEG=-INFINITY; int kb=64*jb+4*hi;
  #pragma unroll
  for(int r=0;r<16;++r){int kv=kb+(r&3)+8*(r>>2); if(kv>qrel)p0[r]=NEG; if(kv+32>qrel)p1[r]=NEG;}
}

constexpr int NSLOT=3, SLOTB=8192;
constexpr int VSLOTB=2*SLOTB;
constexpr int LDS_K=0, LDS_V=NSLOT*SLOTB, LDS_WS=LDS_V+NSLOT*VSLOTB, LDS_OST=LDS_WS+NW*64*4, LDS_BYTES=LDS_OST+NW*4096;
constexpr float C2=0.125f*1.4426950408889634f;
__device__ __forceinline__ void glds16(const void*gsrc,unsigned lds_dst){unsigned keep;
  asm volatile("s_mov_b32 %0, m0\n\ts_mov_b32 m0, %2\n\ts_nop 0\n\tglobal_load_lds_dwordx4 %1, off\n\ts_mov_b32 m0, %0":"=&s"(keep):"v"(gsrc),"s"(lds_dst):"memory");}
__device__ __forceinline__ float max3f(float a,float b,float c){float r;asm("v_max3_f32 %0, %1, %2, %3":"=v"(r):"v"(a),"v"(b),"v"(c));return r;}
__device__ __forceinline__ float max2f(float a,float b){float r;asm("v_max_f32_e32 %0, %1, %2":"=v"(r):"v"(a),"v"(b));return r;}
__device__ __forceinline__ float fadd_s(float a,float b){float r;asm("v_add_f32_e32 %0, %1, %2":"=v"(r):"v"(a),"v"(b));return r;}
__device__ __forceinline__ float fsub_s(float a,float b){float r;asm("v_sub_f32_e32 %0, %1, %2":"=v"(r):"v"(a),"v"(b));return r;}
typedef float f32x2_t __attribute__((ext_vector_type(2))); typedef __bf16 bf16x2_t __attribute__((ext_vector_type(2)));
__device__ __forceinline__ unsigned cvtpk_s(float lo,float hi){f32x2_t v={lo,hi};bf16x2_t b=__builtin_convertvector(v,bf16x2_t);return __builtin_bit_cast(unsigned,b);}
#define WAIT_BAR(N) asm volatile("s_waitcnt vmcnt(" #N ") lgkmcnt(0)\n\ts_barrier":::"memory")

__device__ __forceinline__ void qkt(f32x16&p0,f32x16&p1,const char*Kslot,const bf16x8*qr,const f32x16&negm,int r32,int hi){
  const char*kb=Kslot+hi*1024+r32*16;
  #pragma unroll
  for(int d0=0;d0<4;++d0){
    const bf16x8 b0=*reinterpret_cast<const bf16x8*>(kb+d0*2048);
    const bf16x8 b1=*reinterpret_cast<const bf16x8*>(kb+d0*2048+512);
    if(d0==0){p0=__builtin_amdgcn_mfma_f32_32x32x16_bf16(b0,qr[0],negm,0,0,0);p1=__builtin_amdgcn_mfma_f32_32x32x16_bf16(b1,qr[0],negm,0,0,0);}
    else{p0=__builtin_amdgcn_mfma_f32_32x32x16_bf16(b0,qr[d0],p0,0,0,0);p1=__builtin_amdgcn_mfma_f32_32x32x16_bf16(b1,qr[d0],p1,0,0,0);}}
}
typedef __attribute__((address_space(3))) const char* lds_cptr;
typedef short v4i16_t __attribute__((ext_vector_type(4)));
__device__ __forceinline__ void kload8(bf16x8*kf,lds_cptr kp){
  kf[0]=*(const __attribute__((address_space(3))) bf16x8*)(kp);      kf[1]=*(const __attribute__((address_space(3))) bf16x8*)(kp+512);
  kf[2]=*(const __attribute__((address_space(3))) bf16x8*)(kp+2048); kf[3]=*(const __attribute__((address_space(3))) bf16x8*)(kp+2560);
  kf[4]=*(const __attribute__((address_space(3))) bf16x8*)(kp+4096); kf[5]=*(const __attribute__((address_space(3))) bf16x8*)(kp+4608);
  kf[6]=*(const __attribute__((address_space(3))) bf16x8*)(kp+6144); kf[7]=*(const __attribute__((address_space(3))) bf16x8*)(kp+6656);
}
__device__ __forceinline__ void kload2(bf16x8*kf,lds_cptr kp,int j){ kf[2*j]=*(const __attribute__((address_space(3))) bf16x8*)(kp+j*2048); kf[2*j+1]=*(const __attribute__((address_space(3))) bf16x8*)(kp+j*2048+512); }
__device__ __forceinline__ s16x4 vtr(lds_cptr p){ return __builtin_bit_cast(s16x4,__builtin_amdgcn_ds_read_tr16_b64_v4i16((__attribute__((address_space(3))) v4i16_t*)p)); }
__device__ __forceinline__ float rowmax(const f32x16&p0,const f32x16&p1){
  float a=max3f(p0[0],p0[1],p1[0]),b=max3f(p0[2],p0[3],p1[1]);a=max3f(a,p1[2],p1[3]);
  #pragma unroll
  for(int r=4;r<16;r+=4){a=max3f(a,p0[r],p0[r+1]);b=max3f(b,p0[r+2],p0[r+3]);a=max3f(a,p1[r],p1[r+1]);b=max3f(b,p1[r+2],p1[r+3]);}
  const float m=max2f(a,b);
  auto rr=__builtin_amdgcn_permlane32_swap(__float_as_uint(m),__float_as_uint(m),false,false);
  return max2f(__uint_as_float(rr[0]),__uint_as_float(rr[1]));
}
__device__ __forceinline__ void pv(f32x16*o,int vb,bf16x8 pa0,bf16x8 pa1,bf16x8 pa2,bf16x8 pa3){
  #pragma unroll
  for(int d0=0;d0<4;++d0){s16x4 lo[4],hi[4];
    #pragma unroll
    for(int ks=0;ks<4;++ks){
      asm volatile("ds_read_b64_tr_b16 %0,%1 offset:%c2":"=&v"(lo[ks]):"v"(vb),"i"(d0*4096+ks*1024):"memory");
      asm volatile("ds_read_b64_tr_b16 %0,%1 offset:%c2":"=&v"(hi[ks]):"v"(vb),"i"(d0*4096+ks*1024+512):"memory");}
    asm volatile("s_waitcnt lgkmcnt(0)":::"memory");SBAR();
    #define PK(k) (bf16x8){lo[k][0],lo[k][1],lo[k][2],lo[k][3],hi[k][0],hi[k][1],hi[k][2],hi[k][3]}
    o[d0]=__builtin_amdgcn_mfma_f32_32x32x16_bf16(pa0,PK(0),o[d0],0,0,0);
    o[d0]=__builtin_amdgcn_mfma_f32_32x32x16_bf16(pa1,PK(1),o[d0],0,0,0);
    o[d0]=__builtin_amdgcn_mfma_f32_32x32x16_bf16(pa2,PK(2),o[d0],0,0,0);
    o[d0]=__builtin_amdgcn_mfma_f32_32x32x16_bf16(pa3,PK(3),o[d0],0,0,0);
    #undef PK
  }
}

#ifndef ATTN_STORE16
#define ATTN_STORE16(p,v) (*(u32x4*)(p)=(v))
#endif
template<int THRL,int MODE> __device__ __forceinline__ void attn_unit(int b,int h,int hv,int qb,const bf16*Q,const bf16*__restrict__ K,const bf16*__restrict__ V,bf16*O,bf16*OUT,float lam,const float*sg,char*shm,
    bool pre,bool has_next,int nb,int nh,int nhv,int nqb,bf16x8 (&qr)[4]){
  int tid_=threadIdx.x; asm volatile("":"+v"(tid_));
  const int tid=tid_,lane=tid&63,r32=lane&31,hi=lane>>5; const int wid=__builtin_amdgcn_readfirstlane(tid>>6);
  if(wid>=4)__builtin_amdgcn_s_setprio(1);
  const long rowbase=(long)b*SEQ; const int q0=qb*QB;
  const bf16*Qw=Q+(rowbase+q0+wid*QBLK)*DM+h*D;
  const bf16*Kh=K+rowbase*DM+h*D,*Vh=V+rowbase*DM+hv*D;
  const unsigned lds0=(unsigned)(uintptr_t)shm;
  float*wsf=(float*)(shm+LDS_WS)+wid*64;
  const bf16*ksrc=Kh+(long)lane*DM+wid*8;
  const bf16*vsrc=Vh+(long)(16*(wid&3)+(lane>>2))*DM+(wid>>2)*32+(lane&3)*8;
  const unsigned kdst=lds0+LDS_K+wid*1024, vdst=lds0+LDS_V+wid*1024;
  #define DMA_K(t,slot) glds16(ksrc+(long)(t)*KVBLK*DM,(unsigned)__builtin_amdgcn_readfirstlane(kdst+(slot)))
  #define DMA_V(t,slot) do{ glds16(vsrc+(long)(t)*KVBLK*DM,(unsigned)__builtin_amdgcn_readfirstlane(vdst+2*(slot))); glds16(vsrc+64+(long)(t)*KVBLK*DM,(unsigned)__builtin_amdgcn_readfirstlane(vdst+2*(slot)+SLOTB)); }while(0)
  const int vb0=(int)(lds0+LDS_V)+((lane>>4)&1)*32+(lane&3)*8+(4*hi+((lane&15)>>2))*64;
  const char*Kbase=shm+LDS_K; bf16x8 kf[8];
  const lds_cptr shm3=(lds_cptr)shm; const lds_cptr kp0=shm3+LDS_K+hi*1024+r32*16; const lds_cptr vp0=shm3+LDS_V+((lane>>4)&1)*32+(lane&3)*8+(4*hi+((lane&15)>>2))*64;
  const int NT=(q0+QB)/KVBLK;
  if(!pre){
  DMA_K(0,0);DMA_V(0,0);DMA_K(1,SLOTB);
  #pragma unroll
  for(int d0=0;d0<4;++d0)qr[d0]=*reinterpret_cast<const bf16x8*>(&Qw[(long)r32*DM+d0*16+hi*8]);
  }
  float l_reg=0.f;f32x16 o[4];o[0]=f32x16{};o[1]=f32x16{};o[2]=f32x16{};o[3]=f32x16{};const f32x16 negm=f32x16{};
  const int qrel=wid*QBLK+r32;
  #define CMASK(P0,P1,t) do{int jb_=(t)-(NT-4); if(jb_>=0)cmask(P0,P1,jb_,qrel,hi);}while(0)
  #define START(P0,P1) do{ _Pragma("unroll") for(int r=0;r<16;++r)P0[r]=__builtin_amdgcn_exp2f(P0[r]); }while(0)
  #define RESC() do{}while(0)
  f32x16 pA0,pA1,pB0,pB1;
  int sl_prev=0,sl_cur=0,sl_next=SLOTB;
  #define ROT() do{sl_prev=sl_cur;sl_cur=sl_next;sl_next=(sl_next==(NSLOT-1)*SLOTB)?0:sl_next+SLOTB;}while(0)
  DMA_K(2,2*SLOTB);
  WAIT_BAR(4);
  qkt(pA0,pA1,Kbase,qr,negm,r32,hi);asm volatile("s_nop 15\n\ts_nop 7":"+v"(pA0),"+v"(pA1));CMASK(pA0,pA1,0);
  START(pA0,pA1);
  _Pragma("unroll") for(int r=0;r<16;++r)pA1[r]=__builtin_amdgcn_exp2f(pA1[r]);
  WAIT_BAR(0);
  DMA_K(3,0);DMA_V(1,SLOTB);
  ROT();
  kload8(kf,kp0+sl_cur);
  WAIT_BAR(3);
  s16x4 vlo[8],vhi[8],wlo[8],whi[8]; u32x4 pw0,pw1,pw2,pw3;
  #define PKW(P,B) cvtpk_s(P[B],P[B+1])
  #define PAF(k) __builtin_bit_cast(bf16x8,pw##k)
  #define VFR(i) (bf16x8){vlo[i][0],vlo[i][1],vlo[i][2],vlo[i][3],vhi[i][0],vhi[i][1],vhi[i][2],vhi[i][3]}
  #define PIN(x) asm volatile("":"+v"(x))
  #define MX3(a,b,c) __builtin_fmaxf(__builtin_fmaxf((a),(b)),(c))
  #define GAPA(MF,A0,A1,A2,A3,W0,W1,PW) do{ MF; sacc+=A0; sacc+=A1; sacc+=A2; sacc+=A3; PIN(sacc); W0; W1; PIN(PW); SBAR(); }while(0)
  #define EX(v) __builtin_amdgcn_exp2f(v)
  #define GAPB(MF,X,B) do{ MF; X[B]=EX(X[B]); X[B+1]=EX(X[B+1]); X[B+2]=EX(X[B+2]); X[B+3]=EX(X[B+3]); PIN(X); SBAR(); }while(0)
  #define VRD(i) do{ vlo[i]=vtr(vp_+(((i)>>2)*4096+((i)&3)*1024)); vhi[i]=vtr(vp_+(((i)>>2)*4096+((i)&3)*1024+512)); }while(0)
  #define VRD1(i) do{ wlo[i]=vtr(vp_+(SLOTB+((i)>>2)*4096+((i)&3)*1024)); whi[i]=vtr(vp_+(SLOTB+((i)>>2)*4096+((i)&3)*1024+512)); SBAR(); }while(0)
  #define VFR1(i) (bf16x8){wlo[i][0],wlo[i][1],wlo[i][2],wlo[i][3],whi[i][0],whi[i][1],whi[i][2],whi[i][3]}
  #define GAPB2(MF,MG,X,B) do{ MF; MG; X[B]=EX(X[B]); X[B+1]=EX(X[B+1]); X[B+2]=EX(X[B+2]); X[B+3]=EX(X[B+3]); PIN(X); SBAR(); }while(0)
  #define KRD(G,j) do{ if(G){ kload2(kf,kp0+sl_next,j); SBAR(); } }while(0)
  #define STEP(C0,C1,P0,P1,t,GK,GV,GL) do{ SBAR(); \
    const lds_cptr vp_=vp0+2*sl_prev; \
    VRD(0); SBAR(); float sacc=(P0[0]+P0[1]); \
    GAPA(C0=__builtin_amdgcn_mfma_f32_32x32x16_bf16(kf[0],qr[0],negm,0,0,0), P0[2],P0[3],P0[4],P0[5],     pw0[0]=PKW(P0,0), pw0[1]=PKW(P0,2), pw0); \
    VRD(4); SBAR(); GAPA(C1=__builtin_amdgcn_mfma_f32_32x32x16_bf16(kf[1],qr[0],negm,0,0,0), P0[6],P0[7],P0[8],P0[9],     pw0[2]=PKW(P0,4), pw0[3]=PKW(P0,6), pw0); \
    VRD(1); SBAR(); GAPA(C0=__builtin_amdgcn_mfma_f32_32x32x16_bf16(kf[2],qr[1],C0,0,0,0),   P0[10],P0[11],P0[12],P0[13], pw1[0]=PKW(P0,8), pw1[1]=PKW(P0,10), pw1); \
    VRD(5); SBAR(); GAPA(C1=__builtin_amdgcn_mfma_f32_32x32x16_bf16(kf[3],qr[1],C1,0,0,0),   P0[14],P0[15],P1[0],P1[1],   pw1[2]=PKW(P0,12),pw1[3]=PKW(P0,14), pw1); \
    VRD(2); SBAR(); GAPA(C0=__builtin_amdgcn_mfma_f32_32x32x16_bf16(kf[4],qr[2],C0,0,0,0),   P1[2],P1[3],P1[4],P1[5],     pw2[0]=PKW(P1,0), pw2[1]=PKW(P1,2), pw2); VRD1(0); \
    VRD(6); SBAR(); GAPA(C1=__builtin_amdgcn_mfma_f32_32x32x16_bf16(kf[5],qr[2],C1,0,0,0),   P1[6],P1[7],P1[8],P1[9],     pw2[2]=PKW(P1,4), pw2[3]=PKW(P1,6), pw2); VRD1(4); \
    VRD(3); SBAR(); GAPA(C0=__builtin_amdgcn_mfma_f32_32x32x16_bf16(kf[6],qr[3],C0,0,0,0),   P1[10],P1[11],P1[12],P1[13], pw3[0]=PKW(P1,8), pw3[1]=PKW(P1,10), pw3); VRD1(1); \
    VRD(7); SBAR(); GAPA(C1=__builtin_amdgcn_mfma_f32_32x32x16_bf16(kf[7],qr[3],C1,0,0,0),   P1[14],P1[15],0.f,0.f,       pw3[2]=PKW(P1,12),pw3[3]=PKW(P1,14), pw3); VRD1(5); \
    l_reg+=sacc; \
    if(GK){DMA_K((t)+3,sl_cur);} if(GV){DMA_V((t)+1,sl_next);} \
    CMASK(C0,C1,t); \
    SBAR(); \
      \
    GAPB(o[0]=__builtin_amdgcn_mfma_f32_32x32x16_bf16(PAF(0),VFR(0),o[0],0,0,0), C0,0); VRD1(2); \
    GAPB2(o[1]=__builtin_amdgcn_mfma_f32_32x32x16_bf16(PAF(0),VFR(4),o[1],0,0,0), o[2]=__builtin_amdgcn_mfma_f32_32x32x16_bf16(PAF(0),VFR1(0),o[2],0,0,0), C0,4); VRD1(6); \
    KRD(GL,0); GAPB2(o[0]=__builtin_amdgcn_mfma_f32_32x32x16_bf16(PAF(1),VFR(1),o[0],0,0,0), o[3]=__builtin_amdgcn_mfma_f32_32x32x16_bf16(PAF(0),VFR1(4),o[3],0,0,0), C0,8); VRD1(3); \
    KRD(GL,1); GAPB2(o[1]=__builtin_amdgcn_mfma_f32_32x32x16_bf16(PAF(1),VFR(5),o[1],0,0,0), o[2]=__builtin_amdgcn_mfma_f32_32x32x16_bf16(PAF(1),VFR1(1),o[2],0,0,0), C0,12); VRD1(7); \
    KRD(GL,2); GAPB2(o[0]=__builtin_amdgcn_mfma_f32_32x32x16_bf16(PAF(2),VFR(2),o[0],0,0,0), o[3]=__builtin_amdgcn_mfma_f32_32x32x16_bf16(PAF(1),VFR1(5),o[3],0,0,0), C1,0); \
    KRD(GL,3); GAPB2(o[1]=__builtin_amdgcn_mfma_f32_32x32x16_bf16(PAF(2),VFR(6),o[1],0,0,0), o[2]=__builtin_amdgcn_mfma_f32_32x32x16_bf16(PAF(2),VFR1(2),o[2],0,0,0), C1,4); \
    GAPB2(o[0]=__builtin_amdgcn_mfma_f32_32x32x16_bf16(PAF(3),VFR(3),o[0],0,0,0), o[3]=__builtin_amdgcn_mfma_f32_32x32x16_bf16(PAF(2),VFR1(6),o[3],0,0,0), C1,8); \
    GAPB2(o[1]=__builtin_amdgcn_mfma_f32_32x32x16_bf16(PAF(3),VFR(7),o[1],0,0,0), o[2]=__builtin_amdgcn_mfma_f32_32x32x16_bf16(PAF(3),VFR1(3),o[2],0,0,0), C1,12); \
    o[3]=__builtin_amdgcn_mfma_f32_32x32x16_bf16(PAF(3),VFR1(7),o[3],0,0,0); SBAR(); \
    }while(0)
  int t=1;
  #undef CMASK
  #define CMASK(P0,P1,t) do{int jb_=(t)-(NT-4); if(jb_>=0)cmask(P0,P1,jb_,qrel,hi);}while(0)
  for(;t+3<NT;t+=2){
    STEP(pB0,pB1,pA0,pA1,t,true,true,true);     WAIT_BAR(3); RESC(); ROT();
    STEP(pA0,pA1,pB0,pB1,t+1,true,true,true);   WAIT_BAR(3); RESC(); ROT();
  }
  #undef CMASK
  #define CMASK(P0,P1,t) do{int jb_=(t)-(NT-4); if(jb_>=0)cmask(P0,P1,jb_,qrel,hi);}while(0)
  #define ENDW(tt) do{ if((tt)+3<NT){WAIT_BAR(3);} else if((tt)+2<NT){WAIT_BAR(2);} else {WAIT_BAR(0);} }while(0)
  #define PVTAIL(P0,P1,slot) do{ float sacc=P0[0]+P0[1]; _Pragma("unroll") for(int r=2;r<16;++r)sacc+=P0[r]; _Pragma("unroll") for(int r=0;r<16;++r)sacc+=P1[r]; l_reg+=sacc; \
    pw0=(u32x4){PKW(P0,0),PKW(P0,2),PKW(P0,4),PKW(P0,6)};pw1=(u32x4){PKW(P0,8),PKW(P0,10),PKW(P0,12),PKW(P0,14)};pw2=(u32x4){PKW(P1,0),PKW(P1,2),PKW(P1,4),PKW(P1,6)};pw3=(u32x4){PKW(P1,8),PKW(P1,10),PKW(P1,12),PKW(P1,14)}; \
    SBAR(); pv(o,vb0+2*(slot),PAF(0),PAF(1),PAF(2),PAF(3)); }while(0)
  STEP(pB0,pB1,pA0,pA1,NT-3,false,true,true);  WAIT_BAR(2); ROT();
  int vslot=sl_prev;
  if(wid>=4){ STEP(pA0,pA1,pB0,pB1,NT-2,false,true,true); WAIT_BAR(0); ROT();
              if(wid>=6){ STEP(pB0,pB1,pA0,pA1,NT-1,false,false,false); vslot=sl_cur; }
              else { pB0=pA0; pB1=pA1; vslot=sl_prev; } }
  else { SBAR(); DMA_V(NT-1,sl_next); WAIT_BAR(0); }
  PVTAIL(pB0,pB1,vslot);
  #undef PVTAIL
  #undef PKW
  #undef PAF
  #undef VFR
  #undef PIN
  #undef MX3
  #undef GAPA
  #undef GAPB
  #undef EX
  #undef VRD
  #undef VRD1
  #undef VFR1
  #undef GAPB2
  #undef KRD
  #undef STEP
  #undef ENDW
  asm volatile("s_waitcnt lgkmcnt(0)\n\ts_barrier":::"memory");
  u32x4 o0v[2][4];
  if(MODE==1){ const bf16*Ow0=O+(rowbase+q0+wid*QBLK)*DM+hv*D;
    #pragma unroll
    for(int hf=0;hf<2;++hf)
      #pragma unroll
      for(int i=0;i<4;++i)o0v[hf][i]=*(const u32x4*)(Ow0+(long)(i*8+(lane>>3))*DM+hf*64+(lane&7)*8); }
  bf16x8 qn[4];
  if(has_next){
    const long nrow=(long)nb*SEQ;
    const bf16*nks=K+nrow*DM+nh*D+(long)lane*DM+wid*8;
    const bf16*nvs=V+nrow*DM+nhv*D+(long)(16*(wid&3)+(lane>>2))*DM+(wid>>2)*32+(lane&3)*8;
    glds16(nks,(unsigned)__builtin_amdgcn_readfirstlane(kdst));
    glds16(nvs,(unsigned)__builtin_amdgcn_readfirstlane(vdst)); glds16(nvs+64,(unsigned)__builtin_amdgcn_readfirstlane(vdst+SLOTB));
    glds16(nks+(long)KVBLK*DM,(unsigned)__builtin_amdgcn_readfirstlane(kdst+SLOTB));
    const bf16*nQw=Q+(nrow+nqb*QB+wid*QBLK)*DM+nh*D;
    #pragma unroll
    for(int d0=0;d0<4;++d0)qn[d0]=*reinterpret_cast<const bf16x8*>(&nQw[(long)r32*DM+d0*16+hi*8]);
  }
  {auto rr=__builtin_amdgcn_permlane32_swap(__float_as_uint(l_reg),__float_as_uint(l_reg),false,false);l_reg=__uint_as_float(rr[0])+__uint_as_float(rr[1]);}
  if(hi==0)wsf[32+r32]=l_reg;asm volatile("s_waitcnt lgkmcnt(0)":::"memory");
  float rli[16];
  #pragma unroll
  for(int r=0;r<16;++r)rli[r]=__builtin_amdgcn_rcpf(wsf[32+crow(r,hi)]);
  bf16*Ow=O+(rowbase+q0+wid*QBLK)*DM+hv*D;
  { bf16*stg=(bf16*)(shm+LDS_OST)+wid*2048;
    float cmb[2][4][8];
    #pragma unroll
    for(int hf=0;hf<2;++hf){
    #pragma unroll
    for(int r=0;r<16;++r){const int orow=crow(r,hi);
      #pragma unroll
      for(int d0=0;d0<2;++d0)stg[orow*64+d0*32+r32]=__float2bfloat16(o[2*hf+d0][r]*rli[r]);}
    asm volatile("s_waitcnt lgkmcnt(0)":::"memory");
    #pragma unroll
    for(int i=0;i<4;++i){const int row=i*8+(lane>>3),ch=lane&7; const u32x4 v=*(const u32x4*)(stg+row*64+ch*8);
      if(MODE==0){ ATTN_STORE16(Ow+(long)row*DM+hf*64+ch*8,v); }
      else { const u32x4 w=o0v[hf][i];
        cmb[hf][i][0]=__uint_as_float(w.x<<16)-lam*__uint_as_float(v.x<<16); cmb[hf][i][1]=__uint_as_float(w.x&0xffff0000u)-lam*__uint_as_float(v.x&0xffff0000u);
        cmb[hf][i][2]=__uint_as_float(w.y<<16)-lam*__uint_as_float(v.y<<16); cmb[hf][i][3]=__uint_as_float(w.y&0xffff0000u)-lam*__uint_as_float(v.y&0xffff0000u);
        cmb[hf][i][4]=__uint_as_float(w.z<<16)-lam*__uint_as_float(v.z<<16); cmb[hf][i][5]=__uint_as_float(w.z&0xffff0000u)-lam*__uint_as_float(v.z&0xffff0000u);
        cmb[hf][i][6]=__uint_as_float(w.w<<16)-lam*__uint_as_float(v.w<<16); cmb[hf][i][7]=__uint_as_float(w.w&0xffff0000u)-lam*__uint_as_float(v.w&0xffff0000u); } }
    asm volatile("s_waitcnt lgkmcnt(0)":::"memory"); }
    if(MODE==1){ bf16*Uw=OUT+(rowbase+q0+wid*QBLK)*DM+hv*D; const int ch=lane&7;
      #pragma unroll
      for(int i=0;i<4;++i){ float ss=0.f;
        #pragma unroll
        for(int hf=0;hf<2;++hf){
          #pragma unroll
          for(int e=0;e<8;++e)ss+=cmb[hf][i][e]*cmb[hf][i][e]; }
        ss+=__shfl_xor(ss,1);ss+=__shfl_xor(ss,2);ss+=__shfl_xor(ss,4);
        const float rstd=0.8f*__builtin_amdgcn_rsqf(ss*(1.0f/128.0f)+1e-6f);
        const int row=i*8+(lane>>3);
        #pragma unroll
        for(int hf=0;hf<2;++hf){ const float*g=sg+hf*64+ch*8; u32x4 w;
          w.x=cvtpk_s(cmb[hf][i][0]*rstd*g[0],cmb[hf][i][1]*rstd*g[1]); w.y=cvtpk_s(cmb[hf][i][2]*rstd*g[2],cmb[hf][i][3]*rstd*g[3]);
          w.z=cvtpk_s(cmb[hf][i][4]*rstd*g[4],cmb[hf][i][5]*rstd*g[5]); w.w=cvtpk_s(cmb[hf][i][6]*rstd*g[6],cmb[hf][i][7]*rstd*g[7]);
          ATTN_STORE16(Uw+(long)row*DM+hf*64+ch*8,w); } } } }
  __builtin_amdgcn_s_setprio(0);
  if(has_next){
    #pragma unroll
    for(int d0=0;d0<4;++d0)qr[d0]=qn[d0];
  }
  #undef DMA_K
  #undef DMA_V
  #undef CMASK
  #undef START
  #undef RESC
  #undef ROT
}
constexpr int ATTN_LDS_BYTES=LDS_BYTES;
struct AttnTensors { const bf16* Q; const bf16* K; const bf16* V; bf16* O0; bf16* OUT; const float* sg; float lam; };
struct AttnUnit { int bh; int qb; };
struct AttnOrder {
  int vcu, G;
  __device__ __forceinline__ bool next(int i,AttnUnit&u)const{ const int L=i*G+vcu; if(L>=BATCH*8*NQB)return false; const int j=L&3, ii=L>>8; u.bh=(L&255)>>2; u.qb=(ii==0)?15-j:(ii==1)?8+j:(ii==2)?7-j:j; return true; }
};
template<int THRL=8> __device__ __forceinline__ void attn_phase(char*lds,const AttnTensors&T,const AttnOrder&S){
  AttnUnit u,un; un.bh=0; un.qb=0; bf16x8 qr[4]; bool pre=false;
  for(int i=0;S.next(i,u);++i){
    const bool hn=S.next(i+1,un);
    const int b=u.bh>>3, h=u.bh&7, nb=un.bh>>3, nh=un.bh&7;
    attn_unit<THRL,0>(b,2*h,2*h,u.qb,T.Q,T.K,T.V,T.O0,T.OUT,T.lam,T.sg,lds, pre,true,b,2*h+1,2*h,u.qb,qr);
    attn_unit<THRL,1>(b,2*h+1,2*h,u.qb,T.Q,T.K,T.V,T.O0,T.OUT,T.lam,T.sg,lds, true,hn,nb,2*nh,2*nh,un.qb,qr);
    pre=true;
  }
  asm volatile("s_waitcnt vmcnt(0) lgkmcnt(0)\n\ts_barrier":::"memory");
}
#undef SBAR
#undef WAIT_BAR
}

constexpr int NWAVES = 8;
constexpr int BATCH = 8, T = 4096, D = 1024, FF = 4096, MEMLEN = 256;
constexpr int M = BATCH * T;
constexpr int MM = BATCH * MEMLEN;
constexpr int NPROJ1 = 7 * D;
constexpr int PROJW = 10 * D;
constexpr size_t MiB = 1u << 20;
constexpr size_t WS_CTL = 0, CTL_ZERO_BYTES = 128 * 1024;
constexpr size_t WS_WIN = 1 * MiB;
constexpr size_t WS_WA = 21 * MiB, WS_WC = 23 * MiB, WS_WM = 25 * MiB, WS_WO = 27 * MiB;
constexpr size_t WS_WKV = 29 * MiB;
constexpr size_t WS_W1 = 33 * MiB;
constexpr size_t WS_W2 = 41 * MiB;
constexpr size_t WS_MEMN = 49 * MiB;
constexpr size_t WS_KP = 53 * MiB;
constexpr size_t WS_VT = 57 * MiB;
constexpr size_t WS_STATS = 61 * MiB;
constexpr size_t REG = 64 * MiB;
constexpr size_t WS_R1 = 1 * REG;
constexpr size_t WS_R2 = 2 * REG;
constexpr size_t WS_R3 = 3 * REG;
constexpr size_t WS_R4 = 4 * REG;
constexpr size_t WS_R5 = 5 * REG;
constexpr size_t WS_R6 = 6 * REG;
constexpr size_t WS_R7 = 7 * REG;
constexpr size_t WS_XN8 = WS_R7;
constexpr size_t WS_W8 = WS_WIN;
constexpr size_t WS_XSC = 63 * MiB;
constexpr size_t WS_WSC = 63 * MiB + 256 * 1024;
constexpr int CW_WMAX = 16384;
constexpr size_t WS_END = 8 * REG;
constexpr int CW_BAR = 4096;

constexpr int RING_OFF = 0, RING_BYTES = 131072;
constexpr int LDSCTL_OFF = RING_BYTES, MISC_OFF = LDSCTL_OFF + 320;
constexpr int XCH_OFF = RING_BYTES + 1024;
constexpr int LDS_BYTES = 147456;
static_assert(XCH_OFF + 8192 <= LDS_BYTES, "LDS map");
#define GAS __attribute__((address_space(1)))
#define LAS __attribute__((address_space(3)))
typedef unsigned short bf16;
typedef unsigned v4u __attribute__((ext_vector_type(4)));
typedef float f32x4 __attribute__((ext_vector_type(4)));
typedef short bf16x8 __attribute__((ext_vector_type(8)));
typedef GAS unsigned gu32;
typedef GAS unsigned long long gu64;
#define RLX_AGENT __ATOMIC_RELAXED, __HIP_MEMORY_SCOPE_AGENT
#define LDS_WAIT() asm volatile("s_waitcnt lgkmcnt(0)" ::: "memory")
#define VM_WAIT() asm volatile("s_waitcnt vmcnt(0)" ::: "memory")
__device__ __forceinline__ unsigned long long rt() { return __builtin_amdgcn_s_memrealtime(); }
__device__ __forceinline__ unsigned f2bf(float f) { unsigned u = __builtin_bit_cast(unsigned, f); return (u + 0x7fffu + ((u >> 16) & 1u)) >> 16; }
__device__ __forceinline__ unsigned pk2(float lo, float hi) { return f2bf(lo) | (f2bf(hi) << 16); }

#define XB_TMO      128
#define XB_XCNT(j)  (256  + 64 * (j))
#define XB_XSUB(j)  (1280 + 64 * (j))
#define XB_XGEN(j)  (2304 + 64 * (j))
#define XB_TOP      3328
#define XB_TOPGEN   3392
#define XCD_BAR_WORDS 3456
#define XB_SPIN_CAP (1u << 18)

__device__ __forceinline__ unsigned xb_ld(unsigned* p)              { return __hip_atomic_load(p, __ATOMIC_RELAXED, __HIP_MEMORY_SCOPE_AGENT); }
__device__ __forceinline__ unsigned xb_add(unsigned* p, unsigned v) { return __hip_atomic_fetch_add(p, v, __ATOMIC_RELAXED, __HIP_MEMORY_SCOPE_AGENT); }
__device__ __forceinline__ unsigned xb_xcc_id() { return (unsigned)__builtin_amdgcn_s_getreg((3 << 11) | 20) & 0xFu; }
#define XB_SPIN(cond, bar) do { unsigned _sp = 0; while (cond) { __builtin_amdgcn_s_sleep(1); \
    if ((++_sp & 255u) == 0u) { if (xb_ld(&(bar)[XB_TMO])) break; if (_sp > XB_SPIN_CAP) { atomicAdd(&(bar)[XB_TMO], 1u); break; } } } } while (0)

struct XcdBarrier {
    unsigned* bar; unsigned x;
    volatile LAS unsigned* st;
};

__device__ __forceinline__ XcdBarrier xcd_barrier_post(unsigned* bar, volatile LAS unsigned* st) {
    XcdBarrier b; b.bar = bar; b.x = xb_xcc_id(); b.st = st;
    if (threadIdx.x == 0) (void)xb_add(&bar[XB_XCNT(b.x)], 1u);
    return b;
}
__device__ __forceinline__ void xcd_barrier_complete(unsigned* bar, unsigned x, unsigned& nloc, unsigned& nx) {
    const unsigned G = gridDim.x * gridDim.y * gridDim.z;
    unsigned sum, cnt, mine, sp = 0u;
    for (;;) {
        sum = 0u; cnt = 0u; mine = 0u;
#pragma unroll
        for (unsigned j = 0; j < 16; ++j) { const unsigned c = xb_ld(&bar[XB_XCNT(j)]); sum += c; cnt += (c > 0u) ? 1u : 0u; mine = (j == x) ? c : mine; }
        if (sum == G) break;
        __builtin_amdgcn_s_sleep(1);
        if ((++sp & 255u) == 0u) { if (xb_ld(&bar[XB_TMO])) break; if (sp > XB_SPIN_CAP) { atomicAdd(&bar[XB_TMO], 1u); break; } }
    }
    nloc = mine > 0u ? mine : 1u; nx = cnt > 0u ? cnt : 1u;
}

__device__ __forceinline__ void xcd_barrier(const XcdBarrier& b) {
    asm volatile("s_waitcnt vmcnt(0)" ::: "memory");
    __syncthreads();
    if (threadIdx.x == 0) {
        unsigned* bar = b.bar;
        __builtin_amdgcn_s_waitcnt(0);
        unsigned nloc = b.st[0], nx = b.st[1];
        if (nloc == 0u) { xcd_barrier_complete(bar, b.x, nloc, nx); b.st[0] = nloc; b.st[1] = nx; }
        const unsigned old = xb_add(&bar[XB_XSUB(b.x)], 1u);
        const unsigned gen = old / nloc;
        if (old + 1u == (gen + 1u) * nloc) {
            __builtin_amdgcn_fence(__ATOMIC_RELEASE, "agent");
            asm volatile("s_waitcnt vmcnt(0)" ::: "memory");
            const unsigned og = xb_add(&bar[XB_TOP], 1u);
            const unsigned tg = og / nx;
            if (og + 1u == (tg + 1u) * nx) xb_add(&bar[XB_TOPGEN], 1u);
            else XB_SPIN(xb_ld(&bar[XB_TOPGEN]) == tg, bar);
            __builtin_amdgcn_fence(__ATOMIC_ACQUIRE, "agent");
            xb_add(&bar[XB_XGEN(b.x)], 1u);
            asm volatile("s_waitcnt vmcnt(0)" ::: "memory");
        } else {
            XB_SPIN(xb_ld(&bar[XB_XGEN(b.x)]) == gen, bar);
            __builtin_amdgcn_fence(__ATOMIC_ACQUIRE, "agent");
            asm volatile("s_waitcnt vmcnt(0)" ::: "memory");
        }
    }
    __syncthreads();
}
struct Frame {
    LAS unsigned char* lds;
    volatile LAS unsigned* MISC;
    gu32* ctl;
    int wave;
    int vcu, G;
};
__device__ __forceinline__ float wave_sum(float v) {
#pragma unroll
    for (int o = 1; o < 64; o <<= 1) v += __shfl_xor(v, o);
    return v;
}
__device__ __forceinline__ void p0_transpose_item(const float* W, int K, int N, bf16* WT, int row_off, LAS float* scr, int item, int lane, const float* kgain = nullptr) {
    const int nblk = N / 32, kb = item / nblk, nb = item % nblk, k0 = 64 * kb, n0 = 32 * nb;
    float wv[32];
#pragma unroll
    for (int i = 0; i < 32; ++i) { const int kk = 2 * i + (lane >> 5); wv[i] = W[(size_t)(k0 + kk) * N + n0 + (lane & 31)]; }
#pragma unroll
    for (int i = 0; i < 32; ++i) { const int kk = 2 * i + (lane >> 5); float w = wv[i]; if (kgain) w *= kgain[k0 + kk]; scr[kk * 33 + (lane & 31)] = w; }
    LDS_WAIT(); asm volatile("" ::: "memory");
    const int c = lane & 7;
#pragma unroll
    for (int j = 0; j < 4; ++j) { const int n = (lane >> 3) + 8 * j; const LAS float* s = scr + (8 * c) * 33 + n;
        v4u o; o.x = pk2(s[0 * 33], s[1 * 33]); o.y = pk2(s[2 * 33], s[3 * 33]); o.z = pk2(s[4 * 33], s[5 * 33]); o.w = pk2(s[6 * 33], s[7 * 33]);
        *(GAS v4u*)(WT + (size_t)(row_off + n0 + n) * K + k0 + 8 * c) = o; }
    LDS_WAIT(); asm volatile("" ::: "memory");
}
__device__ __forceinline__ void p0_transpose_item_f8(const float* W, int N, int ncol0, unsigned char* W8T, int K, LAS float* scr, int kb, int nb, int lane, float mul) {
    const int k0 = 64 * kb, n0 = ncol0 + 32 * nb;
    float wv[32];
#pragma unroll
    for (int i = 0; i < 32; ++i) { const int kk = 2 * i + (lane >> 5); wv[i] = W[(size_t)(k0 + kk) * N + n0 + (lane & 31)]; }
#pragma unroll
    for (int i = 0; i < 32; ++i) { const int kk = 2 * i + (lane >> 5); scr[kk * 33 + (lane & 31)] = wv[i] * mul; }
    LDS_WAIT(); asm volatile("" ::: "memory");
    const int c = lane & 7;
#pragma unroll
    for (int j = 0; j < 4; ++j) { const int n = (lane >> 3) + 8 * j; const LAS float* sp = scr + (8 * c) * 33 + n;
        int lo = __builtin_amdgcn_cvt_pk_fp8_f32(sp[0 * 33], sp[1 * 33], 0, false); lo = __builtin_amdgcn_cvt_pk_fp8_f32(sp[2 * 33], sp[3 * 33], lo, true);
        int hi = __builtin_amdgcn_cvt_pk_fp8_f32(sp[4 * 33], sp[5 * 33], 0, false); hi = __builtin_amdgcn_cvt_pk_fp8_f32(sp[6 * 33], sp[7 * 33], hi, true);
        *(GAS unsigned long long*)(W8T + (size_t)(32 * nb + n) * K + k0 + 8 * c) = (unsigned long long)(unsigned)lo | ((unsigned long long)(unsigned)hi << 32); }
    LDS_WAIT(); asm volatile("" ::: "memory");
}
__device__ __forceinline__ void p0_colmax_item(const float* W, int N, int kb, int nb, unsigned* wmax, int lane) {
    const int k0 = 64 * kb, n0 = 32 * nb; float mx = 0.f;
    float wv[32];
#pragma unroll
    for (int i = 0; i < 32; ++i) wv[i] = W[(size_t)(k0 + 2 * i + (lane >> 5)) * N + n0 + (lane & 31)];
#pragma unroll
    for (int i = 0; i < 32; ++i) mx = __builtin_fmaxf(mx, __builtin_fabsf(wv[i]));
    mx = __builtin_fmaxf(mx, __shfl_xor(mx, 32));
    if (lane < 32) __hip_atomic_fetch_max(wmax + lane, __float_as_uint(mx), __ATOMIC_RELAXED, __HIP_MEMORY_SCOPE_AGENT);
}
__device__ __forceinline__ void p0_quant_item(const float* W, int N, int kb, int nb, unsigned char* W8T, unsigned* wmax, float* wsc, LAS float* scr, int lane) {
    const int k0 = 64 * kb, n0 = 32 * nb;
    float wv[32];
#pragma unroll
    for (int i = 0; i < 32; ++i) wv[i] = W[(size_t)(k0 + 2 * i + (lane >> 5)) * N + n0 + (lane & 31)];
#pragma unroll
    for (int i = 0; i < 32; ++i) scr[(2 * i + (lane >> 5)) * 33 + (lane & 31)] = wv[i];
    LDS_WAIT(); asm volatile("" ::: "memory");
    const int c = lane & 7;
#pragma unroll
    for (int j = 0; j < 4; ++j) { const int n = (lane >> 3) + 8 * j; const LAS float* sp = scr + (8 * c) * 33 + n;
        const float cm = __uint_as_float(__hip_atomic_load(wmax + n, __ATOMIC_RELAXED, __HIP_MEMORY_SCOPE_AGENT)); const float inv = cm > 0.f ? 127.0f / cm : 0.f;
        unsigned lo = 0u, hi = 0u;
#pragma unroll
        for (int e = 0; e < 4; ++e) { lo |= ((unsigned)(int)__builtin_rintf(sp[e * 33] * inv) & 0xffu) << (8 * e); hi |= ((unsigned)(int)__builtin_rintf(sp[(4 + e) * 33] * inv) & 0xffu) << (8 * e); }
        *(GAS unsigned long long*)(W8T + (size_t)n * 1024 + k0 + 8 * c) = (unsigned long long)lo | ((unsigned long long)hi << 32); }
    if (kb == 0 && lane < 32) wsc[lane] = __uint_as_float(__hip_atomic_load(wmax + lane, __ATOMIC_RELAXED, __HIP_MEMORY_SCOPE_AGENT)) * (1.0f / 127.0f);
    LDS_WAIT(); asm volatile("" ::: "memory");
}
__device__ __forceinline__ void rms_row2_to_i8(int lane, const float* xrow, const float* g, unsigned* o8row, float* xsc) {
    const GAS f32x4* xr = (const GAS f32x4*)xrow + lane; const GAS f32x4* gr = (const GAS f32x4*)g + lane;
    f32x4 v[8]; float s0 = 0.f, s1 = 0.f;
#pragma unroll
    for (int j = 0; j < 8; ++j) v[j] = xr[64 * j];
#pragma unroll
    for (int j = 0; j < 4; ++j) { s0 += (v[j].x * v[j].x + v[j].y * v[j].y) + (v[j].z * v[j].z + v[j].w * v[j].w); s1 += (v[4 + j].x * v[4 + j].x + v[4 + j].y * v[4 + j].y) + (v[4 + j].z * v[4 + j].z + v[4 + j].w * v[4 + j].w); }
#pragma unroll
    for (int o = 1; o < 64; o <<= 1) { s0 += __shfl_xor(s0, o); s1 += __shfl_xor(s1, o); }
    const float r0 = 1.f / sqrtf(s0 * (1.f / D) + 1e-6f), r1 = 1.f / sqrtf(s1 * (1.f / D) + 1e-6f);
    float a0 = 0.f, a1 = 0.f;
#pragma unroll
    for (int j = 0; j < 4; ++j) { const f32x4 gg = gr[64 * j]; v[j] = v[j] * gg * r0; v[4 + j] = v[4 + j] * gg * r1;
        a0 = __builtin_fmaxf(a0, __builtin_fmaxf(__builtin_fmaxf(__builtin_fabsf(v[j].x), __builtin_fabsf(v[j].y)), __builtin_fmaxf(__builtin_fabsf(v[j].z), __builtin_fabsf(v[j].w))));
        a1 = __builtin_fmaxf(a1, __builtin_fmaxf(__builtin_fmaxf(__builtin_fabsf(v[4 + j].x), __builtin_fabsf(v[4 + j].y)), __builtin_fmaxf(__builtin_fabsf(v[4 + j].z), __builtin_fabsf(v[4 + j].w)))); }
#pragma unroll
    for (int o = 1; o < 64; o <<= 1) { a0 = __builtin_fmaxf(a0, __shfl_xor(a0, o)); a1 = __builtin_fmaxf(a1, __shfl_xor(a1, o)); }
    const float i0 = a0 > 0.f ? 127.0f / a0 : 0.f, i1 = a1 > 0.f ? 127.0f / a1 : 0.f;
#pragma unroll
    for (int j = 0; j < 4; ++j) {
        const unsigned p0 = ((unsigned)(int)__builtin_rintf(v[j].x * i0) & 0xffu) | (((unsigned)(int)__builtin_rintf(v[j].y * i0) & 0xffu) << 8) | (((unsigned)(int)__builtin_rintf(v[j].z * i0) & 0xffu) << 16) | (((unsigned)(int)__builtin_rintf(v[j].w * i0) & 0xffu) << 24);
        const unsigned p1 = ((unsigned)(int)__builtin_rintf(v[4 + j].x * i1) & 0xffu) | (((unsigned)(int)__builtin_rintf(v[4 + j].y * i1) & 0xffu) << 8) | (((unsigned)(int)__builtin_rintf(v[4 + j].z * i1) & 0xffu) << 16) | (((unsigned)(int)__builtin_rintf(v[4 + j].w * i1) & 0xffu) << 24);
        ((GAS unsigned*)o8row)[lane + 64 * j] = p0; ((GAS unsigned*)o8row)[256 + lane + 64 * j] = p1; }
    if (lane == 0) { xsc[0] = a0 * (1.0f / 127.0f); xsc[1] = a1 * (1.0f / 127.0f); }
}
__device__ __forceinline__ void rms_row_to_bf16(int lane, const float* xrow, const float* g, bf16* orow) {
    const GAS f32x4* xr = (const GAS f32x4*)xrow + lane; const GAS f32x4* gr = (const GAS f32x4*)g + lane;
    f32x4 v[4]; float s = 0.f;
#pragma unroll
    for (int j = 0; j < 4; ++j) { v[j] = xr[64 * j]; s += (v[j].x * v[j].x + v[j].y * v[j].y) + (v[j].z * v[j].z + v[j].w * v[j].w); }
    const float rstd = 1.f / sqrtf(wave_sum(s) * (1.f / D) + 1e-6f);
    GAS unsigned long long* o8 = (GAS unsigned long long*)orow + lane;
#pragma unroll
    for (int j = 0; j < 4; ++j) { const f32x4 gg = gr[64 * j]; o8[64 * j] = (unsigned long long)pk2(v[j].x * rstd * gg.x, v[j].y * rstd * gg.y) | ((unsigned long long)pk2(v[j].z * rstd * gg.z, v[j].w * rstd * gg.w) << 32); }
}
__device__ __forceinline__ void rms_row2_to_bf16(int lane, const float* xrow, const float* g, bf16* orow, unsigned* o8row) {
    const GAS f32x4* xr = (const GAS f32x4*)xrow + lane; const GAS f32x4* gr = (const GAS f32x4*)g + lane;
    f32x4 v[8]; float s0 = 0.f, s1 = 0.f;
#pragma unroll
    for (int j = 0; j < 8; ++j) v[j] = xr[64 * j];
#pragma unroll
    for (int j = 0; j < 4; ++j) { s0 += (v[j].x * v[j].x + v[j].y * v[j].y) + (v[j].z * v[j].z + v[j].w * v[j].w); s1 += (v[4 + j].x * v[4 + j].x + v[4 + j].y * v[4 + j].y) + (v[4 + j].z * v[4 + j].z + v[4 + j].w * v[4 + j].w); }
#pragma unroll
    for (int o = 1; o < 64; o <<= 1) { s0 += __shfl_xor(s0, o); s1 += __shfl_xor(s1, o); }
    const float r0 = 1.f / sqrtf(s0 * (1.f / D) + 1e-6f), r1 = 1.f / sqrtf(s1 * (1.f / D) + 1e-6f);
    GAS unsigned long long* o8 = (GAS unsigned long long*)orow + lane;
#pragma unroll
    for (int j = 0; j < 4; ++j) { const f32x4 gg = gr[64 * j];
        o8[64 * j] = (unsigned long long)pk2(v[j].x * r0 * gg.x, v[j].y * r0 * gg.y) | ((unsigned long long)pk2(v[j].z * r0 * gg.z, v[j].w * r0 * gg.w) << 32);
        o8[64 * (4 + j)] = (unsigned long long)pk2(v[4 + j].x * r1 * gg.x, v[4 + j].y * r1 * gg.y) | ((unsigned long long)pk2(v[4 + j].z * r1 * gg.z, v[4 + j].w * r1 * gg.w) << 32);
        int p0 = __builtin_amdgcn_cvt_pk_fp8_f32(v[j].x * r0 * gg.x, v[j].y * r0 * gg.y, 0, false); p0 = __builtin_amdgcn_cvt_pk_fp8_f32(v[j].z * r0 * gg.z, v[j].w * r0 * gg.w, p0, true);
        int p1 = __builtin_amdgcn_cvt_pk_fp8_f32(v[4 + j].x * r1 * gg.x, v[4 + j].y * r1 * gg.y, 0, false); p1 = __builtin_amdgcn_cvt_pk_fp8_f32(v[4 + j].z * r1 * gg.z, v[4 + j].w * r1 * gg.w, p1, true);
        ((GAS unsigned*)o8row)[lane + 64 * j] = (unsigned)p0; ((GAS unsigned*)o8row)[256 + lane + 64 * j] = (unsigned)p1; }
}
__device__ __forceinline__ void unpack8f(const v4u w, float (&v)[8]) {
    v[0] = __uint_as_float(w.x << 16); v[1] = __uint_as_float(w.x & 0xffff0000u); v[2] = __uint_as_float(w.y << 16); v[3] = __uint_as_float(w.y & 0xffff0000u);
    v[4] = __uint_as_float(w.z << 16); v[5] = __uint_as_float(w.z & 0xffff0000u); v[6] = __uint_as_float(w.w << 16); v[7] = __uint_as_float(w.w & 0xffff0000u); }
__device__ __forceinline__ v4u pack8f(const float (&v)[8]) { v4u o; o.x = pk2(v[0], v[1]); o.y = pk2(v[2], v[3]); o.z = pk2(v[4], v[5]); o.w = pk2(v[6], v[7]); return o; }

struct Args { const float* in[24]; float* out; unsigned char* ws; int ph_lo, ph_hi; };
constexpr int N_PHASES = 9;

typedef const __attribute__((address_space(4))) Args KArgs;
__device__ __forceinline__ KArgs* ka_ptr() { KArgs* p = (KArgs*)__builtin_amdgcn_kernarg_segment_ptr(); asm volatile("" : "+s"(p)); return p; }
#define PHASE_PTRS const KArgs* KA = ka_ptr(); unsigned char* ws = KA->ws; const float* x = KA->in[0]; const float* mem = KA->in[1]; const float* norm_mix_g = KA->in[2]; const float* norm_mem_g = KA->in[3]; const float* w_in = KA->in[4]; const float* b_gate = KA->in[5]; const float* q_norm_g = KA->in[6]; const float* k_norm_g = KA->in[7]; const float* lam_q1 = KA->in[8]; const float* lam_k1 = KA->in[9]; const float* lam_q2 = KA->in[10]; const float* lam_k2 = KA->in[11]; const float* subln_g = KA->in[12]; const float* w_attn_o = KA->in[13]; const float* conv_w = KA->in[14]; const float* w_conv_o = KA->in[15]; const float* w_mem_kv = KA->in[16]; const float* mq_norm_g = KA->in[17]; const float* mk_norm_g = KA->in[18]; const float* w_mem_o = KA->in[19]; const float* w_o = KA->in[20]; const float* norm_mlp_g = KA->in[21]; const float* w_mlp_in = KA->in[22]; const float* w_mlp_out = KA->in[23]; float* out = KA->out; bf16* WinT = (bf16*)(ws + WS_WIN); bf16* WaT = (bf16*)(ws + WS_WA); bf16* WcT = (bf16*)(ws + WS_WC); bf16* WmT = (bf16*)(ws + WS_WM); bf16* WoT = (bf16*)(ws + WS_WO); bf16* WkvT = (bf16*)(ws + WS_WKV); bf16* W1T = (bf16*)(ws + WS_W1); bf16* W2T = (bf16*)(ws + WS_W2); float* STATS = (float*)(ws + WS_STATS); bf16* MEMN = (bf16*)(ws + WS_MEMN); bf16* KP = (bf16*)(ws + WS_KP); bf16* VT = (bf16*)(ws + WS_VT); bf16* R1 = (bf16*)(ws + WS_R1); bf16* R2 = (bf16*)(ws + WS_R2); bf16* R3 = (bf16*)(ws + WS_R3); bf16* R4 = (bf16*)(ws + WS_R4); bf16* R5 = (bf16*)(ws + WS_R5); bf16* R6 = (bf16*)(ws + WS_R6); bf16* R7 = (bf16*)(ws + WS_R7); bf16* D0 = (bf16*)out; bf16* D1 = (bf16*)out + (size_t)M * D;
__global__ void __launch_bounds__(NWAVES * 64, 2) hybrid_fwd(Args args) {
    extern __shared__ __attribute__((aligned(16))) unsigned char lds[];
    Frame F;
    F.lds = (LAS unsigned char*)lds;
    F.MISC = (volatile LAS unsigned*)(F.lds + MISC_OFF);
    F.wave = __builtin_amdgcn_readfirstlane((int)threadIdx.x >> 6);
    F.G = gridDim.x; { const int bx = blockIdx.x; F.vcu = (F.G % 8 == 0) ? (bx % 8) * (F.G / 8) + bx / 8 : bx; }
    F.ctl = (gu32*)(args.ws + WS_CTL);
    for (int u = ((int)threadIdx.x); u < (LDS_BYTES - LDSCTL_OFF) / 4; u += NWAVES * 64) ((LAS unsigned*)(F.lds + LDSCTL_OFF))[u] = 0u;
    __syncthreads();
    const int lo = args.ph_lo, hi = args.ph_hi;
    const bool multi = (hi - lo) > 1;
    XcdBarrier bar; bar.bar = (unsigned*)(F.ctl + CW_BAR); bar.x = 0; bar.st = nullptr;
    if (multi) bar = xcd_barrier_post((unsigned*)(F.ctl + CW_BAR), F.MISC + 8);
#ifndef REP_MASK
#define REP_MASK 0
#endif
#ifndef PH_MASK
#define PH_MASK 0x1ff
#endif
#define IN(k) (((PH_MASK >> (k)) & 1) && lo <= (k) && (k) < hi)
#define BOTH(k) (IN(k) && IN((k) + 1))
#define GRID_BAR() xcd_barrier(bar)
    PG8_LAS float* X0 = (PG8_LAS float*)(F.lds + XCH_OFF); PG8_LAS float* X1 = (PG8_LAS float*)(F.lds + XCH_OFF + 4096);
    const int gw = F.vcu * NWAVES + F.wave, NGW = F.G * NWAVES;
    LAS unsigned char* ring = F.lds + RING_OFF;
    const int cid = (int)blockIdx.x;
    typedef pg8::StaticOrder SO;

    if (IN(0)) for (int rep_ = 0; rep_ <= ((REP_MASK >> 0) & 1); ++rep_) { PHASE_PTRS if (rep_) { VM_WAIT(); __syncthreads(); }
        LAS float* scr = (LAS float*)(F.lds + RING_OFF + F.wave * 16384);
        constexpr int I_IN = (D / 64) * (PROJW / 32), I_KV = (D / 64) * (2 * D / 32);
        unsigned* WMAX = (unsigned*)F.ctl + CW_WMAX; unsigned char* W8 = ws + WS_W8; float* WSC = (float*)(ws + WS_WSC); float* XSC = (float*)(ws + WS_XSC);
        const int ln_ = (int)threadIdx.x & 63;
        for (int it = gw; it < I_IN + I_KV; it += NGW) {
            int r = it;
            if (r < I_KV) { p0_transpose_item(w_mem_kv, D, 2 * D, WkvT, 0, scr, r, ln_); continue; } r -= I_KV;
            { const int nb = r % (PROJW / 32), kb = r / (PROJW / 32);
                const int db = nb < 96 ? nb : nb < 128 ? 128 + 2 * (nb - 96) : nb < 160 ? 96 + (nb - 128) : nb < 192 ? 129 + 2 * (nb - 160) : nb;
                p0_colmax_item(w_in, PROJW, kb, nb, WMAX + 32 * db, ln_); }
        }
        for (int m = gw; m < MM; m += NGW) rms_row_to_bf16(ln_, mem + (size_t)m * D, norm_mem_g, MEMN + (size_t)m * D);
        for (int m = 2 * gw; m < M; m += 2 * NGW) rms_row2_to_i8(ln_, x + (size_t)m * D, norm_mix_g, (unsigned*)(ws + WS_XN8) + (size_t)m * (D / 4), XSC + m);
        if (multi) GRID_BAR();
        for (int it = gw; it < I_IN; it += NGW) {
            const int nb = it % (PROJW / 32), kb = it / (PROJW / 32);
            const int db = nb < 96 ? nb : nb < 128 ? 128 + 2 * (nb - 96) : nb < 160 ? 96 + (nb - 128) : nb < 192 ? 129 + 2 * (nb - 160) : nb;
            p0_quant_item(w_in, PROJW, kb, nb, W8 + (size_t)(32 * db) * 1024, WMAX + 32 * db, WSC + 32 * db, scr, ln_);
        }
        if (BOTH(0)) GRID_BAR();
    }
    if (IN(1)) for (int rep_ = 0; rep_ <= ((REP_MASK >> 1) & 1); ++rep_) { PHASE_PTRS if (rep_) { VM_WAIT(); __syncthreads(); }
#ifndef P1_SUB
#define P1_SUB 31
#endif
        if (P1_SUB & 1) { pg8::Gemm g{MEMN, WkvT, D, D, D, (long)256 * D, 0, (long)256 * D, 0}; SO S; S.init(MM, D, F.G, cid);
          pg8::EpiMemK E{KP, mq_norm_g, mk_norm_g, X0};
          pg8::gemm_phase<pg8::EpiMemK, SO, true, true>(ring, g, S, E); }
        if (P1_SUB & 2) { pg8::Gemm g{WkvT + (size_t)D * D, MEMN, D, D, D, (long)256 * D, 0, (long)256 * D, 0}; SO S; S.init(D, MM, F.G, (cid + 64) % F.G);
          pg8::EpiPlain E{VT, MM};
          pg8::gemm_phase<pg8::EpiPlain, SO, true, true>(ring, g, S, E); }
        const bf16* XN8 = (const bf16*)(ws + WS_XN8); const bf16* W8 = (const bf16*)(ws + WS_W8); const float* XSC = (const float*)(ws + WS_XSC); const float* WSC = (const float*)(ws + WS_WSC);
        if (P1_SUB & 4) { pg8::Gemm g{XN8, W8, D / 2, D / 2, D / 2, (long)256 * (D / 2), 0, (long)256 * (D / 2), 0}; SO S; S.init(M, 2 * D, F.G, cid);
          pg8::EpiQK E{R2, (size_t)M * D, q_norm_g, k_norm_g, XSC, WSC};
          pg8::gemm_phase<pg8::EpiQK, SO, true, true, false, false, true>(ring, g, S, E); }
        if (P1_SUB & 8) { pg8::Gemm g{XN8, W8 + (size_t)2 * D * (D / 2), D / 2, D / 2, D / 2, (long)256 * (D / 2), 0, (long)256 * (D / 2), 0}; SO S; S.init(M, 4 * D, F.G, cid);
          pg8::EpiP1b E{R4, R6, R5, XSC, WSC + 2 * D};
          pg8::gemm_phase<pg8::EpiP1b, SO, true, true, false, false, true>(ring, g, S, E); }
        if (P1_SUB & 16) { pg8::Gemm g{XN8, W8 + (size_t)6 * D * (D / 2), D / 2, D / 2, D / 2, (long)256 * (D / 2), 0, (long)256 * (D / 2), 0}; SO S; S.init(M, D, F.G, cid);
          pg8::EpiQm E{D0, X0, XSC, WSC + 6 * D};
          pg8::gemm_phase<pg8::EpiQm, SO, true, true, false, false, true>(ring, g, S, E); }
        {
            const int nk = (F.G >= 224) ? ((cid < 32 || (cid >= 192 && cid < 224)) ? -1 : (cid < 192 ? cid - 32 : cid - 64)) : cid;
            const int NH = (F.G >= 224) ? F.G - 64 : F.G;
            if (nk >= 0) {
                LAS float* scr = (LAS float*)(F.lds + RING_OFF + F.wave * 16384);
                constexpr int I_SQ = (D / 64) * (D / 32), I_1 = (D / 64) * (FF / 32), I_2 = (FF / 64) * (D / 32);
                constexpr int NIT2 = 4 * I_SQ + I_1 + I_2;
                for (int it = nk * NWAVES + F.wave; it < NIT2; it += NH * NWAVES) {
                    int r = it;
                    if (r < I_SQ) { p0_transpose_item(w_attn_o, D, D, WaT, 0, scr, r, ((int)threadIdx.x & 63)); continue; } r -= I_SQ;
                    if (r < I_SQ) { p0_transpose_item(w_conv_o, D, D, WcT, 0, scr, r, ((int)threadIdx.x & 63)); continue; } r -= I_SQ;
                    if (r < I_SQ) { p0_transpose_item(w_mem_o, D, D, WmT, 0, scr, r, ((int)threadIdx.x & 63)); continue; } r -= I_SQ;
                    if (r < I_SQ) { p0_transpose_item(w_o, D, D, WoT, 0, scr, r, ((int)threadIdx.x & 63)); continue; } r -= I_SQ;
                    if (r < I_1) { p0_transpose_item(w_mlp_in, D, FF, W1T, 0, scr, r, ((int)threadIdx.x & 63), norm_mlp_g); continue; } r -= I_1;
                    p0_transpose_item(w_mlp_out, FF, D, W2T, 0, scr, r, ((int)threadIdx.x & 63));
                }
            }
        }
        if (BOTH(1)) GRID_BAR();
    }
    if (IN(2)) for (int rep_ = 0; rep_ <= ((REP_MASK >> 2) & 1); ++rep_) { PHASE_PTRS if (rep_) { VM_WAIT(); __syncthreads(); }
#ifndef P2_SUB
#define P2_SUB 7
#endif
        if (P2_SUB & 1) {
            const int cg8 = (((int)threadIdx.x) & 127) * 8, sub = ((int)threadIdx.x) >> 7;
            float w0[8], w1[8], w2[8];
#pragma unroll
            for (int e = 0; e < 8; ++e) { w0[e] = conv_w[cg8 + e]; w1[e] = conv_w[D + cg8 + e]; w2[e] = conv_w[2 * D + cg8 + e]; }
            for (int it = F.vcu; it < M / 64; it += F.G) {
                const int r0 = it * 64 + sub * 16;
                float p2[8], p1[8];
                if ((r0 & (T - 1)) == 0) {
#pragma unroll
                    for (int e = 0; e < 8; ++e) { p2[e] = 0.f; p1[e] = 0.f; }
                } else {
                    unpack8f(*(const GAS v4u*)(R5 + (size_t)(r0 - 2) * D + cg8), p2); unpack8f(*(const GAS v4u*)(R5 + (size_t)(r0 - 1) * D + cg8), p1);
                }
#pragma unroll 4
                for (int r = 0; r < 16; ++r) {
                    const size_t off = (size_t)(r0 + r) * D + cg8;
                    float a[8], gb[8], y[8];
                    unpack8f(*(const GAS v4u*)(R5 + off), a); unpack8f(*(const GAS v4u*)(R6 + off), gb);
#pragma unroll
                    for (int e = 0; e < 8; ++e) { const float cur = a[e]; y[e] = gb[e] * (w0[e] * p2[e] + w1[e] * p1[e] + w2[e] * cur); p2[e] = p1[e]; p1[e] = cur; }
                    *(GAS v4u*)(D1 + off) = pack8f(y);
                }
            }
        }
        __syncthreads();
        if (P2_SUB & 2) { pg8::Gemm g{D0, KP, D, D, 256, (long)256 * D, 256, 256, (long)256 * D}; SO S; S.init(M, D, F.G, cid);
          pg8::EpiSoftmax E{D0, X0};
          pg8::gemm_phase<pg8::EpiSoftmax, SO, true, true>(ring, g, S, E); }
        VM_WAIT(); __syncthreads();
        if (P2_SUB & 4) { pg8::Gemm g{D0, VT, D, MM, 256, (long)256 * D, 256, (long)256 * MM, 256}; SO S; S.init(M, D, F.G, cid);
          pg8::EpiPlain E{D0, D};
          pg8::gemm_phase<pg8::EpiPlain, SO, true, true>(ring, g, S, E); }
    }
    if (IN(3)) for (int rep_ = 0; rep_ <= ((REP_MASK >> 3) & 1); ++rep_) { PHASE_PTRS if (rep_) { VM_WAIT(); __syncthreads(); }
        const int ln_ = (int)threadIdx.x & 63;
        const float d1 = wave_sum(lam_q1[ln_] * lam_k1[ln_]), d2 = wave_sum(lam_q2[ln_] * lam_k2[ln_]);
        const float lam = expf(d1) - expf(d2) + 0.2f;
        const attn_body::AttnTensors AT{(const attn_body::bf16*)R2, (const attn_body::bf16*)R3, (const attn_body::bf16*)R4, (attn_body::bf16*)R1, (attn_body::bf16*)R2, subln_g, lam};
        const attn_body::AttnOrder AS{F.vcu, F.G};
        attn_body::attn_phase<8>((char*)lds + RING_OFF, AT, AS);
        if (BOTH(3)) GRID_BAR();
    }
    if (IN(5)) for (int rep_ = 0; rep_ <= ((REP_MASK >> 5) & 1); ++rep_) { PHASE_PTRS if (rep_) { VM_WAIT(); __syncthreads(); }
        { pg8::Gemm g{(const bf16*)(ws + WS_XN8), (const bf16*)(ws + WS_W8) + (size_t)NPROJ1 * (D / 2), D / 2, D / 2, D / 2, (long)256 * (D / 2), 0, (long)256 * (D / 2), 0}; pg8::GateOrder S; S.base.init(M, D, F.G, cid);
          pg8::EpiGate E{(unsigned char*)R3, (size_t)M * D, b_gate, (const float*)(ws + WS_XSC), (const float*)(ws + WS_WSC) + NPROJ1};
          pg8::gemm_phase<pg8::EpiGate, pg8::GateOrder, true, true, false, false, true>(ring, g, S, E); }
        VM_WAIT(); __syncthreads();
        { pg8::Gemm g{R2, WaT, D, D, D, (long)256 * D, 0, (long)256 * D, 0, D1, D0, (long)(WS_WC - WS_WA) / 2}; pg8::SegOrder S; S.base.init(M, D, F.G, cid);
          pg8::EpiBranch3 E{(const unsigned char*)R3, (const unsigned char*)R3 + (size_t)M * D, (const unsigned char*)R3 + (size_t)2 * M * D, R6};
          pg8::gemm_phase<pg8::EpiBranch3, pg8::SegOrder, true, true, true>(ring, g, S, E); }
        if (BOTH(5)) GRID_BAR();
    }
    if (IN(6)) for (int rep_ = 0; rep_ <= ((REP_MASK >> 6) & 1); ++rep_) { PHASE_PTRS if (rep_) { VM_WAIT(); __syncthreads(); }
        { pg8::Gemm g{R6, WoT, D, D, D, (long)256 * D, 0, (long)256 * D, 0}; SO S; S.init(M, D, F.G, cid);
          pg8::EpiX1 E{x, out, R2, STATS};
          pg8::gemm_phase<pg8::EpiX1, SO, true, true>(ring, g, S, E); }
        if (BOTH(6)) GRID_BAR();
    }
    if (IN(7)) for (int rep_ = 0; rep_ <= ((REP_MASK >> 7) & 1); ++rep_) { PHASE_PTRS if (rep_) { VM_WAIT(); __syncthreads(); }
        { pg8::Gemm g{R2, W1T, D, D, D, (long)256 * D, 0, (long)256 * D, 0}; SO S; S.init(M, FF, F.G, cid);
          pg8::EpiRelu2P E{R3, FF};
          pg8::gemm_phase<pg8::EpiRelu2P, SO, true, true>(ring, g, S, E); }
        if (BOTH(7)) GRID_BAR();
    }
    if (IN(8)) for (int rep_ = 0; rep_ <= ((REP_MASK >> 8) & 1); ++rep_) { PHASE_PTRS if (rep_) { VM_WAIT(); __syncthreads(); }
        { pg8::Gemm g{R3, W2T, FF, FF, FF, (long)256 * FF, 0, (long)256 * FF, 0}; SO S; S.init(M, D, F.G, cid);
          pg8::EpiOutN E{R2, out, STATS};
          pg8::gemm_phase<pg8::EpiOutN, SO, true, true>(ring, g, S, E); }
    }
    if (hi > N_PHASES) { const unsigned long long* ia = (const unsigned long long*)__builtin_amdgcn_implicitarg_ptr(); if (ia[11] == 1ull) __builtin_trap(); }
#undef IN
#undef BOTH
}

#ifndef MK_N_LAUNCHES
#define MK_N_LAUNCHES 1
#endif
extern "C" void kernel_launch(void* const* d_in, const int* in_sizes, int n_in, void* d_out, int out_size, void* d_ws, size_t ws_size, hipStream_t stream) {
    static int grid = 0;
    if (grid == 0) {
        if (n_in != 24 || in_sizes[0] != M * D || out_size != M * D || ws_size < WS_END) { fprintf(stderr, "kernel_launch: unexpected shapes (n_in %d, in0 %d, out %d, ws %zu); nothing launched\n", n_in, n_in > 0 ? in_sizes[0] : -1, out_size, ws_size); grid = -1; return; }
        int dev = 0, cus = 0, per_cu = 0;
        if (hipGetDevice(&dev) != hipSuccess || hipDeviceGetAttribute(&cus, hipDeviceAttributeMultiprocessorCount, dev) != hipSuccess) { grid = -1; return; }
        if (hipFuncSetAttribute((const void*)hybrid_fwd, hipFuncAttributeMaxDynamicSharedMemorySize, LDS_BYTES) != hipSuccess) { fprintf(stderr, "kernel_launch: hipFuncSetAttribute failed\n"); grid = -1; return; }
        if (hipOccupancyMaxActiveBlocksPerMultiprocessor(&per_cu, (const void*)hybrid_fwd, NWAVES * 64, LDS_BYTES) != hipSuccess || per_cu < 1) { fprintf(stderr, "kernel_launch: occupancy query says %d\n", per_cu); per_cu = 1; }
        (void)hipGetLastError();
        grid = cus * 1;
    }
    if (grid < 0) return;
    (void)hipMemsetAsync((char*)d_ws + WS_CTL, 0, CTL_ZERO_BYTES, stream);
    Args a{};
    for (int i = 0; i < 24; ++i) a.in[i] = (const float*)d_in[i];
    a.out = (float*)d_out; a.ws = (unsigned char*)d_ws;
    if (MK_N_LAUNCHES == 1) {
        a.ph_lo = 0; a.ph_hi = N_PHASES;
        void* kargs[] = {&a};
        hipError_t e = hipLaunchCooperativeKernel((const void*)hybrid_fwd, dim3(grid), dim3(NWAVES * 64), kargs, LDS_BYTES, stream);
        if (e != hipSuccess) fprintf(stderr, "kernel_launch: cooperative launch failed: %s (grid %d)\n", hipGetErrorString(e), grid);
    } else {
        for (int p = 0; p < N_PHASES; ++p) { a.ph_lo = p; a.ph_hi = p + 1; hipLaunchKernelGGL(hybrid_fwd, dim3(grid), dim3(NWAVES * 64), LDS_BYTES, stream, a); }
    }
}
```
